# Optimizing an MI355X kernel written in HIP

```python
import jax, jax.numpy as jnp
from jax import lax
import numpy as np

D_MODEL = 1024
BATCH = 2
SEQ = 8192
DEPTH = 2

HEAD_DIM = 64
ROPE_THETA = 10000.0

RET_HEADS = 4
RET_DK = 64
RET_DV = 64
RET_CHUNK = 128

SWA_Q_HEADS = 6
SWA_KV_HEADS = 2
SWA_WINDOW = 128
SWA_BLOCK = 128

MLA_HEADS = 6
MLA_Q_RANK = 384
MLA_KV_RANK = 256
MLA_NOPE = 64
MLA_ROPE = 32
MLA_V = 64
MLA_BLOCK = 128

RET_W = RET_HEADS * RET_DV
SWA_W = SWA_Q_HEADS * HEAD_DIM
MLA_W = MLA_HEADS * MLA_V
D_MIX = RET_W + SWA_W + MLA_W

IN_SIZES = (
    RET_HEADS * RET_DK,
    RET_HEADS * RET_DK,
    RET_W,
    RET_W,
    SWA_Q_HEADS * HEAD_DIM,
    SWA_KV_HEADS * HEAD_DIM,
    SWA_KV_HEADS * HEAD_DIM,
    MLA_Q_RANK,
    MLA_KV_RANK,
    MLA_ROPE,
)
IN_COLS = sum(IN_SIZES)

N_EXPERTS = 16
N_GROUPS = 4
EXPERTS_PER_GROUP = N_EXPERTS // N_GROUPS
TOP_K = 2
D_EXPERT = 256

DEEPNORM_ALPHA = (2 * DEPTH) ** 0.25
DEEPNORM_BETA = (8 * DEPTH) ** -0.25
LN_EPS = 1e-5
RMS_EPS = 1e-6
NEG_INF = -1e30

kernel_name = "hymba_style_ret_swa_mla_grouped_moe_deepnorm"


def _split_points():
    return [int(s) for s in np.cumsum(np.array(IN_SIZES))[:-1]]


def layer_norm(x, g, b):
    xf = x.astype(jnp.float32)
    mu = jnp.mean(xf, -1, keepdims=True)
    var = jnp.mean(jnp.square(xf - mu), -1, keepdims=True)
    return ((xf - mu) * lax.rsqrt(var + LN_EPS) * g + b).astype(x.dtype)


def rms_norm(x, g):
    xf = x.astype(jnp.float32)
    return (xf * lax.rsqrt(jnp.mean(xf * xf, -1, keepdims=True) + RMS_EPS) * g).astype(x.dtype)


def rope(x, pos):
    d = x.shape[-1]
    inv = ROPE_THETA ** (-jnp.arange(0, d, 2, dtype=jnp.float32) / d)
    ang = pos.astype(jnp.float32)[:, None] * inv[None, :]
    cos = jnp.cos(ang)[:, None, :]
    sin = jnp.sin(ang)[:, None, :]
    x1, x2 = x[..., : d // 2], x[..., d // 2:]
    return jnp.concatenate([x1 * cos - x2 * sin, x1 * sin + x2 * cos], -1).astype(x.dtype)


def retention(q, k, v, g, gn_w):
    B, S, H, dk = q.shape
    dv = RET_DV
    C = RET_CHUNK
    NC = S // C
    gamma = 1.0 - 2.0 ** (-5.0 - jnp.arange(H, dtype=jnp.float32))
    log_g = jnp.log(gamma)
    idx = jnp.arange(C, dtype=jnp.float32)
    rel = idx[:, None] - idx[None, :]
    decay_in = jnp.where(rel[None] >= 0,
                         jnp.exp(jnp.maximum(rel, 0.0)[None] * log_g[:, None, None]), 0.0)
    xi = jnp.exp((idx[None, :] + 1.0) * log_g[:, None]).T
    zeta = jnp.exp((C - 1.0 - idx[None, :]) * log_g[:, None]).T
    chunk_decay = jnp.exp(C * log_g)

    qc = q.reshape(B, NC, C, H, dk).astype(jnp.float32)
    kc = (k * (dk ** -0.5)).reshape(B, NC, C, H, dk).astype(jnp.float32)
    vc = v.reshape(B, NC, C, H, dv).astype(jnp.float32)

    scores = jnp.einsum('bnihd,bnjhd->bnhij', qc, kc) * decay_in[None, None]
    inner = jnp.einsum('bnhij,bnjhe->bnihe', scores, vc)

    upd = jnp.einsum('bnjhd,bnjhe->bnhde', kc * zeta[None, None, :, :, None], vc)

    def step(state, u):
        return chunk_decay[None, :, None, None] * state + u, state

    init = jnp.zeros((B, H, dk, dv), jnp.float32)
    _, prev_states = lax.scan(step, init, jnp.moveaxis(upd, 1, 0))
    prev_states = jnp.moveaxis(prev_states, 0, 1)
    cross = jnp.einsum('bnihd,bnhde->bnihe', qc * xi[None, None, :, :, None], prev_states)

    o = (inner + cross).reshape(B, S, H, dv)
    mu = jnp.mean(o, -1, keepdims=True)
    var = jnp.mean(jnp.square(o - mu), -1, keepdims=True)
    o = (o - mu) * lax.rsqrt(var + LN_EPS) * gn_w.astype(jnp.float32).reshape(H, dv)
    o = o.reshape(B, S, H * dv) * jax.nn.silu(g.astype(jnp.float32))
    return o.astype(q.dtype)


def sliding_window_sink_attention(q, k, v, sinks):
    B, S, Hq, d = q.shape
    Hkv = k.shape[2]
    G = Hq // Hkv
    L = SWA_BLOCK
    NB = S // L
    qb = q.reshape(B, NB, L, Hkv, G, d)
    kb = k.reshape(B, NB, L, Hkv, d)
    vb = v.reshape(B, NB, L, Hkv, d)
    pad = ((0, 0), (1, 0), (0, 0), (0, 0), (0, 0))
    kwin = jnp.concatenate([jnp.pad(kb, pad)[:, :NB], kb], axis=2)
    vwin = jnp.concatenate([jnp.pad(vb, pad)[:, :NB], vb], axis=2)

    s = jnp.einsum('bnihgd,bnjhd->bnhgij', qb, kwin).astype(jnp.float32) * (d ** -0.5)
    i = jnp.arange(L)[:, None]
    j = jnp.arange(2 * L)[None, :]
    band = (j <= i + L) & (j > i + L - SWA_WINDOW)
    blk = jnp.arange(NB)[:, None]
    valid = (blk > 0) | (jnp.arange(2 * L)[None, :] >= L)
    mask = band[None] & valid[:, None, :]
    s = jnp.where(mask[None, :, None, None], s, NEG_INF)

    sink = sinks.astype(jnp.float32).reshape(1, 1, Hkv, G, 1, 1)
    m = jnp.maximum(jnp.max(s, -1, keepdims=True), sink)
    p = jnp.exp(s - m)
    denom = jnp.sum(p, -1, keepdims=True) + jnp.exp(sink - m)
    o = jnp.einsum('bnhgij,bnjhd->bnihgd', (p / denom).astype(v.dtype), vwin)
    return o.reshape(B, S, Hq * d)


def latent_attention(c_q, c_kv, k_rope, q_norm_w, kv_norm_w, w_uq, w_ukv, pos):
    B, S, _ = c_q.shape
    H = MLA_HEADS
    dq = MLA_NOPE + MLA_ROPE
    q = (rms_norm(c_q, q_norm_w) @ w_uq).reshape(B, S, H, dq)
    q = jnp.concatenate([q[..., :MLA_NOPE], rope(q[..., MLA_NOPE:], pos)], -1)
    kv = (rms_norm(c_kv, kv_norm_w) @ w_ukv).reshape(B, S, H, MLA_NOPE + MLA_V)
    k_nope, v = kv[..., :MLA_NOPE], kv[..., MLA_NOPE:]
    k_pe = rope(k_rope[:, :, None, :], pos)
    k = jnp.concatenate([k_nope, jnp.broadcast_to(k_pe, (B, S, H, MLA_ROPE))], -1)
    scale = dq ** -0.5
    L = MLA_BLOCK
    NB = S // L
    qb = jnp.moveaxis(q.reshape(B, NB, L, H, dq), 1, 0)
    kpos = jnp.arange(S)

    def block(args):
        q_blk, n = args
        s = jnp.einsum('bihd,bjhd->bhij', q_blk, k).astype(jnp.float32) * scale
        qpos = n * L + jnp.arange(L)
        s = jnp.where(kpos[None, :] <= qpos[:, None], s, NEG_INF)
        p = jax.nn.softmax(s, axis=-1)
        return jnp.einsum('bhij,bjhe->bihe', p.astype(v.dtype), v)

    o = lax.map(block, (qb, jnp.arange(NB)))
    return jnp.moveaxis(o, 0, 1).reshape(B, S, H * MLA_V)


def grouped_moe(x, router_w, router_bias, w_gate_up, w_down):
    B, S, D = x.shape
    t = x.reshape(-1, D)
    T = t.shape[0]
    scores = jax.nn.sigmoid((t @ router_w).astype(jnp.float32))
    biased = scores + router_bias.astype(jnp.float32)
    grp = biased.reshape(T, N_GROUPS, EXPERTS_PER_GROUP)
    grp_score = jnp.sum(lax.top_k(grp, TOP_K)[0], -1)
    sel_group = jnp.argmax(grp_score, -1)
    in_group = jnp.repeat(jax.nn.one_hot(sel_group, N_GROUPS) > 0, EXPERTS_PER_GROUP, axis=-1)
    _, top_idx = lax.top_k(jnp.where(in_group, biased, -jnp.inf), TOP_K)
    sel = jnp.take_along_axis(scores, top_idx, -1)
    weights = sel / jnp.sum(sel, -1, keepdims=True)
    gates = jnp.sum(jax.nn.one_hot(top_idx, N_EXPERTS, dtype=jnp.float32) * weights[..., None], 1)
    h = jnp.einsum('td,edf->tef', t, w_gate_up)
    a = jax.nn.silu(h[..., :D_EXPERT]) * h[..., D_EXPERT:] * gates[..., None].astype(h.dtype)
    y = jnp.einsum('tef,efd->td', a, w_down)
    return y.reshape(B, S, D)


def setup_inputs(seed: int = 0) -> dict:
    key = jax.random.key(seed)
    ks = jax.random.split(key, 20)
    f32 = jnp.float32
    nrm = lambda k, shape, s: jax.random.normal(k, shape, f32) * s
    return {
        "x": nrm(ks[0], (BATCH, SEQ, D_MODEL), 1.0),
        "w_in": nrm(ks[1], (DEPTH, D_MODEL, IN_COLS), D_MODEL ** -0.5),
        "ret_gn_w": 1.0 + nrm(ks[2], (DEPTH, RET_W), 0.02),
        "swa_sinks": nrm(ks[3], (DEPTH, SWA_Q_HEADS), 0.5),
        "mla_q_norm_w": 1.0 + nrm(ks[4], (DEPTH, MLA_Q_RANK), 0.02),
        "mla_kv_norm_w": 1.0 + nrm(ks[5], (DEPTH, MLA_KV_RANK), 0.02),
        "mla_w_uq": nrm(ks[6], (DEPTH, MLA_Q_RANK, MLA_HEADS * (MLA_NOPE + MLA_ROPE)), MLA_Q_RANK ** -0.5),
        "mla_w_ukv": nrm(ks[7], (DEPTH, MLA_KV_RANK, MLA_HEADS * (MLA_NOPE + MLA_V)), MLA_KV_RANK ** -0.5),
        "w_out": nrm(ks[8], (DEPTH, D_MIX, D_MODEL), DEEPNORM_BETA * D_MIX ** -0.5),
        "ln1_g": 1.0 + nrm(ks[9], (DEPTH, D_MODEL), 0.02),
        "ln1_b": nrm(ks[10], (DEPTH, D_MODEL), 0.02),
        "router_w": nrm(ks[11], (D_MODEL, N_EXPERTS), D_MODEL ** -0.5),
        "router_bias": nrm(ks[12], (N_EXPERTS,), 0.01),
        "exp_w_gate_up": nrm(ks[13], (DEPTH, N_EXPERTS, D_MODEL, 2 * D_EXPERT), D_MODEL ** -0.5),
        "exp_w_down": nrm(ks[14], (DEPTH, N_EXPERTS, D_EXPERT, D_MODEL), DEEPNORM_BETA * D_EXPERT ** -0.5),
        "ln2_g": 1.0 + nrm(ks[15], (DEPTH, D_MODEL), 0.02),
        "ln2_b": nrm(ks[16], (DEPTH, D_MODEL), 0.02),
    }


def reference(x, w_in, ret_gn_w, swa_sinks, mla_q_norm_w, mla_kv_norm_w, mla_w_uq, mla_w_ukv,
              w_out, ln1_g, ln1_b, router_w, router_bias, exp_w_gate_up, exp_w_down, ln2_g, ln2_b):
    B, S, _ = x.shape
    pos = jnp.arange(S)
    splits = _split_points()
    for l in range(DEPTH):
        (r_q, r_k, r_v, r_g, s_q, s_k, s_v, c_q, c_kv, k_rope) = jnp.split(x @ w_in[l], splits, axis=-1)
        rq = rope(r_q.reshape(B, S, RET_HEADS, RET_DK), pos)
        rk = rope(r_k.reshape(B, S, RET_HEADS, RET_DK), pos)
        ret_o = retention(rq, rk, r_v, r_g, ret_gn_w[l])
        swa_o = sliding_window_sink_attention(
            s_q.reshape(B, S, SWA_Q_HEADS, HEAD_DIM),
            s_k.reshape(B, S, SWA_KV_HEADS, HEAD_DIM),
            s_v.reshape(B, S, SWA_KV_HEADS, HEAD_DIM),
            swa_sinks[l])
        mla_o = latent_attention(c_q, c_kv, k_rope, mla_q_norm_w[l], mla_kv_norm_w[l],
                                 mla_w_uq[l], mla_w_ukv[l], pos)
        mix = jnp.concatenate([ret_o, swa_o, mla_o], axis=-1) @ w_out[l]
        x = layer_norm(DEEPNORM_ALPHA * x + mix, ln1_g[l], ln1_b[l])
        ffn = grouped_moe(x, router_w, router_bias, exp_w_gate_up[l], exp_w_down[l])
        x = layer_norm(DEEPNORM_ALPHA * x + ffn, ln2_g[l], ln2_b[l])
    return x
```

```cpp
#include <hip/hip_runtime.h>
#include <cstdio>
#include <cstdint>
#include <math.h>

constexpr int BATCH = 2, SEQ = 8192, TOK = BATCH * SEQ, DM = 1024, DEPTH = 2;
constexpr int NP = 2336, NPP = 2560;
constexpr int O_RQ = 0, O_RK = 256, O_RV = 512, O_RG = 768, O_SQ = 1024, O_SK = 1408, O_SV = 1536, O_CQ = 1664, O_CKV = 2048, O_KR = 2304;
constexpr int NQM = 576, NQMP = 768, NKVM = 768;
constexpr int NEXP = 16, DEXP = 256;
constexpr float LN_EPS = 1e-5f, RMS_EPS = 1e-6f;
constexpr float ALPHA = 1.4142135623730951f;
constexpr float LOG2E = 1.4426950408889634f;

typedef unsigned short bf16_t;
typedef short bf16x8 __attribute__((ext_vector_type(8)));
typedef float f32x4 __attribute__((ext_vector_type(4)));
typedef float f32x16 __attribute__((ext_vector_type(16)));
typedef unsigned u32x4 __attribute__((ext_vector_type(4)));
typedef unsigned u32x2 __attribute__((ext_vector_type(2)));
#define LAS __attribute__((address_space(3)))
#define GAS __attribute__((address_space(1)))

constexpr size_t MiB = 1u << 20;
constexpr size_t WS_CTL = 0, CTL_ZERO_BYTES = 1 * MiB;
constexpr size_t WS_LIST = 1 * MiB, WS_GATE = 2 * MiB;
constexpr size_t WS_TABR = 3 * MiB, WS_TABM = 5 * MiB;
constexpr size_t WS_WIN = 6 * MiB;
constexpr size_t WS_WUQ = 16 * MiB;
constexpr size_t WS_WUKV = 17 * MiB + 256 * 1024;
constexpr size_t WS_WOUT = 18 * MiB;
constexpr size_t WS_WGU = 22 * MiB;
constexpr size_t WS_WD = 38 * MiB;
constexpr size_t WS_R0 = 46 * MiB;
constexpr size_t WS_R1 = 78 * MiB;
constexpr size_t WS_A2 = WS_R1, WS_YE = WS_R1 + 18 * MiB;
constexpr size_t WS_R2 = 162 * MiB;
constexpr size_t WS_QM = WS_R2, WS_KVM = WS_R2 + 24 * MiB, WS_KPE = WS_R2 + 48 * MiB, WS_U = WS_R2 + 49 * MiB;
constexpr size_t WS_R3 = 219 * MiB;
constexpr size_t WS_X1 = WS_R2;
constexpr size_t WS_END = 251 * MiB;
static_assert(WS_WUQ + 2 * 768 * 384 * 2 <= WS_WUKV && WS_WUKV + 2 * 768 * 256 * 2 <= WS_WOUT, "ws map");
static_assert(WS_U + 8 * MiB <= WS_R3 && WS_X1 + 64 * MiB <= WS_END && WS_YE + 64 * MiB <= WS_R2, "ws map");

__device__ __forceinline__ float bf2f(bf16_t v) { return __uint_as_float(((unsigned)v) << 16); }
__device__ __forceinline__ unsigned f2bf(float f) { unsigned u = __float_as_uint(f); return (u + 0x7fffu + ((u >> 16) & 1u)) >> 16; }
__device__ __forceinline__ unsigned pk2(float lo, float hi) { return f2bf(lo) | (f2bf(hi) << 16); }
__device__ __forceinline__ unsigned cvt_pk_bf16(float lo, float hi) { unsigned r; asm volatile("v_cvt_pk_bf16_f32 %0, %1, %2" : "=v"(r) : "v"(lo), "v"(hi)); return r; }
__device__ __forceinline__ float wave_sum(float v) {
#pragma unroll
  for (int o = 1; o < 64; o <<= 1) v += __shfl_xor(v, o);
  return v;
}
#define LDS_WAIT() asm volatile("s_waitcnt lgkmcnt(0)" ::: "memory")
#define VM_WAIT() asm volatile("s_waitcnt vmcnt(0)" ::: "memory")

__device__ __forceinline__ int tidx() { int t = (int)threadIdx.x; asm volatile("" : "+v"(t)); return t; }
namespace pg8 {
constexpr int BM = 256, BK = 64, HALF = 128, HTB = HALF * BK * 2  , STAGE_BYTES = 8 * HTB, NXCD = 8, WGM = 8;

__host__ __device__ __forceinline__ int lds_byte(int r, int c) { const int st = (r >> 4) * 2 + (c >> 5), rr = r & 15, cc = c & 31, ob = rr * 64 + cc * 2; return st * 1024 + (ob ^ (((ob >> 9) & 1) << 5)); }
__host__ __device__ __forceinline__ void stage_rc(int b, int& R, int& C) { const int st = b / 1024, sb = b % 1024, swz = sb ^ (((sb >> 9) & 1) << 5); R = (st >> 1) * 16 + swz / 64; C = (st & 1) * 32 + (swz % 64) / 2; }
__host__ __device__ __forceinline__ int perm32(int rho) { const int n = rho >> 4, i = rho & 15; return 8 * (i >> 2) + 4 * n + (i & 3); }

struct Unit { int pm, pn; const char* pA; const char* pB; int e, mt, valid, pad; };
struct Gemm { const bf16_t* A; const bf16_t* Bt; int lda, ldb, K, pad; };

struct StaticOrder {
    int nM, nN, nwg, G, c; const char* A; const char* Bt; size_t tA, tB;
    __host__ __device__ void init(const Gemm& g, int M, int N, int G_, int c_) { nM = M / BM; nN = N / BM; nwg = nM * nN; G = G_; c = c_; A = (const char*)g.A; Bt = (const char*)g.Bt; tA = (size_t)BM * g.lda * 2; tB = (size_t)BM * g.ldb * 2; }
    __device__ __forceinline__ unsigned rowoff(const Unit&, int) const { return 0u; }
    __host__ __device__ bool next(int i, Unit& u) const {
        const long L = (long)i * G + c; if (L >= nwg) return false;
        int wgid = (int)L; { const int q = nwg / NXCD, r = nwg % NXCD, xcd = wgid % NXCD, off = wgid / NXCD; wgid = (xcd < r ? xcd * (q + 1) : r * (q + 1) + (xcd - r) * q) + off; }
        const int nig = WGM * nN, gid = wgid / nig, fm = gid * WGM, gsz = (nM - fm) < WGM ? (nM - fm) : WGM;
        u.pm = fm + ((wgid % nig) % gsz); u.pn = (wgid % nig) / gsz; u.pA = A + (size_t)u.pm * tA; u.pB = Bt + (size_t)u.pn * tB; u.e = 0; u.mt = 0; u.valid = BM; u.pad = 0; return true;
    }
};

struct EpiBf16 {
    static constexpr bool PERM = true;
    bf16_t* O; int ldc, pad;
    __device__ __forceinline__ void operator()(const f32x4 (&acc)[2][2][4][2], const Unit& u, int wr, int wc, int fr, int fq) const {
        const int row0 = u.pm * BM + wr * 64 + fr; const int col0 = u.pn * BM + wc * 32 + 8 * fq;
#pragma unroll
        for (int ai = 0; ai < 2; ++ai)
#pragma unroll
            for (int m = 0; m < 4; ++m) { bf16_t* rowp = O + (size_t)(row0 + ai * HALF + m * 16) * ldc + col0;
#pragma unroll
                for (int bj = 0; bj < 2; ++bj) { const f32x4 v0 = acc[ai][bj][m][0], v1 = acc[ai][bj][m][1];
                    u32x4 w; w.x = cvt_pk_bf16(v0[0], v0[1]); w.y = cvt_pk_bf16(v0[2], v0[3]); w.z = cvt_pk_bf16(v1[0], v1[1]); w.w = cvt_pk_bf16(v1[2], v1[3]);
                    *(u32x4*)(rowp + bj * HALF) = w; } }
    }
};
struct EpiRms {
    static constexpr bool PERM = true;
    bf16_t* O; int ldc, lda; const bf16_t* A; int kdim; float eps;
    __device__ __forceinline__ void operator()(const f32x4 (&acc)[2][2][4][2], const Unit& u, int wr, int wc, int fr, int fq) const {
        const int row0 = u.pm * BM + wr * 64 + fr; const int col0 = u.pn * BM + wc * 32 + 8 * fq;
        const float inv_k = 1.0f / (float)kdim; const int nch = kdim >> 5;
#pragma unroll
        for (int ai = 0; ai < 2; ++ai)
#pragma unroll
            for (int m = 0; m < 4; ++m) { const int row = row0 + ai * HALF + m * 16;
                const bf16_t* ar = A + (size_t)row * lda + fq * 8; float ss = 0.f;
                for (int i = 0; i < nch; ++i) { const bf16x8 v = *(const bf16x8*)(ar + i * 32);
#pragma unroll
                    for (int j = 0; j < 8; ++j) { const float f = bf2f((bf16_t)v[j]); ss = fmaf(f, f, ss); } }
                ss += __shfl_xor(ss, 16); ss += __shfl_xor(ss, 32);
                const float r = rsqrtf(ss * inv_k + eps);
                bf16_t* rowp = O + (size_t)row * ldc + col0;
#pragma unroll
                for (int bj = 0; bj < 2; ++bj) { const f32x4 v0 = acc[ai][bj][m][0] * r, v1 = acc[ai][bj][m][1] * r;
                    u32x4 w; w.x = cvt_pk_bf16(v0[0], v0[1]); w.y = cvt_pk_bf16(v0[2], v0[3]); w.z = cvt_pk_bf16(v1[0], v1[1]); w.w = cvt_pk_bf16(v1[2], v1[3]);
                    *(u32x4*)(rowp + bj * HALF) = w; } }
    }
};
struct EpiResid {
    static constexpr bool PERM = false;
    const float* X; float* Y; int ldc; float alpha;
    __device__ __forceinline__ void operator()(const f32x4 (&acc)[2][2][4][2], const Unit& u, int wr, int wc, int fr, int fq) const {
        const int col0 = u.pn * BM + wc * 32 + 4 * fq;
#pragma unroll
        for (int ai = 0; ai < 2; ++ai)
#pragma unroll
            for (int m = 0; m < 4; ++m) { const size_t off = (size_t)(u.pm * BM + ai * HALF + wr * 64 + m * 16 + fr) * ldc + col0;
#pragma unroll
                for (int bj = 0; bj < 2; ++bj)
#pragma unroll
                    for (int n = 0; n < 2; ++n) { const f32x4 xv = *(const f32x4*)(X + off + bj * HALF + n * 16);
                        *(f32x4*)(Y + off + bj * HALF + n * 16) = xv * alpha + acc[ai][bj][m][n]; } }
    }
};

template <class Epi, class Sched, bool ALIGN_EPI, bool GATHER>
__device__ __forceinline__ void gemm_phase(LAS unsigned char* lds, const Gemm g, const Sched& S, const Epi& E) {
    const int tid = tidx(), wid = __builtin_amdgcn_readfirstlane(tid >> 6), lane = tid & 63, wr = wid >> 2, wc = wid & 3, fr = lane & 15, fq = lane >> 4;
    int nt = g.K / BK; asm volatile("" : "+s"(nt));
    unsigned voffA[2], voffB[2]; int RA[2];
#pragma unroll
    for (int i = 0; i < 2; ++i) { int R, C; stage_rc(tid * 16 + i * 8192, R, C); const int Rb = Epi::PERM ? ((R & ~31) + perm32(R & 31)) : R;
        RA[i] = R; voffA[i] = GATHER ? (unsigned)C * 2u : (unsigned)(R * g.lda + C) * 2u; voffB[i] = (unsigned)(Rb * g.ldb + C) * 2u; }
    const size_t kstep = (size_t)(BK * 2);
    const size_t hstepA = GATHER ? (size_t)0 : (size_t)HALF * g.lda * 2, hstepB = (size_t)HALF * g.ldb * 2;
    const unsigned ldsw = (unsigned)wid * 1024u;
    const int aoff = lds_byte(wr * 64 + fr, fq * 8), boff = lds_byte(wc * 32 + fr, fq * 8);
#define PG8_SA(b, h) (((b) * 2 + (h)) * HTB)
#define PG8_SB(b, h) ((4 + (b) * 2 + (h)) * HTB)
#define PG8_STAGE(bufoff, gbase, voff) do { _Pragma("unroll") for (int _i = 0; _i < 2; ++_i) \
        __builtin_amdgcn_global_load_lds((const unsigned*)((const char*)(gbase) + (voff)[_i]), (LAS unsigned*)(lds + (bufoff) + ldsw + _i * 8192), 16, 0, 0); } while (0)
#define PG8_STAGE_A(bufoff, gbase, h, vg) do { _Pragma("unroll") for (int _i = 0; _i < 2; ++_i) \
        __builtin_amdgcn_global_load_lds((const unsigned*)((const char*)(gbase) + (GATHER ? (size_t)0 : (h) * hstepA) + (GATHER ? (vg)[h][_i] : voffA[_i])), (LAS unsigned*)(lds + (bufoff) + ldsw + _i * 8192), 16, 0, 0); } while (0)
#define PG8_GOFF(vg, u) do { if (GATHER) { _Pragma("unroll") for (int _h = 0; _h < 2; ++_h) _Pragma("unroll") for (int _i = 0; _i < 2; ++_i) (vg)[_h][_i] = S.rowoff(u, _h * HALF + RA[_i]) + voffA[_i]; } } while (0)
#define PG8_LDA(dst, b, h) do { _Pragma("unroll") for (int m = 0; m < 4; ++m) _Pragma("unroll") for (int k = 0; k < 2; ++k) dst[m][k] = *(const LAS bf16x8*)(lds + PG8_SA(b, h) + aoff + m * 2048 + k * 1024); } while (0)
#define PG8_LDB(dst, b, h) do { _Pragma("unroll") for (int n = 0; n < 2; ++n) _Pragma("unroll") for (int k = 0; k < 2; ++k) dst[n][k] = *(const LAS bf16x8*)(lds + PG8_SB(b, h) + boff + n * 2048 + k * 1024); } while (0)
#define PG8_MMA(ai, bj, At, Bt) do { __builtin_amdgcn_s_setprio(1); _Pragma("unroll") for (int m = 0; m < 4; ++m) _Pragma("unroll") for (int n = 0; n < 2; ++n) _Pragma("unroll") for (int k = 0; k < 2; ++k) \
        acc[ai][bj][m][n] = __builtin_amdgcn_mfma_f32_16x16x32_bf16(Bt[n][k], At[m][k], acc[ai][bj][m][n], 0, 0, 0); __builtin_amdgcn_s_setprio(0); } while (0)
#define PG8_WAIT_V(n) asm volatile("s_waitcnt vmcnt(" #n ")" ::: "memory")
#define PG8_WAIT_L(n) asm volatile("s_waitcnt lgkmcnt(" #n ")" ::: "memory")
#define PG8_BAR __builtin_amdgcn_s_barrier()
#define PG8_SCHED __builtin_amdgcn_sched_barrier(0)
    Unit cur, nxt; int ui = 0;
    if (!S.next(0, cur)) return;
    f32x4 acc[2][2][4][2];
#pragma unroll
    for (int a = 0; a < 2; ++a)
#pragma unroll
        for (int b = 0; b < 2; ++b)
#pragma unroll
            for (int m = 0; m < 4; ++m)
#pragma unroll
                for (int n = 0; n < 2; ++n) acc[a][b][m][n] = (f32x4){0.f, 0.f, 0.f, 0.f};
    bf16x8 At[4][2], B0[2][2], B1[2][2];
    const char* cA = cur.pA; const char* cB = cur.pB;
    unsigned vgc[2][2] = {{0u, 0u}, {0u, 0u}};
    PG8_GOFF(vgc, cur);
    PG8_STAGE(PG8_SB(0, 0), cB, voffB); PG8_STAGE(PG8_SB(0, 1), cB + hstepB, voffB); PG8_STAGE_A(PG8_SA(0, 0), cA, 0, vgc); PG8_STAGE_A(PG8_SA(0, 1), cA, 1, vgc);
    if (wr == 1) PG8_BAR;
    PG8_WAIT_V(2); PG8_BAR;
    PG8_STAGE(PG8_SB(1, 0), cB + kstep, voffB); PG8_STAGE_A(PG8_SA(1, 0), cA + kstep, 0, vgc); PG8_STAGE(PG8_SB(1, 1), cB + hstepB + kstep, voffB);
    PG8_WAIT_V(6); PG8_BAR;
    for (;;) {
        const bool has_next = S.next(ui + 1, nxt);
        const char* nA = has_next ? nxt.pA : cA; const char* nB = has_next ? nxt.pB : cB;

#pragma unroll 1
        for (int t = 0; t < nt; t += 2) {
            const bool last = (t == nt - 2);
            const char* a1 = cA + (size_t)(t + 1) * kstep;
            const char* a2 = last ? nA : cA + (size_t)(t + 2) * kstep; const char* b2 = last ? nB : cB + (size_t)(t + 2) * kstep;
            const char* a3 = a2 + kstep; const char* b3 = b2 + kstep;
            unsigned vgn[2][2] = {{0u, 0u}, {0u, 0u}};
            if (GATHER) { if (last && has_next) { PG8_GOFF(vgn, nxt); PG8_SCHED; } }
            PG8_LDB(B0, 0, 0); PG8_LDB(B1, 0, 1); PG8_SCHED; PG8_LDA(At, 0, 0); PG8_STAGE_A(PG8_SA(1, 1), a1, 1, vgc);
            if (GATHER) { if (last && has_next) {
#pragma unroll
                for (int _h = 0; _h < 2; ++_h) { vgc[_h][0] = vgn[_h][0]; vgc[_h][1] = vgn[_h][1]; } } }
            PG8_WAIT_V(8); PG8_WAIT_L(0); PG8_BAR; PG8_MMA(0, 0, At, B0); PG8_MMA(0, 1, At, B1); PG8_BAR; PG8_SCHED;
            PG8_LDA(At, 0, 1); PG8_STAGE(PG8_SB(0, 0), b2, voffB); PG8_STAGE(PG8_SB(0, 1), b2 + hstepB, voffB); PG8_STAGE_A(PG8_SA(0, 0), a2, 0, vgc);
            PG8_WAIT_V(8); PG8_WAIT_L(0); PG8_BAR; PG8_MMA(1, 0, At, B0); PG8_MMA(1, 1, At, B1); PG8_BAR; PG8_SCHED;
            PG8_LDB(B0, 1, 0); PG8_LDB(B1, 1, 1); PG8_SCHED; PG8_LDA(At, 1, 0); PG8_STAGE_A(PG8_SA(0, 1), a2, 1, vgc);
            PG8_WAIT_V(8); PG8_WAIT_L(0); PG8_BAR; PG8_MMA(0, 0, At, B0); PG8_MMA(0, 1, At, B1); PG8_BAR; PG8_SCHED;
            PG8_LDA(At, 1, 1); PG8_STAGE(PG8_SB(1, 0), b3, voffB); PG8_STAGE(PG8_SB(1, 1), b3 + hstepB, voffB); PG8_STAGE_A(PG8_SA(1, 0), a3, 0, vgc);
            PG8_WAIT_V(8); PG8_WAIT_L(0); PG8_BAR; PG8_MMA(1, 0, At, B0); PG8_MMA(1, 1, At, B1); PG8_BAR; PG8_SCHED;
        }
        if constexpr (ALIGN_EPI) { if (wr == 0) PG8_BAR; }
        E(acc, cur, wr, wc, fr, fq);
        if (!has_next) break;
#pragma unroll
        for (int a = 0; a < 2; ++a)
#pragma unroll
            for (int b = 0; b < 2; ++b)
#pragma unroll
                for (int m = 0; m < 4; ++m)
#pragma unroll
                    for (int n = 0; n < 2; ++n) acc[a][b][m][n] = (f32x4){0.f, 0.f, 0.f, 0.f};
        cur = nxt; cA = nA; cB = nB; ++ui;

        if constexpr (ALIGN_EPI) { if (wr == 1) PG8_BAR; }
    }
    PG8_WAIT_V(0);
    if constexpr (!ALIGN_EPI) { if (wr == 0) PG8_BAR; }
    PG8_BAR;
#undef PG8_SA
#undef PG8_SB
#undef PG8_STAGE
#undef PG8_STAGE_A
#undef PG8_GOFF
#undef PG8_LDA
#undef PG8_LDB
#undef PG8_MMA
#undef PG8_WAIT_V
#undef PG8_WAIT_L
#undef PG8_BAR
#undef PG8_SCHED
}
}
__device__ __forceinline__ void p0_transpose_item(const float* __restrict__ W, int K, int N, bf16_t* WT, int row_off, LAS float* scr, int kb, int nb, int lane, const float* __restrict__ kscale) {
    const int k0 = 64 * kb, n0 = 32 * nb;
#pragma unroll 8
    for (int i = 0; i < 32; ++i) { const int kk = 2 * i + (lane >> 5); float w = W[(size_t)(k0 + kk) * N + n0 + (lane & 31)]; if (kscale) w *= kscale[k0 + kk]; scr[kk * 33 + (lane & 31)] = w; }
    LDS_WAIT(); asm volatile("" ::: "memory");
    const int c = lane & 7;
#pragma unroll
    for (int j = 0; j < 4; ++j) { const int n = (lane >> 3) + 8 * j; const LAS float* s = scr + (8 * c) * 33 + n;
        u32x4 o; o.x = pk2(s[0 * 33], s[1 * 33]); o.y = pk2(s[2 * 33], s[3 * 33]); o.z = pk2(s[4 * 33], s[5 * 33]); o.w = pk2(s[6 * 33], s[7 * 33]);
        *(u32x4*)(WT + (size_t)(row_off + n0 + n) * K + k0 + 8 * c) = o; }
    LDS_WAIT(); asm volatile("" ::: "memory");
}
__device__ __forceinline__ void p0_convert(const float* W, int K, int N, bf16_t* WT, LAS float* scr, int gw, int NGW, int lane, const float* kscale, int rowmap) {
    const int nblk = N / 32, nitems = (K / 64) * nblk;
    for (int it = gw; it < nitems; it += NGW) { const int kb = it / nblk, nb = it % nblk; int row_off = 0;
        if (rowmap == 1) { const int c0 = nb * 32; const int cc = (c0 < 256) ? c0 : c0 - 256; const int pn = cc >> 7, j = (cc & 127) + ((c0 < 256) ? 0 : 128); row_off = (256 * pn + j) - c0; }
        p0_transpose_item(W, K, N, WT, row_off, scr, kb, nb, lane, kscale); }
}
__device__ __forceinline__ void p0_zero_rows(bf16_t* WT, int K, int r0, int r1, int gtid, int NGT) {
    const size_t n16 = (size_t)(r1 - r0) * K * 2 / 16; u32x4* p = (u32x4*)(WT + (size_t)r0 * K);
    for (size_t i = gtid; i < n16; i += NGT) p[i] = (u32x4){0u, 0u, 0u, 0u};
}
struct P0Args { const float *x, *w_in, *qn_w, *kvn_w, *w_uq, *w_ukv, *w_out; unsigned char* ws; };
__device__ __forceinline__ void p0_experts(const float* wgu_l, const float* wd_l, unsigned char* ws, LAS float* scr, int gw, int NGW, int lane) {
    for (int e = 0; e < NEXP; ++e) {
        p0_convert(wgu_l + (size_t)e * DM * 512, DM, 512, (bf16_t*)(ws + WS_WGU) + (size_t)e * 512 * DM, scr, gw, NGW, lane, nullptr, 1);
        p0_convert(wd_l + (size_t)e * DEXP * DM, DEXP, DM, (bf16_t*)(ws + WS_WD) + (size_t)e * DM * DEXP, scr, gw, NGW, lane, nullptr, 0);
    }
}
__device__ __forceinline__ void p0_all(const P0Args& a, LAS unsigned char* lds, int vcu, int G) {
    const int tid = tidx(), lane = tid & 63, wave = tid >> 6;
    LAS float* scr = (LAS float*)(lds + wave * 16384);
    const int gw = vcu * 8 + wave, NGW = G * 8, gtid = vcu * 512 + tid, NGT = G * 512;
    for (int l = 0; l < DEPTH; ++l) {
        bf16_t* win_t = (bf16_t*)(a.ws + WS_WIN) + (size_t)l * NPP * DM;
        p0_convert(a.w_in + (size_t)l * DM * NP, DM, NP, win_t, scr, gw, NGW, lane, nullptr, 0);
        p0_zero_rows(win_t, DM, NP, NPP, gtid, NGT);
        bf16_t* wuq_t = (bf16_t*)(a.ws + WS_WUQ) + (size_t)l * NQMP * 384;
        p0_convert(a.w_uq + (size_t)l * 384 * NQM, 384, NQM, wuq_t, scr, gw, NGW, lane, a.qn_w + l * 384, 0);
        p0_zero_rows(wuq_t, 384, NQM, NQMP, gtid, NGT);
        p0_convert(a.w_ukv + (size_t)l * 256 * NKVM, 256, NKVM, (bf16_t*)(a.ws + WS_WUKV) + (size_t)l * NKVM * 256, scr, gw, NGW, lane, a.kvn_w + l * 256, 0);
        p0_convert(a.w_out + (size_t)l * DM * DM, DM, DM, (bf16_t*)(a.ws + WS_WOUT) + (size_t)l * DM * DM, scr, gw, NGW, lane, nullptr, 0);
    }
    { const f32x4* xs = (const f32x4*)a.x; u32x2* xb = (u32x2*)(a.ws + WS_R0); const size_t n4 = (size_t)TOK * DM / 4;
      for (size_t i = gtid; i < n4; i += NGT) { const f32x4 v = xs[i]; u32x2 o; o.x = pk2(v[0], v[1]); o.y = pk2(v[2], v[3]); xb[i] = o; } }
    { float2* tr = (float2*)(a.ws + WS_TABR); float2* tm = (float2*)(a.ws + WS_TABM);
      for (int idx = gtid; idx < SEQ * 32; idx += NGT) { const int pos = idx >> 5, i = idx & 31;
          const float invf = (float)exp(-log(10000.0) * (double)(2 * i) / 64.0); const double ang = (double)((float)pos * invf);
          tr[idx] = make_float2((float)cos(ang), (float)sin(ang)); }
      for (int idx = gtid; idx < SEQ * 16; idx += NGT) { const int pos = idx >> 4, i = idx & 15;
          const float invf = (float)exp(-log(10000.0) * (double)(2 * i) / 32.0); const double ang = (double)((float)pos * invf);
          tm[idx] = make_float2((float)cos(ang), (float)sin(ang)); } }
}
namespace att {
__device__ __forceinline__ int crow(int r, int hi) { return (r & 3) + 8 * (r >> 2) + 4 * hi; }
#define ATT_SBAR() __builtin_amdgcn_sched_barrier(0)
#define ATT_WAIT_BAR0() asm volatile("s_waitcnt vmcnt(0) lgkmcnt(0)\n\ts_barrier" ::: "memory")
constexpr int KSLOT = 12288, VSLOT = 8192;
constexpr int LDS_K = 0, LDS_V = 2 * KSLOT, LDS_WS = LDS_V + 2 * VSLOT, LDS_OST = LDS_WS + 8 * 256, LDS_BYTES = LDS_OST + 8 * 4096;
__device__ __forceinline__ void glds16(const void* gsrc, unsigned lds_dst) { unsigned keep;
  asm volatile("s_mov_b32 %0, m0\n\ts_mov_b32 m0, %2\n\ts_nop 0\n\tglobal_load_lds_dwordx4 %1, off\n\ts_mov_b32 m0, %0" : "=&s"(keep) : "v"(gsrc), "s"(lds_dst) : "memory"); }
__device__ __forceinline__ float max3f(float a, float b, float c) { float r; asm("v_max3_f32 %0, %1, %2, %3" : "=v"(r) : "v"(a), "v"(b), "v"(c)); return r; }
__device__ __forceinline__ float rowmax(const f32x16& p0, const f32x16& p1) {
  float a = max3f(p0[0], p0[1], p1[0]), b = max3f(p0[2], p0[3], p1[1]); a = max3f(a, p1[2], p1[3]);
#pragma unroll
  for (int r = 4; r < 16; r += 4) { a = max3f(a, p0[r], p0[r + 1]); b = max3f(b, p0[r + 2], p0[r + 3]); a = max3f(a, p1[r], p1[r + 1]); b = max3f(b, p1[r + 2], p1[r + 3]); }
  const float m = fmaxf(a, b);
  auto rr = __builtin_amdgcn_permlane32_swap(__float_as_uint(m), __float_as_uint(m), false, false);
  return fmaxf(__uint_as_float(rr[0]), __uint_as_float(rr[1]));
}
template <int NCH>
__device__ __forceinline__ void qkt(f32x16& p0, f32x16& p1, const LAS char* Kslot, const bf16x8* qr, int r32, int hi) {
  const LAS char* kb = Kslot + hi * 1024 + r32 * 16;
#pragma unroll
  for (int d0 = 0; d0 < NCH; ++d0) {
    const bf16x8 b0 = *(const LAS bf16x8*)(kb + d0 * 2048);
    const bf16x8 b1 = *(const LAS bf16x8*)(kb + d0 * 2048 + 512);
    p0 = __builtin_amdgcn_mfma_f32_32x32x16_bf16(b0, qr[d0], p0, 0, 0, 0);
    p1 = __builtin_amdgcn_mfma_f32_32x32x16_bf16(b1, qr[d0], p1, 0, 0, 0);
  }
}
typedef short s16x4 __attribute__((ext_vector_type(4)));
__device__ __forceinline__ void pv(f32x16* o, int vb, bf16x8 pa0, bf16x8 pa1, bf16x8 pa2, bf16x8 pa3) {
#pragma unroll
  for (int d0 = 0; d0 < 2; ++d0) { s16x4 lo[4], hi[4];
#pragma unroll
    for (int ks = 0; ks < 4; ++ks) {
      asm volatile("ds_read_b64_tr_b16 %0,%1 offset:%c2" : "=&v"(lo[ks]) : "v"(vb), "i"(d0 * 4096 + ks * 1024) : "memory");
      asm volatile("ds_read_b64_tr_b16 %0,%1 offset:%c2" : "=&v"(hi[ks]) : "v"(vb), "i"(d0 * 4096 + ks * 1024 + 512) : "memory"); }
    asm volatile("s_waitcnt lgkmcnt(0)" ::: "memory"); ATT_SBAR();
#define ATT_PK(k) (bf16x8){lo[k][0], lo[k][1], lo[k][2], lo[k][3], hi[k][0], hi[k][1], hi[k][2], hi[k][3]}
    o[d0] = __builtin_amdgcn_mfma_f32_32x32x16_bf16(pa0, ATT_PK(0), o[d0], 0, 0, 0);
    o[d0] = __builtin_amdgcn_mfma_f32_32x32x16_bf16(pa1, ATT_PK(1), o[d0], 0, 0, 0);
    o[d0] = __builtin_amdgcn_mfma_f32_32x32x16_bf16(pa2, ATT_PK(2), o[d0], 0, 0, 0);
    o[d0] = __builtin_amdgcn_mfma_f32_32x32x16_bf16(pa3, ATT_PK(3), o[d0], 0, 0, 0);
#undef ATT_PK
  }
}
struct AttnPtrs { const bf16_t* proj; const bf16_t* qm; const bf16_t* kvm; const bf16_t* kpe; const float2* tabm; const float* sinks; bf16_t* concat; };

template <int MODE>
__device__ __forceinline__ void attn_unit(const AttnPtrs& P, int b, int h, int qb, LAS char* shm) {
  constexpr int NCH = (MODE == 0) ? 6 : 4;
  const int tid = tidx(), lane = tid & 63, r32 = lane & 31, hi = lane >> 5; const int wid = __builtin_amdgcn_readfirstlane(tid >> 6);
  const long rowbase = (long)b * SEQ; const int q0 = qb * 256;
  const unsigned lds0 = (unsigned)(uintptr_t)shm;
  LAS float* wsf = (LAS float*)(shm + LDS_WS) + wid * 64;
  const bf16_t *Qp, *Kp, *Vp; int ldq, ldk; bf16_t* Op;
  if (MODE == 0) { Qp = P.qm + h * 96; ldq = NQMP; Kp = P.kvm + h * 128; Vp = P.kvm + h * 128 + 64; ldk = NKVM; Op = P.concat + 640 + h * 64; }
  else { Qp = P.proj + O_SQ + h * 64; ldq = NPP; Kp = P.proj + O_SK + (h / 3) * 64; Vp = P.proj + O_SV + (h / 3) * 64; ldk = NPP; Op = P.concat + 256 + h * 64; }
  const bf16_t* ksrc = Kp + (rowbase + lane) * ldk + wid * 8;
  const bf16_t* krsrc = P.kpe + (rowbase + lane) * 32 + (wid & 3) * 8;
  const bf16_t* vsrc = Vp + (rowbase + 16 * (wid & 3) + (lane >> 2)) * ldk + (wid >> 2) * 32 + (lane & 3) * 8;
  const unsigned kdst = lds0 + LDS_K + wid * 1024, krdst = lds0 + LDS_K + (8 + (wid & 3)) * 1024, vdst = lds0 + LDS_V + wid * 1024;
#define ATT_DMA(t, s) do { glds16(ksrc + (long)(t) * 64 * ldk, (unsigned)__builtin_amdgcn_readfirstlane(kdst + (s) * KSLOT)); \
    if (MODE == 0 && wid < 4) glds16(krsrc + (long)(t) * 64 * 32, (unsigned)__builtin_amdgcn_readfirstlane(krdst + (s) * KSLOT)); \
    glds16(vsrc + (long)(t) * 64 * ldk, (unsigned)__builtin_amdgcn_readfirstlane(vdst + (s) * VSLOT)); } while (0)
  const int vb0 = (int)(lds0 + LDS_V) + ((lane >> 4) & 1) * 32 + (lane & 3) * 8 + (4 * hi + ((lane & 15) >> 2)) * 64;
  int t_lo, t_hi;
  if (MODE == 0) { t_lo = 0; t_hi = (q0 + 256) / 64; } else { t_lo = q0 / 64 - 2; if (t_lo < 0) t_lo = 0; t_hi = q0 / 64 + 4; }
  ATT_DMA(t_lo, 0);
  const int qpos = q0 + wid * 32 + r32;
  bf16x8 qr[NCH];
  { const float c2 = (MODE == 0 ? 0.10206207261596575f : 0.125f) * LOG2E;
    const bf16_t* qrow = Qp + (rowbase + qpos) * ldq + hi * 8;
    float qf[NCH][8];
#pragma unroll
    for (int d0 = 0; d0 < NCH; ++d0) { const bf16x8 v = *reinterpret_cast<const bf16x8*>(qrow + d0 * 16);
#pragma unroll
      for (int j = 0; j < 8; ++j) qf[d0][j] = bf2f((bf16_t)v[j]); }
    if (MODE == 0) {
      const float2* tb = P.tabm + qpos * 16 + hi * 8;
#pragma unroll
      for (int j = 0; j < 8; ++j) { const float2 cs = tb[j]; const float x1 = qf[NCH - 2][j], x2 = qf[NCH - 1][j]; qf[NCH - 2][j] = x1 * cs.x - x2 * cs.y; qf[NCH - 1][j] = x1 * cs.y + x2 * cs.x; }
    }
#pragma unroll
    for (int d0 = 0; d0 < NCH; ++d0) { u32x4 w; w.x = cvt_pk_bf16(qf[d0][0] * c2, qf[d0][1] * c2); w.y = cvt_pk_bf16(qf[d0][2] * c2, qf[d0][3] * c2); w.z = cvt_pk_bf16(qf[d0][4] * c2, qf[d0][5] * c2); w.w = cvt_pk_bf16(qf[d0][6] * c2, qf[d0][7] * c2);
      qr[d0] = __builtin_bit_cast(bf16x8, w); }
  }
  float m_run, l_run;
  if (MODE == 0) { m_run = -1e30f; l_run = 0.f; } else { m_run = P.sinks[h] * LOG2E; l_run = (hi == 0) ? 1.f : 0.f; }
  f32x16 o[2]; o[0] = f32x16{}; o[1] = f32x16{};
  const int qw0 = q0 + wid * 32;
  ATT_WAIT_BAR0();
  for (int t = t_lo; t < t_hi; ++t) {
    const int s = (t - t_lo) & 1;
    if (t + 1 < t_hi) ATT_DMA(t + 1, s ^ 1);
    const int k0 = t * 64;
    bool active, need_mask;
    if (MODE == 0) { active = (k0 <= qw0 + 31); need_mask = (k0 + 63 > qw0); }
    else { active = (k0 <= qw0 + 31) && (k0 + 63 >= qw0 - 127); need_mask = (k0 + 63 > qw0) || (k0 < qw0 + 31 - 127); }
    if (active) {
      f32x16 p0 = f32x16{}, p1 = f32x16{};
      qkt<NCH>(p0, p1, shm + LDS_K + s * KSLOT, qr, r32, hi);
      if (need_mask) {
#pragma unroll
        for (int r = 0; r < 16; ++r) { const int kv = k0 + crow(r, hi);
          bool bad0 = kv > qpos, bad1 = kv + 32 > qpos;
          if (MODE == 1) { bad0 = bad0 || (kv < qpos - 127); bad1 = bad1 || (kv + 32 < qpos - 127); }
          if (bad0) p0[r] = -1e30f; if (bad1) p1[r] = -1e30f; }
      }
      const float rm = rowmax(p0, p1);
      const float mn = fmaxf(m_run, rm);
      const float alpha = __builtin_amdgcn_exp2f(m_run - mn);
      m_run = mn;
      float psum = 0.f;
#pragma unroll
      for (int r = 0; r < 16; ++r) { p0[r] = __builtin_amdgcn_exp2f(p0[r] - mn); p1[r] = __builtin_amdgcn_exp2f(p1[r] - mn); psum += p0[r] + p1[r]; }
      l_run = l_run * alpha + psum;
      if (hi == 0) wsf[r32] = alpha;
      asm volatile("s_waitcnt lgkmcnt(0)" ::: "memory");
#pragma unroll
      for (int r = 0; r < 16; ++r) { const float f = wsf[crow(r, hi)]; o[0][r] *= f; o[1][r] *= f; }
      u32x4 pw0, pw1, pw2, pw3;
      pw0 = (u32x4){cvt_pk_bf16(p0[0], p0[1]), cvt_pk_bf16(p0[2], p0[3]), cvt_pk_bf16(p0[4], p0[5]), cvt_pk_bf16(p0[6], p0[7])};
      pw1 = (u32x4){cvt_pk_bf16(p0[8], p0[9]), cvt_pk_bf16(p0[10], p0[11]), cvt_pk_bf16(p0[12], p0[13]), cvt_pk_bf16(p0[14], p0[15])};
      pw2 = (u32x4){cvt_pk_bf16(p1[0], p1[1]), cvt_pk_bf16(p1[2], p1[3]), cvt_pk_bf16(p1[4], p1[5]), cvt_pk_bf16(p1[6], p1[7])};
      pw3 = (u32x4){cvt_pk_bf16(p1[8], p1[9]), cvt_pk_bf16(p1[10], p1[11]), cvt_pk_bf16(p1[12], p1[13]), cvt_pk_bf16(p1[14], p1[15])};
      asm volatile("s_waitcnt lgkmcnt(0)" ::: "memory"); ATT_SBAR();
      pv(o, vb0 + s * VSLOT, __builtin_bit_cast(bf16x8, pw0), __builtin_bit_cast(bf16x8, pw1), __builtin_bit_cast(bf16x8, pw2), __builtin_bit_cast(bf16x8, pw3));
    }
    ATT_WAIT_BAR0();
  }
  { auto rr = __builtin_amdgcn_permlane32_swap(__float_as_uint(l_run), __float_as_uint(l_run), false, false); l_run = __uint_as_float(rr[0]) + __uint_as_float(rr[1]); }
  if (hi == 0) wsf[32 + r32] = l_run;
  asm volatile("s_waitcnt lgkmcnt(0)" ::: "memory");
  float rli[16];
#pragma unroll
  for (int r = 0; r < 16; ++r) rli[r] = 1.0f / wsf[32 + crow(r, hi)];
  bf16_t* Ow = Op + (rowbase + q0 + wid * 32) * DM;
  { LAS bf16_t* stg = (LAS bf16_t*)(shm + LDS_OST) + wid * 2048;
#pragma unroll
    for (int r = 0; r < 16; ++r) { const int orow = crow(r, hi);
#pragma unroll
      for (int d0 = 0; d0 < 2; ++d0) stg[orow * 64 + d0 * 32 + r32] = (bf16_t)f2bf(o[d0][r] * rli[r]); }
    asm volatile("s_waitcnt lgkmcnt(0)" ::: "memory");
#pragma unroll
    for (int i = 0; i < 4; ++i) { const int row = i * 8 + (lane >> 3), ch = lane & 7; const u32x4 v = *(const LAS u32x4*)(stg + row * 64 + ch * 8); *(u32x4*)(Ow + (long)row * DM + ch * 8) = v; } }
  asm volatile("s_waitcnt lgkmcnt(0)\n\ts_barrier" ::: "memory");
#undef ATT_DMA
}
}
namespace ret {
using att::crow; using att::glds16; using att::qkt; using att::pv; using att::s16x4;
struct RetPtrs { const bf16_t* proj; const float2* tabr; const float* gn_w; float* U; bf16_t* concat; };
constexpr int R_V = 0, R_K = 32768, R_ST = 65536, R_STG = 0;
constexpr int ST_PITCH = 72;
__device__ __forceinline__ float gamma_log2(int h) { return log2f(1.0f - exp2f(-5.0f - (float)h)); }

__device__ __forceinline__ void dma_v4(const RetPtrs& P, int b, int h, int cp, unsigned lds0, int wid, int lane) {
  const bf16_t* vsrc = P.proj + ((long)b * SEQ + 256 * cp + 16 * (wid & 3) + (lane >> 2)) * NPP + O_RV + h * 64 + (wid >> 2) * 32 + (lane & 3) * 8;
#pragma unroll
  for (int tt = 0; tt < 4; ++tt) glds16(vsrc + (long)tt * 64 * NPP, (unsigned)__builtin_amdgcn_readfirstlane(lds0 + R_V + tt * 8192 + wid * 1024));
}
__device__ __forceinline__ bf16x8 tr_frag(int vb, int off) { s16x4 lo, hi;
  asm volatile("ds_read_b64_tr_b16 %0,%1" : "=&v"(lo) : "v"(vb + off) : "memory");
  asm volatile("ds_read_b64_tr_b16 %0,%1" : "=&v"(hi) : "v"(vb + off + 512) : "memory");
  asm volatile("s_waitcnt lgkmcnt(0)" : "+v"(lo), "+v"(hi) :: "memory");
  return (bf16x8){lo[0], lo[1], lo[2], lo[3], hi[0], hi[1], hi[2], hi[3]}; }

__device__ __forceinline__ void upd_unit(const RetPtrs& P, int b, int h, int cp, LAS char* shm) {
  const int tid = tidx(), lane = tid & 63, hi = lane >> 5; const int wid = __builtin_amdgcn_readfirstlane(tid >> 6);
  const unsigned lds0 = (unsigned)(uintptr_t)shm;
  const float lg = gamma_log2(h);
  dma_v4(P, b, h, cp, lds0, wid, lane);
#pragma unroll
  for (int it = 0; it < 2; ++it) { const int item = tid + 512 * it, row = item >> 2, c = item & 3; const int pos = 256 * cp + row;
    const bf16_t* src = P.proj + ((long)b * SEQ + pos) * NPP + O_RK + h * 64 + 8 * c;
    const bf16x8 lo = *(const bf16x8*)src, hi8 = *(const bf16x8*)(src + 32);
    const float2* tb = P.tabr + pos * 32 + 8 * c;
    const float sc = 0.125f * exp2f(lg * (float)(127 - (row & 127)));
    float y1[8], y2[8];
#pragma unroll
    for (int j = 0; j < 8; ++j) { const float2 cs = tb[j]; const float x1 = bf2f((bf16_t)lo[j]), x2 = bf2f((bf16_t)hi8[j]); y1[j] = (x1 * cs.x - x2 * cs.y) * sc; y2[j] = (x1 * cs.y + x2 * cs.x) * sc; }
    u32x4 w1, w2; w1.x = cvt_pk_bf16(y1[0], y1[1]); w1.y = cvt_pk_bf16(y1[2], y1[3]); w1.z = cvt_pk_bf16(y1[4], y1[5]); w1.w = cvt_pk_bf16(y1[6], y1[7]);
    w2.x = cvt_pk_bf16(y2[0], y2[1]); w2.y = cvt_pk_bf16(y2[2], y2[3]); w2.z = cvt_pk_bf16(y2[4], y2[5]); w2.w = cvt_pk_bf16(y2[6], y2[7]);
    LAS char* dst = shm + R_K + (row >> 6) * 8192 + (row & 63) * 64 + c * 16;
    *(LAS u32x4*)dst = w1; *(LAS u32x4*)(dst + 4096) = w2; }
  asm volatile("s_waitcnt vmcnt(0) lgkmcnt(0)\n\ts_barrier" ::: "memory");
  const int wg = wid >> 2, dt = (wid >> 1) & 1, et = wid & 1;
  const int vbl = ((lane >> 4) & 1) * 32 + (lane & 3) * 8 + (4 * hi + ((lane & 15) >> 2)) * 64;
  f32x16 acc = f32x16{};
#pragma unroll
  for (int tt = 0; tt < 2; ++tt) { const int tile = 2 * wg + tt;
#pragma unroll
    for (int ks = 0; ks < 4; ++ks) { const bf16x8 a = tr_frag((int)lds0 + R_K + tile * 8192 + vbl, dt * 4096 + ks * 1024), bb = tr_frag((int)lds0 + R_V + tile * 8192 + vbl, et * 4096 + ks * 1024);
      acc = __builtin_amdgcn_mfma_f32_32x32x16_bf16(a, bb, acc, 0, 0, 0); } }
  float* Uo = P.U + ((size_t)((b * 4 + h) * 64 + 2 * cp + wg)) * 4096 + (32 * dt) * 64 + 32 * et + (lane & 31);
#pragma unroll
  for (int r = 0; r < 16; ++r) Uo[crow(r, hi) * 64] = acc[r];
  asm volatile("s_waitcnt lgkmcnt(0)\n\ts_barrier" ::: "memory");
}

__device__ __forceinline__ void out_unit(const RetPtrs& P, int b, int h, int cp, LAS char* shm) {
  const int tid = tidx(), lane = tid & 63, r32 = lane & 31, hi = lane >> 5; const int wid = __builtin_amdgcn_readfirstlane(tid >> 6);
  const unsigned lds0 = (unsigned)(uintptr_t)shm;
  const float lg = gamma_log2(h);
  const long rowbase = (long)b * SEQ;
  dma_v4(P, b, h, cp, lds0, wid, lane);
#pragma unroll
  for (int it = 0; it < 2; ++it) { const int item = tid + 512 * it, row = item >> 2, c = item & 3; const int pos = 256 * cp + row;
    const bf16_t* src = P.proj + (rowbase + pos) * NPP + O_RK + h * 64 + 8 * c;
    const bf16x8 lo = *(const bf16x8*)src, hi8 = *(const bf16x8*)(src + 32);
    const float2* tb = P.tabr + pos * 32 + 8 * c;
    float y1[8], y2[8];
#pragma unroll
    for (int j = 0; j < 8; ++j) { const float2 cs = tb[j]; const float x1 = bf2f((bf16_t)lo[j]), x2 = bf2f((bf16_t)hi8[j]); y1[j] = (x1 * cs.x - x2 * cs.y) * 0.125f; y2[j] = (x1 * cs.y + x2 * cs.x) * 0.125f; }
    u32x4 w1, w2; w1.x = cvt_pk_bf16(y1[0], y1[1]); w1.y = cvt_pk_bf16(y1[2], y1[3]); w1.z = cvt_pk_bf16(y1[4], y1[5]); w1.w = cvt_pk_bf16(y1[6], y1[7]);
    w2.x = cvt_pk_bf16(y2[0], y2[1]); w2.y = cvt_pk_bf16(y2[2], y2[3]); w2.z = cvt_pk_bf16(y2[4], y2[5]); w2.w = cvt_pk_bf16(y2[6], y2[7]);
    LAS char* dst = shm + R_K + (row >> 6) * 8192 + c * 1024 + (row & 63) * 16;
    *(LAS u32x4*)dst = w1; *(LAS u32x4*)(dst + 4096) = w2; }
  { const int n0 = 2 * cp; const float cd = exp2f(lg * 128.0f);
    const float* Ub = P.U + (size_t)((b * 4 + h) * 64) * 4096 + tid * 8;
    f32x4 s0a = (f32x4){0.f, 0.f, 0.f, 0.f}, s0b = s0a;
    for (int m = 0; m < n0; ++m) { const f32x4 ua = *(const f32x4*)(Ub + (size_t)m * 4096), ub = *(const f32x4*)(Ub + (size_t)m * 4096 + 4); s0a = s0a * cd + ua; s0b = s0b * cd + ub; }
    const f32x4 ua = *(const f32x4*)(Ub + (size_t)n0 * 4096), ub = *(const f32x4*)(Ub + (size_t)n0 * 4096 + 4);
    const f32x4 s1a = s0a * cd + ua, s1b = s0b * cd + ub;
    const int d = tid >> 3, e0 = (tid & 7) * 8;
    LAS bf16_t* st0 = (LAS bf16_t*)(shm + R_ST), * st1 = st0 + 64 * ST_PITCH;
#pragma unroll
    for (int j = 0; j < 4; ++j) { st0[(e0 + j) * ST_PITCH + d] = (bf16_t)f2bf(s0a[j]); st0[(e0 + 4 + j) * ST_PITCH + d] = (bf16_t)f2bf(s0b[j]);
      st1[(e0 + j) * ST_PITCH + d] = (bf16_t)f2bf(s1a[j]); st1[(e0 + 4 + j) * ST_PITCH + d] = (bf16_t)f2bf(s1b[j]); } }
  const int wg = wid >> 2; const int qi = (wid & 3) * 32 + r32;
  const int qpos = 256 * cp + 128 * wg + qi;
  bf16x8 qr[4], qx[4];
  { const bf16_t* qrow = P.proj + (rowbase + qpos) * NPP + O_RQ + h * 64 + hi * 8;
    float qf[4][8];
#pragma unroll
    for (int d0 = 0; d0 < 4; ++d0) { const bf16x8 v = *(const bf16x8*)(qrow + d0 * 16);
#pragma unroll
      for (int j = 0; j < 8; ++j) qf[d0][j] = bf2f((bf16_t)v[j]); }
#pragma unroll
    for (int d0 = 0; d0 < 2; ++d0) { const float2* tb = P.tabr + qpos * 32 + 16 * d0 + 8 * hi;
#pragma unroll
      for (int j = 0; j < 8; ++j) { const float2 cs = tb[j]; const float x1 = qf[d0][j], x2 = qf[d0 + 2][j]; qf[d0][j] = x1 * cs.x - x2 * cs.y; qf[d0 + 2][j] = x1 * cs.y + x2 * cs.x; } }
    const float xi = exp2f(lg * (float)(qi + 1));
#pragma unroll
    for (int d0 = 0; d0 < 4; ++d0) { u32x4 w, x;
      w.x = cvt_pk_bf16(qf[d0][0], qf[d0][1]); w.y = cvt_pk_bf16(qf[d0][2], qf[d0][3]); w.z = cvt_pk_bf16(qf[d0][4], qf[d0][5]); w.w = cvt_pk_bf16(qf[d0][6], qf[d0][7]);
      x.x = cvt_pk_bf16(qf[d0][0] * xi, qf[d0][1] * xi); x.y = cvt_pk_bf16(qf[d0][2] * xi, qf[d0][3] * xi); x.z = cvt_pk_bf16(qf[d0][4] * xi, qf[d0][5] * xi); x.w = cvt_pk_bf16(qf[d0][6] * xi, qf[d0][7] * xi);
      qr[d0] = __builtin_bit_cast(bf16x8, w); qx[d0] = __builtin_bit_cast(bf16x8, x); } }
  asm volatile("s_waitcnt vmcnt(0) lgkmcnt(0)\n\ts_barrier" ::: "memory");
  f32x16 o[2]; o[0] = f32x16{}; o[1] = f32x16{};
  const int vb0 = (int)(lds0 + R_V) + ((lane >> 4) & 1) * 32 + (lane & 3) * 8 + (4 * hi + ((lane & 15) >> 2)) * 64;
#pragma unroll
  for (int tt = 0; tt < 2; ++tt) {
    if (tt * 64 <= (wid & 3) * 32 + 31) {
      const int tile = 2 * wg + tt;
      f32x16 p0 = f32x16{}, p1 = f32x16{};
      qkt<4>(p0, p1, shm + R_K + tile * 8192, qr, r32, hi);
#pragma unroll
      for (int r = 0; r < 16; ++r) { const int ki = tt * 64 + crow(r, hi);
        const float d0 = (qi >= ki) ? exp2f(lg * (float)(qi - ki)) : 0.f, d1 = (qi >= ki + 32) ? exp2f(lg * (float)(qi - ki - 32)) : 0.f;
        p0[r] *= d0; p1[r] *= d1; }
      u32x4 pw0, pw1, pw2, pw3;
      pw0 = (u32x4){cvt_pk_bf16(p0[0], p0[1]), cvt_pk_bf16(p0[2], p0[3]), cvt_pk_bf16(p0[4], p0[5]), cvt_pk_bf16(p0[6], p0[7])};
      pw1 = (u32x4){cvt_pk_bf16(p0[8], p0[9]), cvt_pk_bf16(p0[10], p0[11]), cvt_pk_bf16(p0[12], p0[13]), cvt_pk_bf16(p0[14], p0[15])};
      pw2 = (u32x4){cvt_pk_bf16(p1[0], p1[1]), cvt_pk_bf16(p1[2], p1[3]), cvt_pk_bf16(p1[4], p1[5]), cvt_pk_bf16(p1[6], p1[7])};
      pw3 = (u32x4){cvt_pk_bf16(p1[8], p1[9]), cvt_pk_bf16(p1[10], p1[11]), cvt_pk_bf16(p1[12], p1[13]), cvt_pk_bf16(p1[14], p1[15])};
      pv(o, vb0 + tile * 8192, __builtin_bit_cast(bf16x8, pw0), __builtin_bit_cast(bf16x8, pw1), __builtin_bit_cast(bf16x8, pw2), __builtin_bit_cast(bf16x8, pw3));
    }
  }
  { const LAS bf16_t* st = (const LAS bf16_t*)(shm + R_ST) + wg * 64 * ST_PITCH;
#pragma unroll
    for (int eb = 0; eb < 2; ++eb)
#pragma unroll
      for (int s = 0; s < 4; ++s) { const bf16x8 bfrag = *(const LAS bf16x8*)(st + (eb * 32 + r32) * ST_PITCH + 16 * s + 8 * hi);
        o[eb] = __builtin_amdgcn_mfma_f32_32x32x16_bf16(qx[s], bfrag, o[eb], 0, 0, 0); } }
  asm volatile("s_waitcnt lgkmcnt(0)\n\ts_barrier" ::: "memory");
  { LAS float* stg = (LAS float*)(shm + R_STG) + wid * (32 * 66);
#pragma unroll
    for (int r = 0; r < 16; ++r) { stg[crow(r, hi) * 66 + r32] = o[0][r]; stg[crow(r, hi) * 66 + 32 + r32] = o[1][r]; }
    asm volatile("s_waitcnt lgkmcnt(0)" ::: "memory");
    const int row = lane >> 1, half = lane & 1;
    float v[32]; float s1 = 0.f;
#pragma unroll
    for (int j = 0; j < 32; ++j) { v[j] = stg[row * 66 + half * 32 + j]; s1 += v[j]; }
    s1 += __shfl_xor(s1, 1);
    const float mu = s1 * (1.0f / 64.0f); float s2 = 0.f;
#pragma unroll
    for (int j = 0; j < 32; ++j) { v[j] -= mu; s2 += v[j] * v[j]; }
    s2 += __shfl_xor(s2, 1);
    const float rs = rsqrtf(s2 * (1.0f / 64.0f) + LN_EPS);
    const long grow = rowbase + 256 * cp + 128 * wg + (wid & 3) * 32 + row;
    const bf16_t* gp = P.proj + grow * NPP + O_RG + h * 64 + half * 32;
    const float* gw = P.gn_w + h * 64 + half * 32;
    bf16_t* op = P.concat + grow * DM + h * 64 + half * 32;
#pragma unroll
    for (int c = 0; c < 4; ++c) { const bf16x8 g8 = *(const bf16x8*)(gp + 8 * c); float ov[8];
#pragma unroll
      for (int j = 0; j < 8; ++j) { const float g = bf2f((bf16_t)g8[j]); const float silu = g / (1.0f + __expf(-g)); ov[j] = v[8 * c + j] * rs * gw[8 * c + j] * silu; }
      u32x4 w; w.x = cvt_pk_bf16(ov[0], ov[1]); w.y = cvt_pk_bf16(ov[2], ov[3]); w.z = cvt_pk_bf16(ov[4], ov[5]); w.w = cvt_pk_bf16(ov[6], ov[7]);
      *(u32x4*)(op + 8 * c) = w; } }
  asm volatile("s_waitcnt lgkmcnt(0)\n\ts_barrier" ::: "memory");
}
}
namespace moe {
constexpr int CAP = TOK;
struct MoePtrs { const float* Y; const float* ln_g; const float* ln_b; const float* router_w; const float* router_bias;
                 float* X1; bf16_t* X1B; unsigned* cnt; unsigned* list; float* gate; };

__device__ __forceinline__ void ln1_router_row(const MoePtrs& P, int row, int lane, const LAS float* rw4, LAS float* xs) {
  const f32x4* yr = (const f32x4*)(P.Y + (size_t)row * DM) + lane;
  f32x4 v[4]; float s = 0.f;
#pragma unroll
  for (int j = 0; j < 4; ++j) { v[j] = yr[64 * j]; s += (v[j][0] + v[j][1]) + (v[j][2] + v[j][3]); }
  const float mean = wave_sum(s) * (1.f / DM); float s2 = 0.f;
#pragma unroll
  for (int j = 0; j < 4; ++j) { v[j] = v[j] - mean; s2 += (v[j][0] * v[j][0] + v[j][1] * v[j][1]) + (v[j][2] * v[j][2] + v[j][3] * v[j][3]); }
  const float rstd = rsqrtf(wave_sum(s2) * (1.f / DM) + LN_EPS);
  f32x4* xo = (f32x4*)(P.X1 + (size_t)row * DM) + lane; u32x2* xb = (u32x2*)(P.X1B + (size_t)row * DM) + lane;
#pragma unroll
  for (int j = 0; j < 4; ++j) { const int c0 = 4 * lane + 256 * j;
    const f32x4 g = *(const f32x4*)(P.ln_g + c0), bb = *(const f32x4*)(P.ln_b + c0);
    const f32x4 x = v[j] * rstd * g + bb;
    xo[64 * j] = x; u32x2 o; o.x = pk2(x[0], x[1]); o.y = pk2(x[2], x[3]); xb[64 * j] = o;
    *(LAS f32x4*)(xs + c0) = x; }
  asm volatile("s_waitcnt lgkmcnt(0)" ::: "memory");
  const int e_l = lane & 15, kq = lane >> 4; float acc = 0.f;
#pragma unroll 8
  for (int i = 0; i < 64; ++i) { const f32x4 x = *(const LAS f32x4*)(xs + 16 * i + 4 * kq); const f32x4 w = *(const LAS f32x4*)(rw4 + ((4 * i + kq) * 16 + e_l) * 4);
    acc = fmaf(x[0], w[0], acc); acc = fmaf(x[1], w[1], acc); acc = fmaf(x[2], w[2], acc); acc = fmaf(x[3], w[3], acc); }
  acc += __shfl_xor(acc, 16); acc += __shfl_xor(acc, 32);
  float sc[16], bi[16];
#pragma unroll
  for (int e = 0; e < 16; ++e) { const float lg = __shfl(acc, e); sc[e] = 1.f / (1.f + expf(-lg)); bi[e] = sc[e] + P.router_bias[e]; }
  int bestg = 0; float bestgs = -INFINITY;
#pragma unroll
  for (int gI = 0; gI < 4; ++gI) { float m1 = -INFINITY, m2 = -INFINITY;
#pragma unroll
    for (int k = 0; k < 4; ++k) { const float x = bi[gI * 4 + k]; if (x > m1) { m2 = m1; m1 = x; } else if (x > m2) { m2 = x; } }
    const float gs = m1 + m2; if (gs > bestgs) { bestgs = gs; bestg = gI; } }
  int i1 = 0, i2 = 0; float m1 = -INFINITY, m2 = -INFINITY, s1 = 0.f, s2v = 0.f;
#pragma unroll
  for (int e = 0; e < 16; ++e) { if ((e >> 2) == bestg) { const float x = bi[e]; if (x > m1) { m2 = m1; i2 = i1; s2v = s1; m1 = x; i1 = e; s1 = sc[e]; } else if (x > m2) { m2 = x; i2 = e; s2v = sc[e]; } } }
  if (lane == 0) { const float inv = 1.f / (s1 + s2v);
    const unsigned p1 = atomicAdd(P.cnt + i1, 1u); P.list[(size_t)i1 * CAP + p1] = (unsigned)row * 2u; P.gate[(size_t)i1 * CAP + p1] = s1 * inv;
    const unsigned p2 = atomicAdd(P.cnt + i2, 1u); P.list[(size_t)i2 * CAP + p2] = (unsigned)row * 2u + 1u; P.gate[(size_t)i2 * CAP + p2] = s2v * inv; }
}
__device__ __forceinline__ void p5_phase(const MoePtrs& P, LAS char* shm, int vcu, int G) {
  const int tid = tidx(), lane = tid & 63, wave = tid >> 6;
  LAS float* rw4 = (LAS float*)shm; LAS float* xs = (LAS float*)(shm + 65536) + wave * 1024;
  for (int i = tid; i < DM * 16; i += 512) { const int k = i >> 4, e = i & 15; rw4[((k >> 2) * 16 + e) * 4 + (k & 3)] = P.router_w[i]; }
  __syncthreads();
  for (int row = vcu * 8 + wave; row < TOK; row += G * 8) ln1_router_row(P, row, lane, rw4, xs);
  __syncthreads();
}

template <int MODE>
struct MoeOrder {
  static constexpr int NPN = MODE == 0 ? 2 : 4, LDA2 = (MODE == 0 ? DM : DEXP) * 2;
  static constexpr size_t BSTRIDE_E = MODE == 0 ? (size_t)512 * DM * 2 : (size_t)DM * DEXP * 2, BSTRIDE_PN = MODE == 0 ? (size_t)256 * DM * 2 : (size_t)256 * DEXP * 2;
  const unsigned* __restrict__ cnt; const unsigned* __restrict__ list; const char* A; const char* Bt;
  __device__ __forceinline__ bool next(int i, pg8::Unit& u) const {
    const int L = i * (int)gridDim.x + (int)blockIdx.x; const int tile = L / NPN; u.pn = L % NPN; u.pm = tile;
    int acc = 0, e = -1, mt = 0, valid = 0;
#pragma unroll
    for (int k = 0; k < NEXP; ++k) { const int cn = __builtin_amdgcn_readfirstlane((int)cnt[k]); const int nt = (cn + 255) >> 8; if (e < 0 && tile < acc + nt) { e = k; mt = tile - acc; valid = cn - mt * 256; } acc += nt; }
    if (e < 0) return false;
    u.e = e; u.mt = mt; u.valid = valid > 256 ? 256 : valid; u.pad = 0;
    u.pA = MODE == 1 ? A + (size_t)tile * 256 * LDA2 : A;
    u.pB = Bt + (size_t)e * BSTRIDE_E + (size_t)u.pn * BSTRIDE_PN;
    return true;
  }
  __device__ __forceinline__ unsigned rowoff(const pg8::Unit& u, int r) const {
    unsigned slot = 0u; if (r < u.valid) slot = list[(size_t)u.e * CAP + u.mt * 256 + r];
    return (slot >> 1) * (unsigned)LDA2; }
};
struct EpiSwiglu {
  static constexpr bool PERM = true;
  bf16_t* A2; const float* gate;
  __device__ __forceinline__ void operator()(const f32x4 (&acc)[2][2][4][2], const pg8::Unit& u, int wr, int wc, int fr, int fq) const {
    { const int l_ = tidx() & 63; fr = l_ & 15; fq = l_ >> 4; }
    const int col0 = u.pn * 128 + wc * 32 + 8 * fq; const int lane = fq * 16 + fr;
    const int rb = wr * 64 + lane; const size_t gb = (size_t)u.e * CAP + u.mt * 256;
    float g0 = 0.f, g1 = 0.f; if (rb < u.valid) g0 = gate[gb + rb]; if (128 + rb < u.valid) g1 = gate[gb + 128 + rb];
#pragma unroll
    for (int ai = 0; ai < 2; ++ai)
#pragma unroll
      for (int m = 0; m < 4; ++m) { const int r = ai * 128 + wr * 64 + m * 16 + fr;
        const float g = __shfl(ai ? g1 : g0, m * 16 + fr);
        float a[8];
#pragma unroll
        for (int n = 0; n < 2; ++n)
#pragma unroll
          for (int i = 0; i < 4; ++i) { const float h1 = acc[ai][0][m][n][i], h2 = acc[ai][1][m][n][i]; a[4 * n + i] = h1 / (1.f + __expf(-h1)) * h2 * g; }
        u32x4 w; w.x = cvt_pk_bf16(a[0], a[1]); w.y = cvt_pk_bf16(a[2], a[3]); w.z = cvt_pk_bf16(a[4], a[5]); w.w = cvt_pk_bf16(a[6], a[7]);
        *(u32x4*)(A2 + ((size_t)u.pm * 256 + r) * 256 + col0) = w;
        asm volatile("" ::: "memory"); }
  }
};
struct EpiScatter {
  static constexpr bool PERM = true;
  bf16_t* YE; const unsigned* list;
  __device__ __forceinline__ void operator()(const f32x4 (&acc)[2][2][4][2], const pg8::Unit& u, int wr, int wc, int fr, int fq) const {
    { const int l_ = tidx() & 63; fr = l_ & 15; fq = l_ >> 4; }
    const int col0 = u.pn * 256 + wc * 32 + 8 * fq; const int lane = fq * 16 + fr;
    const int rb = wr * 64 + lane; const size_t gb = (size_t)u.e * CAP + u.mt * 256;
    unsigned s0 = (unsigned)(2 * TOK), s1 = (unsigned)(2 * TOK); if (rb < u.valid) s0 = list[gb + rb]; if (128 + rb < u.valid) s1 = list[gb + 128 + rb];
#pragma unroll
    for (int ai = 0; ai < 2; ++ai)
#pragma unroll
      for (int m = 0; m < 4; ++m) {
        const unsigned slot = (unsigned)__shfl((int)(ai ? s1 : s0), m * 16 + fr);
        { bf16_t* rowp = YE + (size_t)slot * DM + col0;
#pragma unroll
          for (int bj = 0; bj < 2; ++bj) { const f32x4 v0 = acc[ai][bj][m][0], v1 = acc[ai][bj][m][1];
            u32x4 w; w.x = cvt_pk_bf16(v0[0], v0[1]); w.y = cvt_pk_bf16(v0[2], v0[3]); w.z = cvt_pk_bf16(v1[0], v1[1]); w.w = cvt_pk_bf16(v1[2], v1[3]);
            *(u32x4*)(rowp + bj * 128) = w; } }
        asm volatile("" ::: "memory"); }
  }
};
struct Ln2Ptrs { const float* X1; const bf16_t* YE; const float* g; const float* b; float* out; bf16_t* XB; };
__device__ __forceinline__ void ln2_row(const Ln2Ptrs& P, int row, int lane) {
  const f32x4* xr = (const f32x4*)(P.X1 + (size_t)row * DM) + lane;
  const u32x2* y0 = (const u32x2*)(P.YE + (size_t)row * 2 * DM) + lane; const u32x2* y1 = y0 + DM / 4;
  f32x4 v[4]; float s = 0.f;
#pragma unroll
  for (int j = 0; j < 4; ++j) { const f32x4 x = xr[64 * j]; const u32x2 a = y0[64 * j], bq = y1[64 * j];
    f32x4 y; y[0] = __uint_as_float(a.x << 16) + __uint_as_float(bq.x << 16); y[1] = __uint_as_float(a.x & 0xffff0000u) + __uint_as_float(bq.x & 0xffff0000u);
    y[2] = __uint_as_float(a.y << 16) + __uint_as_float(bq.y << 16); y[3] = __uint_as_float(a.y & 0xffff0000u) + __uint_as_float(bq.y & 0xffff0000u);
    v[j] = x * ALPHA + y; s += (v[j][0] + v[j][1]) + (v[j][2] + v[j][3]); }
  const float mean = wave_sum(s) * (1.f / DM); float s2 = 0.f;
#pragma unroll
  for (int j = 0; j < 4; ++j) { v[j] = v[j] - mean; s2 += (v[j][0] * v[j][0] + v[j][1] * v[j][1]) + (v[j][2] * v[j][2] + v[j][3] * v[j][3]); }
  const float rstd = rsqrtf(wave_sum(s2) * (1.f / DM) + LN_EPS);
  f32x4* xo = (f32x4*)(P.out + (size_t)row * DM) + lane; u32x2* xb = (u32x2*)(P.XB + (size_t)row * DM) + lane;
#pragma unroll
  for (int j = 0; j < 4; ++j) { const int c0 = 4 * lane + 256 * j;
    const f32x4 g = *(const f32x4*)(P.g + c0), bb = *(const f32x4*)(P.b + c0);
    const f32x4 x = v[j] * rstd * g + bb;
    xo[64 * j] = x; u32x2 o; o.x = pk2(x[0], x[1]); o.y = pk2(x[2], x[3]); xb[64 * j] = o; }
}
}
constexpr int LDS_BYTES = 147456;
constexpr int NTHREADS = 512;
constexpr int MISC_OFF = 131072;
constexpr int CW_QCTR = 64;
constexpr int CW_CNT = 2048;
constexpr int CW_BAR = 4096;

typedef GAS unsigned gu32;
#define RLX_AGENT __ATOMIC_RELAXED, __HIP_MEMORY_SCOPE_AGENT
#define XB_TMO      128
#define XB_XCNT(j)  (256  + 64 * (j))
#define XB_XSUB(j)  (1280 + 64 * (j))
#define XB_XGEN(j)  (2304 + 64 * (j))
#define XB_TOP      3328
#define XB_TOPGEN   3392
#define XCD_BAR_WORDS 3456
#define XB_SPIN_CAP (1u << 20)
__device__ __forceinline__ unsigned xb_ld(gu32* p)              { return __hip_atomic_load(p, __ATOMIC_RELAXED, __HIP_MEMORY_SCOPE_AGENT); }
__device__ __forceinline__ unsigned xb_add(gu32* p, unsigned v) { return __hip_atomic_fetch_add(p, v, __ATOMIC_RELAXED, __HIP_MEMORY_SCOPE_AGENT); }
__device__ __forceinline__ unsigned xb_xcc_id() { return (unsigned)__builtin_amdgcn_s_getreg((3 << 11) | 20) & 0xFu; }
#define XB_SPIN(cond, bar) do { unsigned _sp = 0; while (cond) { __builtin_amdgcn_s_sleep(1); \
    if ((++_sp & 255u) == 0u) { if (xb_ld(&(bar)[XB_TMO])) break; if (_sp > XB_SPIN_CAP) { (void)xb_add(&(bar)[XB_TMO], 1u); break; } } } } while (0)
struct XcdBarrier { gu32* bar; unsigned x; volatile LAS unsigned* st; };
__device__ __forceinline__ XcdBarrier xcd_barrier_post(gu32* bar, volatile LAS unsigned* st) {
    XcdBarrier b; b.bar = bar; b.x = xb_xcc_id(); b.st = st;
    if (tidx() == 0) (void)xb_add(&bar[XB_XCNT(b.x)], 1u);
    return b;
}
__device__ __forceinline__ void xcd_barrier_complete(gu32* bar, unsigned x, unsigned& nloc, unsigned& nx) {
    const unsigned G = gridDim.x * gridDim.y * gridDim.z;
    unsigned sum, cnt, mine, sp = 0u;
    for (;;) {
        sum = 0u; cnt = 0u; mine = 0u;
#pragma unroll
        for (unsigned j = 0; j < 16; ++j) { const unsigned c = xb_ld(&bar[XB_XCNT(j)]); sum += c; cnt += (c > 0u) ? 1u : 0u; mine = (j == x) ? c : mine; }
        if (sum == G) break;
        __builtin_amdgcn_s_sleep(1);
        if ((++sp & 255u) == 0u) { if (xb_ld(&bar[XB_TMO])) break; if (sp > XB_SPIN_CAP) { (void)xb_add(&bar[XB_TMO], 1u); break; } }
    }
    nloc = mine > 0u ? mine : 1u; nx = cnt > 0u ? cnt : 1u;
}
__device__ __forceinline__ void xcd_barrier(const XcdBarrier& b) {
    asm volatile("s_waitcnt vmcnt(0)" ::: "memory");
    __syncthreads();
    if (tidx() == 0) {
        gu32* bar = b.bar; unsigned bx_ = b.x;
        asm volatile("" : "+s"(bar), "+s"(bx_));
        __builtin_amdgcn_s_waitcnt(0);
        unsigned nloc = b.st[0], nx = b.st[1];
        if (nloc == 0u) { xcd_barrier_complete(bar, bx_, nloc, nx); b.st[0] = nloc; b.st[1] = nx; }
        const unsigned old = xb_add(&bar[XB_XSUB(bx_)], 1u);
        const unsigned gen = old / nloc;
        if (old + 1u == (gen + 1u) * nloc) {
            __builtin_amdgcn_fence(__ATOMIC_RELEASE, "agent");
            asm volatile("s_waitcnt vmcnt(0)" ::: "memory");
            const unsigned og = xb_add(&bar[XB_TOP], 1u);
            const unsigned tg = og / nx;
            if (og + 1u == (tg + 1u) * nx) xb_add(&bar[XB_TOPGEN], 1u);
            else XB_SPIN(xb_ld(&bar[XB_TOPGEN]) == tg, bar);
            __builtin_amdgcn_fence(__ATOMIC_ACQUIRE, "agent");
            xb_add(&bar[XB_XGEN(bx_)], 1u);
            asm volatile("s_waitcnt vmcnt(0)" ::: "memory");
        } else {
            XB_SPIN(xb_ld(&bar[XB_XGEN(bx_)]) == gen, bar);
            __builtin_amdgcn_fence(__ATOMIC_ACQUIRE, "agent");
            asm volatile("s_waitcnt vmcnt(0)" ::: "memory");
        }
    }
    __syncthreads();
}

struct Args { const float* in[17]; float* out; unsigned char* ws; };
#define CAS __attribute__((address_space(4)))
__device__ __forceinline__ const CAS char* kargs() { const CAS char* kp = (const CAS char*)__builtin_amdgcn_kernarg_segment_ptr(); asm volatile("" : "+s"(kp)); return kp; }

__global__ void __launch_bounds__(NTHREADS, 2) mk_fwd(Args a) {
    extern __shared__ __attribute__((aligned(16))) unsigned char lds[];
    LAS unsigned char* L = (LAS unsigned char*)lds;
    LAS char* shm = (LAS char*)lds;
    volatile LAS unsigned* MISC = (volatile LAS unsigned*)(L + MISC_OFF);
#define lane (tidx() & 63)
#define wave (__builtin_amdgcn_readfirstlane(tidx() >> 6))
    const int G = gridDim.x, bx = blockIdx.x;
    const int vcu = (G % 8 == 0) ? (bx % 8) * (G / 8) + bx / 8 : bx;
    for (int u = tidx(); u < (LDS_BYTES - MISC_OFF) / 4; u += NTHREADS) ((LAS unsigned*)(L + MISC_OFF))[u] = 0u;
    __syncthreads();

#define KPTR(off, ET) ((ET*)(ET GAS*)(*(const unsigned long long CAS*)(kargs() + (off))))
#define IN_(i) KPTR(8 * (i), const float)
#define g_x_in IN_(0)
#define g_w_in IN_(1)
#define g_ret_gn_w IN_(2)
#define g_swa_sinks IN_(3)
#define g_qn_w IN_(4)
#define g_kvn_w IN_(5)
#define g_w_uq IN_(6)
#define g_w_ukv IN_(7)
#define g_w_out IN_(8)
#define g_ln1_g IN_(9)
#define g_ln1_b IN_(10)
#define g_router_w IN_(11)
#define g_router_bias IN_(12)
#define g_wgu IN_(13)
#define g_wd IN_(14)
#define g_ln2_g IN_(15)
#define g_ln2_b IN_(16)
#define g_out KPTR(136, float)
#define g_ws KPTR(144, unsigned char)
#define g_CTL ((unsigned*)(g_ws + WS_CTL))
#define g_XB ((bf16_t*)(g_ws + WS_R0))
#define g_PROJ ((bf16_t*)(g_ws + WS_R1))
#define g_Y ((float*)(g_ws + WS_R1))
#define g_QM ((bf16_t*)(g_ws + WS_QM))
#define g_KVM ((bf16_t*)(g_ws + WS_KVM))
#define g_KPE ((bf16_t*)(g_ws + WS_KPE))
#define g_CONCAT ((bf16_t*)(g_ws + WS_R3))
#define g_X1 ((float*)(g_ws + WS_X1))
#define g_TABR ((const float2*)(g_ws + WS_TABR))
#define g_TABM ((const float2*)(g_ws + WS_TABM))
#define g_X1B ((bf16_t*)(g_ws + WS_R0))
#define g_A2 ((bf16_t*)(g_ws + WS_A2))
#define g_YE ((bf16_t*)(g_ws + WS_YE))
#define g_list ((unsigned*)(g_ws + WS_LIST))
#define g_gate ((float*)(g_ws + WS_GATE))

    XcdBarrier bar = xcd_barrier_post((gu32*)(g_CTL + CW_BAR), MISC + 8);
#define GRID_BAR() xcd_barrier(bar)

    { P0Args pa; pa.x = g_x_in; pa.w_in = g_w_in; pa.qn_w = g_qn_w; pa.kvn_w = g_kvn_w; pa.w_uq = g_w_uq; pa.w_ukv = g_w_ukv; pa.w_out = g_w_out; pa.ws = g_ws;
      p0_all(pa, L, vcu, G);
      p0_experts(g_wgu, g_wd, g_ws, (LAS float*)(L + wave * 16384), vcu * 8 + wave, G * 8, lane); }
    GRID_BAR();

    for (int l = 0; l < DEPTH; ++l) {
        { pg8::Gemm g{g_XB, (const bf16_t*)(g_ws + WS_WIN) + (size_t)l * NPP * DM, DM, DM, DM, 0}; pg8::EpiBf16 E{g_PROJ, NPP, 0};
          pg8::StaticOrder S; S.init(g, TOK, NPP, G, bx);
          pg8::gemm_phase<pg8::EpiBf16, pg8::StaticOrder, true, false>(L, g, S, E); }
        GRID_BAR();
        { pg8::Gemm g{g_PROJ + O_CQ, (const bf16_t*)(g_ws + WS_WUQ) + (size_t)l * NQMP * 384, NPP, 384, 384, 0}; pg8::EpiRms E{g_QM, NQMP, NPP, g_PROJ + O_CQ, 384, RMS_EPS};
          pg8::StaticOrder S; S.init(g, TOK, NQMP, G, bx);
          pg8::gemm_phase<pg8::EpiRms, pg8::StaticOrder, true, false>(L, g, S, E); }
        { pg8::Gemm g{g_PROJ + O_CKV, (const bf16_t*)(g_ws + WS_WUKV) + (size_t)l * NKVM * 256, NPP, 256, 256, 0}; pg8::EpiRms E{g_KVM, NKVM, NPP, g_PROJ + O_CKV, 256, RMS_EPS};
          pg8::StaticOrder S; S.init(g, TOK, NKVM, G, G - 1 - bx);
          pg8::gemm_phase<pg8::EpiRms, pg8::StaticOrder, true, false>(L, g, S, E); }
        for (int idx = vcu * NTHREADS + tidx(); idx < TOK * 16; idx += G * NTHREADS) {
          const int t = idx >> 4, i = idx & 15, pos = t % SEQ; const bf16_t* p = g_PROJ + (size_t)t * NPP + O_KR; const float2 cs = g_TABM[pos * 16 + i];
          const float x1 = bf2f(p[i]), x2 = bf2f(p[i + 16]);
          g_KPE[(size_t)t * 32 + i] = (bf16_t)f2bf(x1 * cs.x - x2 * cs.y); g_KPE[(size_t)t * 32 + i + 16] = (bf16_t)f2bf(x1 * cs.y + x2 * cs.x); }
        { ret::RetPtrs rp; rp.proj = g_PROJ; rp.tabr = g_TABR; rp.gn_w = g_ret_gn_w + l * 256; rp.U = (float*)(g_ws + WS_U); rp.concat = g_CONCAT;
          for (int u = G - 1 - bx; u < 256; u += G) ret::upd_unit(rp, u >> 7, (u >> 5) & 3, u & 31, shm); }
        GRID_BAR();
        { att::AttnPtrs ap; ap.proj = g_PROJ; ap.qm = g_QM; ap.kvm = g_KVM; ap.kpe = g_KPE; ap.tabm = g_TABM; ap.sinks = g_swa_sinks + l * 6; ap.concat = g_CONCAT;
          ret::RetPtrs rp; rp.proj = g_PROJ; rp.tabr = g_TABR; rp.gn_w = g_ret_gn_w + l * 256; rp.U = (float*)(g_ws + WS_U); rp.concat = g_CONCAT;
          for (;;) {
            if (tidx() == 0) MISC[0] = atomicAdd(g_CTL + CW_QCTR + 64 * l, 1u);
            __syncthreads();
            const unsigned idx = MISC[0];
            __syncthreads();
            if (idx >= 1024u) break;
            if (idx < 384u) { const int qb = 31 - (int)(idx / 12u), bh = (int)(idx % 12u); att::attn_unit<0>(ap, bh / 6, bh % 6, qb, shm); }
            else if (idx < 768u) { const unsigned i2 = idx - 384u; const int qb = (int)(i2 / 12u), bh = (int)(i2 % 12u); att::attn_unit<1>(ap, bh / 6, bh % 6, qb, shm); }
            else { const int u = (int)(idx - 768u); ret::out_unit(rp, u >> 7, (u >> 5) & 3, u & 31, shm); }
          } }
        GRID_BAR();
        { pg8::Gemm g{g_CONCAT, (const bf16_t*)(g_ws + WS_WOUT) + (size_t)l * DM * DM, DM, DM, DM, 0}; pg8::EpiResid E{(l == 0) ? g_x_in : (const float*)g_out, g_Y, DM, ALPHA};
          pg8::StaticOrder S; S.init(g, TOK, DM, G, bx);
          pg8::gemm_phase<pg8::EpiResid, pg8::StaticOrder, true, false>(L, g, S, E); }
        GRID_BAR();
#define g_cnt (g_CTL + CW_CNT + 64 * l)
        { moe::MoePtrs mp; mp.Y = g_Y; mp.ln_g = g_ln1_g + l * DM; mp.ln_b = g_ln1_b + l * DM; mp.router_w = g_router_w; mp.router_bias = g_router_bias; mp.X1 = g_X1; mp.X1B = g_X1B; mp.cnt = g_cnt; mp.list = g_list; mp.gate = g_gate;
          moe::p5_phase(mp, shm, vcu, G); }
        GRID_BAR();
        { moe::MoeOrder<0> S; S.cnt = g_cnt; S.list = g_list; S.A = (const char*)g_X1B; S.Bt = (const char*)(g_ws + WS_WGU);
          pg8::Gemm g{nullptr, nullptr, DM, DM, DM, 0}; moe::EpiSwiglu E{g_A2, g_gate};
          pg8::gemm_phase<moe::EpiSwiglu, moe::MoeOrder<0>, true, true>(L, g, S, E); }
        GRID_BAR();
        { moe::MoeOrder<1> S; S.cnt = g_cnt; S.list = g_list; S.A = (const char*)g_A2; S.Bt = (const char*)(g_ws + WS_WD);
          pg8::Gemm g{nullptr, nullptr, DEXP, DEXP, DEXP, 0}; moe::EpiScatter E{g_YE, g_list};
          pg8::gemm_phase<moe::EpiScatter, moe::MoeOrder<1>, true, false>(L, g, S, E); }
        GRID_BAR();
        { moe::Ln2Ptrs lp; lp.X1 = g_X1; lp.YE = g_YE; lp.g = g_ln2_g + l * DM; lp.b = g_ln2_b + l * DM; lp.out = g_out; lp.XB = g_XB;
          for (int row = vcu * 8 + wave; row < TOK; row += G * 8) moe::ln2_row(lp, row, lane); }
        if (l + 1 < DEPTH) {
          p0_experts(g_wgu + (size_t)(l + 1) * NEXP * DM * 512, g_wd + (size_t)(l + 1) * NEXP * DEXP * DM, g_ws, (LAS float*)(L + wave * 16384), vcu * 8 + wave, G * 8, lane);
          GRID_BAR();
        }
    }
    if (xb_ld((gu32*)(g_CTL + CW_BAR + XB_TMO)) != 0u && bx == 0 && tidx() == 0) g_out[0] = __builtin_nanf("");
#undef g_out
#undef g_ws
#undef g_list
#undef g_gate
#undef g_cnt
}

extern "C" void kernel_launch(void* const* d_in, const int* in_sizes, int n_in, void* d_out, int out_size, void* d_ws, size_t ws_size, hipStream_t stream) {
    static int grid = 0;
    if (grid == 0) {
        if (n_in != 17 || ws_size < WS_END || out_size != TOK * DM) { fprintf(stderr, "kernel_launch: unexpected problem (n_in %d, ws %zu, out %d); nothing launched\n", n_in, ws_size, out_size); grid = -1; return; }
        int dev = 0, cus = 0, per_cu = 0;
        if (hipGetDevice(&dev) != hipSuccess || hipDeviceGetAttribute(&cus, hipDeviceAttributeMultiprocessorCount, dev) != hipSuccess) { grid = -1; return; }
        if (hipFuncSetAttribute((const void*)mk_fwd, hipFuncAttributeMaxDynamicSharedMemorySize, LDS_BYTES) != hipSuccess) { fprintf(stderr, "kernel_launch: hipFuncSetAttribute failed\n"); grid = -1; return; }
        if (hipOccupancyMaxActiveBlocksPerMultiprocessor(&per_cu, (const void*)mk_fwd, NTHREADS, LDS_BYTES) != hipSuccess || per_cu < 1) { fprintf(stderr, "kernel_launch: occupancy query says %d workgroups per CU\n", per_cu); (void)hipGetLastError(); grid = -1; return; }
        grid = cus;
    }
    if (grid < 0) return;
    (void)hipMemsetAsync((char*)d_ws + WS_CTL, 0, CTL_ZERO_BYTES, stream);
    Args a{};
    for (int i = 0; i < 17; ++i) a.in[i] = (const float*)d_in[i];
    a.out = (float*)d_out; a.ws = (unsigned char*)d_ws;
    hipLaunchKernelGGL(mk_fwd, dim3(grid), dim3(NTHREADS), LDS_BYTES, stream, a);
}
```

```cpp
#define PROBE_PHASE 0
#include <hip/hip_runtime.h>
#include <cstdio>
#include <cstdint>
#include <math.h>

constexpr int BATCH = 2, SEQ = 8192, TOK = BATCH * SEQ, DM = 1024, DEPTH = 2;
constexpr int NP = 2336, NPP = 2560;
constexpr int O_RQ = 0, O_RK = 256, O_RV = 512, O_RG = 768, O_SQ = 1024, O_SK = 1408, O_SV = 1536, O_CQ = 1664, O_CKV = 2048, O_KR = 2304;
constexpr int NQM = 576, NQMP = 768, NKVM = 768;
constexpr int NEXP = 16, DEXP = 256;
constexpr float LN_EPS = 1e-5f, RMS_EPS = 1e-6f;
constexpr float ALPHA = 1.4142135623730951f;
constexpr float LOG2E = 1.4426950408889634f;

typedef unsigned short bf16_t;
typedef short bf16x8 __attribute__((ext_vector_type(8)));
typedef float f32x4 __attribute__((ext_vector_type(4)));
typedef float f32x16 __attribute__((ext_vector_type(16)));
typedef unsigned u32x4 __attribute__((ext_vector_type(4)));
typedef unsigned u32x2 __attribute__((ext_vector_type(2)));
#define LAS __attribute__((address_space(3)))
#define GAS __attribute__((address_space(1)))

constexpr size_t MiB = 1u << 20;
constexpr size_t WS_CTL = 0, CTL_ZERO_BYTES = 1 * MiB;
constexpr size_t WS_LIST = 1 * MiB, WS_GATE = 2 * MiB;
constexpr size_t WS_TABR = 3 * MiB, WS_TABM = 5 * MiB;
constexpr size_t WS_WIN = 6 * MiB;
constexpr size_t WS_WUQ = 16 * MiB;
constexpr size_t WS_WUKV = 17 * MiB + 256 * 1024;
constexpr size_t WS_WOUT = 18 * MiB;
constexpr size_t WS_WGU = 22 * MiB;
constexpr size_t WS_WD = 38 * MiB;
constexpr size_t WS_R0 = 46 * MiB;
constexpr size_t WS_R1 = 78 * MiB;
constexpr size_t WS_A2 = WS_R1, WS_YE = WS_R1 + 18 * MiB;
constexpr size_t WS_R2 = 162 * MiB;
constexpr size_t WS_QM = WS_R2, WS_KVM = WS_R2 + 24 * MiB, WS_KPE = WS_R2 + 48 * MiB, WS_U = WS_R2 + 49 * MiB;
constexpr size_t WS_R3 = 219 * MiB;
constexpr size_t WS_X1 = WS_R2;
constexpr size_t WS_END = 251 * MiB;
static_assert(WS_WUQ + 2 * 768 * 384 * 2 <= WS_WUKV && WS_WUKV + 2 * 768 * 256 * 2 <= WS_WOUT, "ws map");
static_assert(WS_U + 8 * MiB <= WS_R3 && WS_X1 + 64 * MiB <= WS_END && WS_YE + 64 * MiB <= WS_R2, "ws map");

__device__ __forceinline__ float bf2f(bf16_t v) { return __uint_as_float(((unsigned)v) << 16); }
__device__ __forceinline__ unsigned f2bf(float f) { unsigned u = __float_as_uint(f); return (u + 0x7fffu + ((u >> 16) & 1u)) >> 16; }
__device__ __forceinline__ unsigned pk2(float lo, float hi) { return f2bf(lo) | (f2bf(hi) << 16); }
__device__ __forceinline__ unsigned cvt_pk_bf16(float lo, float hi) { unsigned r; asm volatile("v_cvt_pk_bf16_f32 %0, %1, %2" : "=v"(r) : "v"(lo), "v"(hi)); return r; }
__device__ __forceinline__ float wave_sum(float v) {
#pragma unroll
  for (int o = 1; o < 64; o <<= 1) v += __shfl_xor(v, o);
  return v;
}
#define LDS_WAIT() asm volatile("s_waitcnt lgkmcnt(0)" ::: "memory")
#define VM_WAIT() asm volatile("s_waitcnt vmcnt(0)" ::: "memory")

__device__ __forceinline__ int tidx() { int t = (int)threadIdx.x; asm volatile("" : "+v"(t)); return t; }
namespace pg8 {
constexpr int BM = 256, BK = 64, HALF = 128, HTB = HALF * BK * 2  , STAGE_BYTES = 8 * HTB, NXCD = 8, WGM = 8;

__host__ __device__ __forceinline__ int lds_byte(int r, int c) { const int st = (r >> 4) * 2 + (c >> 5), rr = r & 15, cc = c & 31, ob = rr * 64 + cc * 2; return st * 1024 + (ob ^ (((ob >> 9) & 1) << 5)); }
__host__ __device__ __forceinline__ void stage_rc(int b, int& R, int& C) { const int st = b / 1024, sb = b % 1024, swz = sb ^ (((sb >> 9) & 1) << 5); R = (st >> 1) * 16 + swz / 64; C = (st & 1) * 32 + (swz % 64) / 2; }
__host__ __device__ __forceinline__ int perm32(int rho) { const int n = rho >> 4, i = rho & 15; return 8 * (i >> 2) + 4 * n + (i & 3); }

struct Unit { int pm, pn; const char* pA; const char* pB; int e, mt, valid, pad; };
struct Gemm { const bf16_t* A; const bf16_t* Bt; int lda, ldb, K, pad; };

struct StaticOrder {
    int nM, nN, nwg, G, c; const char* A; const char* Bt; size_t tA, tB;
    __host__ __device__ void init(const Gemm& g, int M, int N, int G_, int c_) { nM = M / BM; nN = N / BM; nwg = nM * nN; G = G_; c = c_; A = (const char*)g.A; Bt = (const char*)g.Bt; tA = (size_t)BM * g.lda * 2; tB = (size_t)BM * g.ldb * 2; }
    __device__ __forceinline__ unsigned rowoff(const Unit&, int) const { return 0u; }
    __host__ __device__ bool next(int i, Unit& u) const {
        const long L = (long)i * G + c; if (L >= nwg) return false;
        int wgid = (int)L; { const int q = nwg / NXCD, r = nwg % NXCD, xcd = wgid % NXCD, off = wgid / NXCD; wgid = (xcd < r ? xcd * (q + 1) : r * (q + 1) + (xcd - r) * q) + off; }
        const int nig = WGM * nN, gid = wgid / nig, fm = gid * WGM, gsz = (nM - fm) < WGM ? (nM - fm) : WGM;
        u.pm = fm + ((wgid % nig) % gsz); u.pn = (wgid % nig) / gsz; u.pA = A + (size_t)u.pm * tA; u.pB = Bt + (size_t)u.pn * tB; u.e = 0; u.mt = 0; u.valid = BM; u.pad = 0; return true;
    }
};

struct EpiBf16 {
    static constexpr bool PERM = true;
    bf16_t* O; int ldc, pad;
    __device__ __forceinline__ void operator()(const f32x4 (&acc)[2][2][4][2], const Unit& u, int wr, int wc, int fr, int fq) const {
        const int row0 = u.pm * BM + wr * 64 + fr; const int col0 = u.pn * BM + wc * 32 + 8 * fq;
#pragma unroll
        for (int ai = 0; ai < 2; ++ai)
#pragma unroll
            for (int m = 0; m < 4; ++m) { bf16_t* rowp = O + (size_t)(row0 + ai * HALF + m * 16) * ldc + col0;
#pragma unroll
                for (int bj = 0; bj < 2; ++bj) { const f32x4 v0 = acc[ai][bj][m][0], v1 = acc[ai][bj][m][1];
                    u32x4 w; w.x = cvt_pk_bf16(v0[0], v0[1]); w.y = cvt_pk_bf16(v0[2], v0[3]); w.z = cvt_pk_bf16(v1[0], v1[1]); w.w = cvt_pk_bf16(v1[2], v1[3]);
                    *(u32x4*)(rowp + bj * HALF) = w; } }
    }
};
struct EpiRms {
    static constexpr bool PERM = true;
    bf16_t* O; int ldc, lda; const bf16_t* A; int kdim; float eps;
    __device__ __forceinline__ void operator()(const f32x4 (&acc)[2][2][4][2], const Unit& u, int wr, int wc, int fr, int fq) const {
        const int row0 = u.pm * BM + wr * 64 + fr; const int col0 = u.pn * BM + wc * 32 + 8 * fq;
        const float inv_k = 1.0f / (float)kdim; const int nch = kdim >> 5;
#pragma unroll
        for (int ai = 0; ai < 2; ++ai)
#pragma unroll
            for (int m = 0; m < 4; ++m) { const int row = row0 + ai * HALF + m * 16;
                const bf16_t* ar = A + (size_t)row * lda + fq * 8; float ss = 0.f;
                for (int i = 0; i < nch; ++i) { const bf16x8 v = *(const bf16x8*)(ar + i * 32);
#pragma unroll
                    for (int j = 0; j < 8; ++j) { const float f = bf2f((bf16_t)v[j]); ss = fmaf(f, f, ss); } }
                ss += __shfl_xor(ss, 16); ss += __shfl_xor(ss, 32);
                const float r = rsqrtf(ss * inv_k + eps);
                bf16_t* rowp = O + (size_t)row * ldc + col0;
#pragma unroll
                for (int bj = 0; bj < 2; ++bj) { const f32x4 v0 = acc[ai][bj][m][0] * r, v1 = acc[ai][bj][m][1] * r;
                    u32x4 w; w.x = cvt_pk_bf16(v0[0], v0[1]); w.y = cvt_pk_bf16(v0[2], v0[3]); w.z = cvt_pk_bf16(v1[0], v1[1]); w.w = cvt_pk_bf16(v1[2], v1[3]);
                    *(u32x4*)(rowp + bj * HALF) = w; } }
    }
};
struct EpiResid {
    static constexpr bool PERM = false;
    const float* X; float* Y; int ldc; float alpha;
    __device__ __forceinline__ void operator()(const f32x4 (&acc)[2][2][4][2], const Unit& u, int wr, int wc, int fr, int fq) const {
        const int col0 = u.pn * BM + wc * 32 + 4 * fq;
#pragma unroll
        for (int ai = 0; ai < 2; ++ai)
#pragma unroll
            for (int m = 0; m < 4; ++m) { const size_t off = (size_t)(u.pm * BM + ai * HALF + wr * 64 + m * 16 + fr) * ldc + col0;
#pragma unroll
                for (int bj = 0; bj < 2; ++bj)
#pragma unroll
                    for (int n = 0; n < 2; ++n) { const f32x4 xv = *(const f32x4*)(X + off + bj * HALF + n * 16);
                        *(f32x4*)(Y + off + bj * HALF + n * 16) = xv * alpha + acc[ai][bj][m][n]; } }
    }
};

template <class Epi, class Sched, bool ALIGN_EPI, bool GATHER>
__device__ __forceinline__ void gemm_phase(LAS unsigned char* lds, const Gemm g, const Sched& S, const Epi& E) {
    const int tid = tidx(), wid = __builtin_amdgcn_readfirstlane(tid >> 6), lane = tid & 63, wr = wid >> 2, wc = wid & 3, fr = lane & 15, fq = lane >> 4;
    int nt = g.K / BK; asm volatile("" : "+s"(nt));
    unsigned voffA[2], voffB[2]; int RA[2];
#pragma unroll
    for (int i = 0; i < 2; ++i) { int R, C; stage_rc(tid * 16 + i * 8192, R, C); const int Rb = Epi::PERM ? ((R & ~31) + perm32(R & 31)) : R;
        RA[i] = R; voffA[i] = GATHER ? (unsigned)C * 2u : (unsigned)(R * g.lda + C) * 2u; voffB[i] = (unsigned)(Rb * g.ldb + C) * 2u; }
    const size_t kstep = (size_t)(BK * 2);
    const size_t hstepA = GATHER ? (size_t)0 : (size_t)HALF * g.lda * 2, hstepB = (size_t)HALF * g.ldb * 2;
    const unsigned ldsw = (unsigned)wid * 1024u;
    const int aoff = lds_byte(wr * 64 + fr, fq * 8), boff = lds_byte(wc * 32 + fr, fq * 8);
#define PG8_SA(b, h) (((b) * 2 + (h)) * HTB)
#define PG8_SB(b, h) ((4 + (b) * 2 + (h)) * HTB)
#define PG8_STAGE(bufoff, gbase, voff) do { _Pragma("unroll") for (int _i = 0; _i < 2; ++_i) \
        __builtin_amdgcn_global_load_lds((const unsigned*)((const char*)(gbase) + (voff)[_i]), (LAS unsigned*)(lds + (bufoff) + ldsw + _i * 8192), 16, 0, 0); } while (0)
#define PG8_STAGE_A(bufoff, gbase, h, vg) do { _Pragma("unroll") for (int _i = 0; _i < 2; ++_i) \
        __builtin_amdgcn_global_load_lds((const unsigned*)((const char*)(gbase) + (GATHER ? (size_t)0 : (h) * hstepA) + (GATHER ? (vg)[h][_i] : voffA[_i])), (LAS unsigned*)(lds + (bufoff) + ldsw + _i * 8192), 16, 0, 0); } while (0)
#define PG8_GOFF(vg, u) do { if (GATHER) { _Pragma("unroll") for (int _h = 0; _h < 2; ++_h) _Pragma("unroll") for (int _i = 0; _i < 2; ++_i) (vg)[_h][_i] = S.rowoff(u, _h * HALF + RA[_i]) + voffA[_i]; } } while (0)
#define PG8_LDA(dst, b, h) do { _Pragma("unroll") for (int m = 0; m < 4; ++m) _Pragma("unroll") for (int k = 0; k < 2; ++k) dst[m][k] = *(const LAS bf16x8*)(lds + PG8_SA(b, h) + aoff + m * 2048 + k * 1024); } while (0)
#define PG8_LDB(dst, b, h) do { _Pragma("unroll") for (int n = 0; n < 2; ++n) _Pragma("unroll") for (int k = 0; k < 2; ++k) dst[n][k] = *(const LAS bf16x8*)(lds + PG8_SB(b, h) + boff + n * 2048 + k * 1024); } while (0)
#define PG8_MMA(ai, bj, At, Bt) do { __builtin_amdgcn_s_setprio(1); _Pragma("unroll") for (int m = 0; m < 4; ++m) _Pragma("unroll") for (int n = 0; n < 2; ++n) _Pragma("unroll") for (int k = 0; k < 2; ++k) \
        acc[ai][bj][m][n] = __builtin_amdgcn_mfma_f32_16x16x32_bf16(Bt[n][k], At[m][k], acc[ai][bj][m][n], 0, 0, 0); __builtin_amdgcn_s_setprio(0); } while (0)
#define PG8_WAIT_V(n) asm volatile("s_waitcnt vmcnt(" #n ")" ::: "memory")
#define PG8_WAIT_L(n) asm volatile("s_waitcnt lgkmcnt(" #n ")" ::: "memory")
#define PG8_BAR __builtin_amdgcn_s_barrier()
#define PG8_SCHED __builtin_amdgcn_sched_barrier(0)
    Unit cur, nxt; int ui = 0;
    if (!S.next(0, cur)) return;
    f32x4 acc[2][2][4][2];
#pragma unroll
    for (int a = 0; a < 2; ++a)
#pragma unroll
        for (int b = 0; b < 2; ++b)
#pragma unroll
            for (int m = 0; m < 4; ++m)
#pragma unroll
                for (int n = 0; n < 2; ++n) acc[a][b][m][n] = (f32x4){0.f, 0.f, 0.f, 0.f};
    bf16x8 At[4][2], B0[2][2], B1[2][2];
    const char* cA = cur.pA; const char* cB = cur.pB;
    unsigned vgc[2][2] = {{0u, 0u}, {0u, 0u}};
    PG8_GOFF(vgc, cur);
    PG8_STAGE(PG8_SB(0, 0), cB, voffB); PG8_STAGE(PG8_SB(0, 1), cB + hstepB, voffB); PG8_STAGE_A(PG8_SA(0, 0), cA, 0, vgc); PG8_STAGE_A(PG8_SA(0, 1), cA, 1, vgc);
    if (wr == 1) PG8_BAR;
    PG8_WAIT_V(2); PG8_BAR;
    PG8_STAGE(PG8_SB(1, 0), cB + kstep, voffB); PG8_STAGE_A(PG8_SA(1, 0), cA + kstep, 0, vgc); PG8_STAGE(PG8_SB(1, 1), cB + hstepB + kstep, voffB);
    PG8_WAIT_V(6); PG8_BAR;
    for (;;) {
        const bool has_next = S.next(ui + 1, nxt);
        const char* nA = has_next ? nxt.pA : cA; const char* nB = has_next ? nxt.pB : cB;

#pragma unroll 1
        for (int t = 0; t < nt; t += 2) {
            const bool last = (t == nt - 2);
            const char* a1 = cA + (size_t)(t + 1) * kstep;
            const char* a2 = last ? nA : cA + (size_t)(t + 2) * kstep; const char* b2 = last ? nB : cB + (size_t)(t + 2) * kstep;
            const char* a3 = a2 + kstep; const char* b3 = b2 + kstep;
            unsigned vgn[2][2] = {{0u, 0u}, {0u, 0u}};
            if (GATHER) { if (last && has_next) { PG8_GOFF(vgn, nxt); PG8_SCHED; } }
            PG8_LDB(B0, 0, 0); PG8_LDB(B1, 0, 1); PG8_SCHED; PG8_LDA(At, 0, 0); PG8_STAGE_A(PG8_SA(1, 1), a1, 1, vgc);
            if (GATHER) { if (last && has_next) {
#pragma unroll
                for (int _h = 0; _h < 2; ++_h) { vgc[_h][0] = vgn[_h][0]; vgc[_h][1] = vgn[_h][1]; } } }
            PG8_WAIT_V(8); PG8_WAIT_L(0); PG8_BAR; PG8_MMA(0, 0, At, B0); PG8_MMA(0, 1, At, B1); PG8_BAR; PG8_SCHED;
            PG8_LDA(At, 0, 1); PG8_STAGE(PG8_SB(0, 0), b2, voffB); PG8_STAGE(PG8_SB(0, 1), b2 + hstepB, voffB); PG8_STAGE_A(PG8_SA(0, 0), a2, 0, vgc);
            PG8_WAIT_V(8); PG8_WAIT_L(0); PG8_BAR; PG8_MMA(1, 0, At, B0); PG8_MMA(1, 1, At, B1); PG8_BAR; PG8_SCHED;
            PG8_LDB(B0, 1, 0); PG8_LDB(B1, 1, 1); PG8_SCHED; PG8_LDA(At, 1, 0); PG8_STAGE_A(PG8_SA(0, 1), a2, 1, vgc);
            PG8_WAIT_V(8); PG8_WAIT_L(0); PG8_BAR; PG8_MMA(0, 0, At, B0); PG8_MMA(0, 1, At, B1); PG8_BAR; PG8_SCHED;
            PG8_LDA(At, 1, 1); PG8_STAGE(PG8_SB(1, 0), b3, voffB); PG8_STAGE(PG8_SB(1, 1), b3 + hstepB, voffB); PG8_STAGE_A(PG8_SA(1, 0), a3, 0, vgc);
            PG8_WAIT_V(8); PG8_WAIT_L(0); PG8_BAR; PG8_MMA(1, 0, At, B0); PG8_MMA(1, 1, At, B1); PG8_BAR; PG8_SCHED;
        }
        if constexpr (ALIGN_EPI) { if (wr == 0) PG8_BAR; }
        E(acc, cur, wr, wc, fr, fq);
        if (!has_next) break;
#pragma unroll
        for (int a = 0; a < 2; ++a)
#pragma unroll
            for (int b = 0; b < 2; ++b)
#pragma unroll
                for (int m = 0; m < 4; ++m)
#pragma unroll
                    for (int n = 0; n < 2; ++n) acc[a][b][m][n] = (f32x4){0.f, 0.f, 0.f, 0.f};
        cur = nxt; cA = nA; cB = nB; ++ui;

        if constexpr (ALIGN_EPI) { if (wr == 1) PG8_BAR; }
    }
    PG8_WAIT_V(0);
    if constexpr (!ALIGN_EPI) { if (wr == 0) PG8_BAR; }
    PG8_BAR;
#undef PG8_SA
#undef PG8_SB
#undef PG8_STAGE
#undef PG8_STAGE_A
#undef PG8_GOFF
#undef PG8_LDA
#undef PG8_LDB
#undef PG8_MMA
#undef PG8_WAIT_V
#undef PG8_WAIT_L
#undef PG8_BAR
#undef PG8_SCHED
}
}
__device__ __forceinline__ void p0_transpose_item(const float* __restrict__ W, int K, int N, bf16_t* WT, int row_off, LAS float* scr, int kb, int nb, int lane, const float* __restrict__ kscale) {
    const int k0 = 64 * kb, n0 = 32 * nb;
#pragma unroll 8
    for (int i = 0; i < 32; ++i) { const int kk = 2 * i + (lane >> 5); float w = W[(size_t)(k0 + kk) * N + n0 + (lane & 31)]; if (kscale) w *= kscale[k0 + kk]; scr[kk * 33 + (lane & 31)] = w; }
    LDS_WAIT(); asm volatile("" ::: "memory");
    const int c = lane & 7;
#pragma unroll
    for (int j = 0; j < 4; ++j) { const int n = (lane >> 3) + 8 * j; const LAS float* s = scr + (8 * c) * 33 + n;
        u32x4 o; o.x = pk2(s[0 * 33], s[1 * 33]); o.y = pk2(s[2 * 33], s[3 * 33]); o.z = pk2(s[4 * 33], s[5 * 33]); o.w = pk2(s[6 * 33], s[7 * 33]);
        *(u32x4*)(WT + (size_t)(row_off + n0 + n) * K + k0 + 8 * c) = o; }
    LDS_WAIT(); asm volatile("" ::: "memory");
}
__device__ __forceinline__ void p0_convert(const float* W, int K, int N, bf16_t* WT, LAS float* scr, int gw, int NGW, int lane, const float* kscale, int rowmap) {
    const int nblk = N / 32, nitems = (K / 64) * nblk;
    for (int it = gw; it < nitems; it += NGW) { const int kb = it / nblk, nb = it % nblk; int row_off = 0;
        if (rowmap == 1) { const int c0 = nb * 32; const int cc = (c0 < 256) ? c0 : c0 - 256; const int pn = cc >> 7, j = (cc & 127) + ((c0 < 256) ? 0 : 128); row_off = (256 * pn + j) - c0; }
        p0_transpose_item(W, K, N, WT, row_off, scr, kb, nb, lane, kscale); }
}
__device__ __forceinline__ void p0_zero_rows(bf16_t* WT, int K, int r0, int r1, int gtid, int NGT) {
    const size_t n16 = (size_t)(r1 - r0) * K * 2 / 16; u32x4* p = (u32x4*)(WT + (size_t)r0 * K);
    for (size_t i = gtid; i < n16; i += NGT) p[i] = (u32x4){0u, 0u, 0u, 0u};
}
struct P0Args { const float *x, *w_in, *qn_w, *kvn_w, *w_uq, *w_ukv, *w_out; unsigned char* ws; };
__device__ __forceinline__ void p0_experts(const float* wgu_l, const float* wd_l, unsigned char* ws, LAS float* scr, int gw, int NGW, int lane) {
    for (int it = gw; it < NEXP * 384; it += NGW) {
        if (it < NEXP * 256) { const int e = it >> 8, r = it & 255, kb = r >> 4, nb = r & 15; const int c0 = nb * 32; const int cc = (c0 < 256) ? c0 : c0 - 256; const int row_off = (256 * (cc >> 7) + (cc & 127) + ((c0 < 256) ? 0 : 128)) - c0;
            p0_transpose_item(wgu_l + (size_t)e * DM * 512, DM, 512, (bf16_t*)(ws + WS_WGU) + (size_t)e * 512 * DM, row_off, scr, kb, nb, lane, nullptr); }
        else { const int i2 = it - NEXP * 256; const int e = i2 >> 7, r = i2 & 127, kb = r >> 5, nb = r & 31;
            p0_transpose_item(wd_l + (size_t)e * DEXP * DM, DEXP, DM, (bf16_t*)(ws + WS_WD) + (size_t)e * DM * DEXP, 0, scr, kb, nb, lane, nullptr); }
    }
}
__device__ __forceinline__ void p0_all(const P0Args& a, LAS unsigned char* lds, int vcu, int G) {
    const int tid = tidx(), lane = tid & 63, wave = tid >> 6;
    LAS float* scr = (LAS float*)(lds + wave * 16384);
    const int gw = vcu * 8 + wave, NGW = G * 8, gtid = vcu * 512 + tid, NGT = G * 512;
    for (int l = 0; l < DEPTH; ++l) {
        bf16_t* win_t = (bf16_t*)(a.ws + WS_WIN) + (size_t)l * NPP * DM;
        p0_convert(a.w_in + (size_t)l * DM * NP, DM, NP, win_t, scr, gw, NGW, lane, nullptr, 0);
        p0_zero_rows(win_t, DM, NP, NPP, gtid, NGT);
        bf16_t* wuq_t = (bf16_t*)(a.ws + WS_WUQ) + (size_t)l * NQMP * 384;
        p0_convert(a.w_uq + (size_t)l * 384 * NQM, 384, NQM, wuq_t, scr, gw, NGW, lane, a.qn_w + l * 384, 0);
        p0_zero_rows(wuq_t, 384, NQM, NQMP, gtid, NGT);
        p0_convert(a.w_ukv + (size_t)l * 256 * NKVM, 256, NKVM, (bf16_t*)(a.ws + WS_WUKV) + (size_t)l * NKVM * 256, scr, gw, NGW, lane, a.kvn_w + l * 256, 0);
        p0_convert(a.w_out + (size_t)l * DM * DM, DM, DM, (bf16_t*)(a.ws + WS_WOUT) + (size_t)l * DM * DM, scr, gw, NGW, lane, nullptr, 0);
    }
    { const f32x4* xs = (const f32x4*)a.x; u32x2* xb = (u32x2*)(a.ws + WS_R0); const size_t n4 = (size_t)TOK * DM / 4;
      for (size_t i = gtid; i < n4; i += NGT) { const f32x4 v = xs[i]; u32x2 o; o.x = pk2(v[0], v[1]); o.y = pk2(v[2], v[3]); xb[i] = o; } }
    { float2* tr = (float2*)(a.ws + WS_TABR); float2* tm = (float2*)(a.ws + WS_TABM);
      for (int idx = gtid; idx < SEQ * 32; idx += NGT) { const int pos = idx >> 5, i = idx & 31;
          const float invf = (float)exp(-log(10000.0) * (double)(2 * i) / 64.0); const double ang = (double)((float)pos * invf);
          tr[idx] = make_float2((float)cos(ang), (float)sin(ang)); }
      for (int idx = gtid; idx < SEQ * 16; idx += NGT) { const int pos = idx >> 4, i = idx & 15;
          const float invf = (float)exp(-log(10000.0) * (double)(2 * i) / 32.0); const double ang = (double)((float)pos * invf);
          tm[idx] = make_float2((float)cos(ang), (float)sin(ang)); } }
}
namespace att {
__device__ __forceinline__ int crow(int r, int hi) { return (r & 3) + 8 * (r >> 2) + 4 * hi; }
#define ATT_SBAR() __builtin_amdgcn_sched_barrier(0)
#define ATT_WAIT_BAR0() asm volatile("s_waitcnt vmcnt(0) lgkmcnt(0)\n\ts_barrier" ::: "memory")
constexpr int KSLOT = 12288, VSLOT = 8192;
constexpr int LDS_K = 0, LDS_V = 2 * KSLOT, LDS_WS = LDS_V + 2 * VSLOT, LDS_OST = LDS_WS + 8 * 256, LDS_BYTES = LDS_OST + 8 * 4096;
__device__ __forceinline__ void glds16(const void* gsrc, unsigned lds_dst) { unsigned keep;
  asm volatile("s_mov_b32 %0, m0\n\ts_mov_b32 m0, %2\n\ts_nop 0\n\tglobal_load_lds_dwordx4 %1, off\n\ts_mov_b32 m0, %0" : "=&s"(keep) : "v"(gsrc), "s"(lds_dst) : "memory"); }
__device__ __forceinline__ float max3f(float a, float b, float c) { float r; asm("v_max3_f32 %0, %1, %2, %3" : "=v"(r) : "v"(a), "v"(b), "v"(c)); return r; }
__device__ __forceinline__ float rowmax(const f32x16& p0, const f32x16& p1) {
  float a = max3f(p0[0], p0[1], p1[0]), b = max3f(p0[2], p0[3], p1[1]); a = max3f(a, p1[2], p1[3]);
#pragma unroll
  for (int r = 4; r < 16; r += 4) { a = max3f(a, p0[r], p0[r + 1]); b = max3f(b, p0[r + 2], p0[r + 3]); a = max3f(a, p1[r], p1[r + 1]); b = max3f(b, p1[r + 2], p1[r + 3]); }
  const float m = fmaxf(a, b);
  auto rr = __builtin_amdgcn_permlane32_swap(__float_as_uint(m), __float_as_uint(m), false, false);
  return fmaxf(__uint_as_float(rr[0]), __uint_as_float(rr[1]));
}
template <int NCH>
__device__ __forceinline__ void qkt(f32x16& p0, f32x16& p1, const LAS char* Kslot, const bf16x8* qr, int r32, int hi) {
  const LAS char* kb = Kslot + hi * 1024 + r32 * 16;
#pragma unroll
  for (int d0 = 0; d0 < NCH; ++d0) {
    const bf16x8 b0 = *(const LAS bf16x8*)(kb + d0 * 2048);
    const bf16x8 b1 = *(const LAS bf16x8*)(kb + d0 * 2048 + 512);
    p0 = __builtin_amdgcn_mfma_f32_32x32x16_bf16(b0, qr[d0], p0, 0, 0, 0);
    p1 = __builtin_amdgcn_mfma_f32_32x32x16_bf16(b1, qr[d0], p1, 0, 0, 0);
  }
}
typedef short s16x4 __attribute__((ext_vector_type(4)));
__device__ __forceinline__ void pv(f32x16* o, int vb, bf16x8 pa0, bf16x8 pa1, bf16x8 pa2, bf16x8 pa3) {
#pragma unroll
  for (int d0 = 0; d0 < 2; ++d0) { s16x4 lo[4], hi[4];
#pragma unroll
    for (int ks = 0; ks < 4; ++ks) {
      asm volatile("ds_read_b64_tr_b16 %0,%1 offset:%c2" : "=&v"(lo[ks]) : "v"(vb), "i"(d0 * 4096 + ks * 1024) : "memory");
      asm volatile("ds_read_b64_tr_b16 %0,%1 offset:%c2" : "=&v"(hi[ks]) : "v"(vb), "i"(d0 * 4096 + ks * 1024 + 512) : "memory"); }
    asm volatile("s_waitcnt lgkmcnt(0)" ::: "memory"); ATT_SBAR();
#define ATT_PK(k) (bf16x8){lo[k][0], lo[k][1], lo[k][2], lo[k][3], hi[k][0], hi[k][1], hi[k][2], hi[k][3]}
    o[d0] = __builtin_amdgcn_mfma_f32_32x32x16_bf16(pa0, ATT_PK(0), o[d0], 0, 0, 0);
    o[d0] = __builtin_amdgcn_mfma_f32_32x32x16_bf16(pa1, ATT_PK(1), o[d0], 0, 0, 0);
    o[d0] = __builtin_amdgcn_mfma_f32_32x32x16_bf16(pa2, ATT_PK(2), o[d0], 0, 0, 0);
    o[d0] = __builtin_amdgcn_mfma_f32_32x32x16_bf16(pa3, ATT_PK(3), o[d0], 0, 0, 0);
#undef ATT_PK
  }
}
struct AttnPtrs { const bf16_t* proj; const bf16_t* qm; const bf16_t* kvm; const bf16_t* kpe; const float2* tabm; const float* sinks; bf16_t* concat; };

template <int MODE>
__device__ __forceinline__ void attn_unit(const AttnPtrs& P, int b, int h, int qb, LAS char* shm) {
  constexpr int NCH = (MODE == 0) ? 6 : 4;
  const int tid = tidx(), lane = tid & 63, r32 = lane & 31, hi = lane >> 5; const int wid = __builtin_amdgcn_readfirstlane(tid >> 6);
  const long rowbase = (long)b * SEQ; const int q0 = qb * 256;
  const unsigned lds0 = (unsigned)(uintptr_t)shm;
  LAS float* wsf = (LAS float*)(shm + LDS_WS) + wid * 64;
  const bf16_t *Qp, *Kp, *Vp; int ldq, ldk; bf16_t* Op;
  if (MODE == 0) { Qp = P.qm + h * 96; ldq = NQMP; Kp = P.kvm + h * 128; Vp = P.kvm + h * 128 + 64; ldk = NKVM; Op = P.concat + 640 + h * 64; }
  else { Qp = P.proj + O_SQ + h * 64; ldq = NPP; Kp = P.proj + O_SK + (h / 3) * 64; Vp = P.proj + O_SV + (h / 3) * 64; ldk = NPP; Op = P.concat + 256 + h * 64; }
  const bf16_t* ksrc = Kp + (rowbase + lane) * ldk + wid * 8;
  const bf16_t* krsrc = P.kpe + (rowbase + lane) * 32 + (wid & 3) * 8;
  const bf16_t* vsrc = Vp + (rowbase + 16 * (wid & 3) + (lane >> 2)) * ldk + (wid >> 2) * 32 + (lane & 3) * 8;
  const unsigned kdst = lds0 + LDS_K + wid * 1024, krdst = lds0 + LDS_K + (8 + (wid & 3)) * 1024, vdst = lds0 + LDS_V + wid * 1024;
#define ATT_DMA(t, s) do { glds16(ksrc + (long)(t) * 64 * ldk, (unsigned)__builtin_amdgcn_readfirstlane(kdst + (s) * KSLOT)); \
    if (MODE == 0 && wid < 4) glds16(krsrc + (long)(t) * 64 * 32, (unsigned)__builtin_amdgcn_readfirstlane(krdst + (s) * KSLOT)); \
    glds16(vsrc + (long)(t) * 64 * ldk, (unsigned)__builtin_amdgcn_readfirstlane(vdst + (s) * VSLOT)); } while (0)
  const int vb0 = (int)(lds0 + LDS_V) + ((lane >> 4) & 1) * 32 + (lane & 3) * 8 + (4 * hi + ((lane & 15) >> 2)) * 64;
  int t_lo, t_hi;
  if (MODE == 0) { t_lo = 0; t_hi = (q0 + 256) / 64; } else { t_lo = q0 / 64 - 2; if (t_lo < 0) t_lo = 0; t_hi = q0 / 64 + 4; }
  ATT_DMA(t_lo, 0);
  const int qpos = q0 + wid * 32 + r32;
  bf16x8 qr[NCH];
  { const float c2 = (MODE == 0 ? 0.10206207261596575f : 0.125f) * LOG2E;
    const bf16_t* qrow = Qp + (rowbase + qpos) * ldq + hi * 8;
    float qf[NCH][8];
#pragma unroll
    for (int d0 = 0; d0 < NCH; ++d0) { const bf16x8 v = *reinterpret_cast<const bf16x8*>(qrow + d0 * 16);
#pragma unroll
      for (int j = 0; j < 8; ++j) qf[d0][j] = bf2f((bf16_t)v[j]); }
    if (MODE == 0) {
      const float2* tb = P.tabm + qpos * 16 + hi * 8;
#pragma unroll
      for (int j = 0; j < 8; ++j) { const float2 cs = tb[j]; const float x1 = qf[NCH - 2][j], x2 = qf[NCH - 1][j]; qf[NCH - 2][j] = x1 * cs.x - x2 * cs.y; qf[NCH - 1][j] = x1 * cs.y + x2 * cs.x; }
    }
#pragma unroll
    for (int d0 = 0; d0 < NCH; ++d0) { u32x4 w; w.x = cvt_pk_bf16(qf[d0][0] * c2, qf[d0][1] * c2); w.y = cvt_pk_bf16(qf[d0][2] * c2, qf[d0][3] * c2); w.z = cvt_pk_bf16(qf[d0][4] * c2, qf[d0][5] * c2); w.w = cvt_pk_bf16(qf[d0][6] * c2, qf[d0][7] * c2);
      qr[d0] = __builtin_bit_cast(bf16x8, w); }
  }
  float m_run, l_run;
  if (MODE == 0) { m_run = -1e30f; l_run = 0.f; } else { m_run = P.sinks[h] * LOG2E; l_run = (hi == 0) ? 1.f : 0.f; }
  f32x16 o[2]; o[0] = f32x16{}; o[1] = f32x16{};
  const int qw0 = q0 + wid * 32;
  ATT_WAIT_BAR0();
  for (int t = t_lo; t < t_hi; ++t) {
    const int s = (t - t_lo) & 1;
    if (t + 1 < t_hi) ATT_DMA(t + 1, s ^ 1);
    const int k0 = t * 64;
    bool active, need_mask;
    if (MODE == 0) { active = (k0 <= qw0 + 31); need_mask = (k0 + 63 > qw0); }
    else { active = (k0 <= qw0 + 31) && (k0 + 63 >= qw0 - 127); need_mask = (k0 + 63 > qw0) || (k0 < qw0 + 31 - 127); }
    if (active) {
      f32x16 p0 = f32x16{}, p1 = f32x16{};
      qkt<NCH>(p0, p1, shm + LDS_K + s * KSLOT, qr, r32, hi);
      if (need_mask) {
#pragma unroll
        for (int r = 0; r < 16; ++r) { const int kv = k0 + crow(r, hi);
          bool bad0 = kv > qpos, bad1 = kv + 32 > qpos;
          if (MODE == 1) { bad0 = bad0 || (kv < qpos - 127); bad1 = bad1 || (kv + 32 < qpos - 127); }
          if (bad0) p0[r] = -1e30f; if (bad1) p1[r] = -1e30f; }
      }
      const float rm = rowmax(p0, p1);
      const float mn = fmaxf(m_run, rm);
      const float alpha = __builtin_amdgcn_exp2f(m_run - mn);
      m_run = mn;
      float psum = 0.f;
#pragma unroll
      for (int r = 0; r < 16; ++r) { p0[r] = __builtin_amdgcn_exp2f(p0[r] - mn); p1[r] = __builtin_amdgcn_exp2f(p1[r] - mn); psum += p0[r] + p1[r]; }
      l_run = l_run * alpha + psum;
      if (hi == 0) wsf[r32] = alpha;
      asm volatile("s_waitcnt lgkmcnt(0)" ::: "memory");
#pragma unroll
      for (int r = 0; r < 16; ++r) { const float f = wsf[crow(r, hi)]; o[0][r] *= f; o[1][r] *= f; }
      u32x4 pw0, pw1, pw2, pw3;
      pw0 = (u32x4){cvt_pk_bf16(p0[0], p0[1]), cvt_pk_bf16(p0[2], p0[3]), cvt_pk_bf16(p0[4], p0[5]), cvt_pk_bf16(p0[6], p0[7])};
      pw1 = (u32x4){cvt_pk_bf16(p0[8], p0[9]), cvt_pk_bf16(p0[10], p0[11]), cvt_pk_bf16(p0[12], p0[13]), cvt_pk_bf16(p0[14], p0[15])};
      pw2 = (u32x4){cvt_pk_bf16(p1[0], p1[1]), cvt_pk_bf16(p1[2], p1[3]), cvt_pk_bf16(p1[4], p1[5]), cvt_pk_bf16(p1[6], p1[7])};
      pw3 = (u32x4){cvt_pk_bf16(p1[8], p1[9]), cvt_pk_bf16(p1[10], p1[11]), cvt_pk_bf16(p1[12], p1[13]), cvt_pk_bf16(p1[14], p1[15])};
      asm volatile("s_waitcnt lgkmcnt(0)" ::: "memory"); ATT_SBAR();
      pv(o, vb0 + s * VSLOT, __builtin_bit_cast(bf16x8, pw0), __builtin_bit_cast(bf16x8, pw1), __builtin_bit_cast(bf16x8, pw2), __builtin_bit_cast(bf16x8, pw3));
    }
    ATT_WAIT_BAR0();
  }
  { auto rr = __builtin_amdgcn_permlane32_swap(__float_as_uint(l_run), __float_as_uint(l_run), false, false); l_run = __uint_as_float(rr[0]) + __uint_as_float(rr[1]); }
  if (hi == 0) wsf[32 + r32] = l_run;
  asm volatile("s_waitcnt lgkmcnt(0)" ::: "memory");
  float rli[16];
#pragma unroll
  for (int r = 0; r < 16; ++r) rli[r] = 1.0f / wsf[32 + crow(r, hi)];
  bf16_t* Ow = Op + (rowbase + q0 + wid * 32) * DM;
  { LAS bf16_t* stg = (LAS bf16_t*)(shm + LDS_OST) + wid * 2048;
#pragma unroll
    for (int r = 0; r < 16; ++r) { const int orow = crow(r, hi);
#pragma unroll
      for (int d0 = 0; d0 < 2; ++d0) stg[orow * 64 + d0 * 32 + r32] = (bf16_t)f2bf(o[d0][r] * rli[r]); }
    asm volatile("s_waitcnt lgkmcnt(0)" ::: "memory");
#pragma unroll
    for (int i = 0; i < 4; ++i) { const int row = i * 8 + (lane >> 3), ch = lane & 7; const u32x4 v = *(const LAS u32x4*)(stg + row * 64 + ch * 8); *(u32x4*)(Ow + (long)row * DM + ch * 8) = v; } }
  asm volatile("s_waitcnt lgkmcnt(0)\n\ts_barrier" ::: "memory");
#undef ATT_DMA
}
}
namespace ret {
using att::crow; using att::glds16; using att::qkt; using att::pv; using att::s16x4;
struct RetPtrs { const bf16_t* proj; const float2* tabr; const float* gn_w; float* U; bf16_t* concat; };
constexpr int R_V = 0, R_K = 32768, R_ST = 65536, R_STG = 0;
constexpr int ST_PITCH = 72;
__device__ __forceinline__ float gamma_log2(int h) { return log2f(1.0f - exp2f(-5.0f - (float)h)); }

__device__ __forceinline__ void dma_v4(const RetPtrs& P, int b, int h, int cp, unsigned lds0, int wid, int lane) {
  const bf16_t* vsrc = P.proj + ((long)b * SEQ + 256 * cp + 16 * (wid & 3) + (lane >> 2)) * NPP + O_RV + h * 64 + (wid >> 2) * 32 + (lane & 3) * 8;
#pragma unroll
  for (int tt = 0; tt < 4; ++tt) glds16(vsrc + (long)tt * 64 * NPP, (unsigned)__builtin_amdgcn_readfirstlane(lds0 + R_V + tt * 8192 + wid * 1024));
}
__device__ __forceinline__ bf16x8 tr_frag(int vb, int off) { s16x4 lo, hi;
  asm volatile("ds_read_b64_tr_b16 %0,%1" : "=&v"(lo) : "v"(vb + off) : "memory");
  asm volatile("ds_read_b64_tr_b16 %0,%1" : "=&v"(hi) : "v"(vb + off + 512) : "memory");
  asm volatile("s_waitcnt lgkmcnt(0)" : "+v"(lo), "+v"(hi) :: "memory");
  return (bf16x8){lo[0], lo[1], lo[2], lo[3], hi[0], hi[1], hi[2], hi[3]}; }

__device__ __forceinline__ void upd_unit(const RetPtrs& P, int b, int h, int cp, LAS char* shm) {
  const int tid = tidx(), lane = tid & 63, hi = lane >> 5; const int wid = __builtin_amdgcn_readfirstlane(tid >> 6);
  const unsigned lds0 = (unsigned)(uintptr_t)shm;
  const float lg = gamma_log2(h);
  dma_v4(P, b, h, cp, lds0, wid, lane);
#pragma unroll
  for (int it = 0; it < 2; ++it) { const int item = tid + 512 * it, row = item >> 2, c = item & 3; const int pos = 256 * cp + row;
    const bf16_t* src = P.proj + ((long)b * SEQ + pos) * NPP + O_RK + h * 64 + 8 * c;
    const bf16x8 lo = *(const bf16x8*)src, hi8 = *(const bf16x8*)(src + 32);
    const float2* tb = P.tabr + pos * 32 + 8 * c;
    const float sc = 0.125f * exp2f(lg * (float)(127 - (row & 127)));
    float y1[8], y2[8];
#pragma unroll
    for (int j = 0; j < 8; ++j) { const float2 cs = tb[j]; const float x1 = bf2f((bf16_t)lo[j]), x2 = bf2f((bf16_t)hi8[j]); y1[j] = (x1 * cs.x - x2 * cs.y) * sc; y2[j] = (x1 * cs.y + x2 * cs.x) * sc; }
    u32x4 w1, w2; w1.x = cvt_pk_bf16(y1[0], y1[1]); w1.y = cvt_pk_bf16(y1[2], y1[3]); w1.z = cvt_pk_bf16(y1[4], y1[5]); w1.w = cvt_pk_bf16(y1[6], y1[7]);
    w2.x = cvt_pk_bf16(y2[0], y2[1]); w2.y = cvt_pk_bf16(y2[2], y2[3]); w2.z = cvt_pk_bf16(y2[4], y2[5]); w2.w = cvt_pk_bf16(y2[6], y2[7]);
    LAS char* dst = shm + R_K + (row >> 6) * 8192 + (row & 63) * 64 + c * 16;
    *(LAS u32x4*)dst = w1; *(LAS u32x4*)(dst + 4096) = w2; }
  asm volatile("s_waitcnt vmcnt(0) lgkmcnt(0)\n\ts_barrier" ::: "memory");
  const int wg = wid >> 2, dt = (wid >> 1) & 1, et = wid & 1;
  const int vbl = ((lane >> 4) & 1) * 32 + (lane & 3) * 8 + (4 * hi + ((lane & 15) >> 2)) * 64;
  f32x16 acc = f32x16{};
#pragma unroll
  for (int tt = 0; tt < 2; ++tt) { const int tile = 2 * wg + tt;
#pragma unroll
    for (int ks = 0; ks < 4; ++ks) { const bf16x8 a = tr_frag((int)lds0 + R_K + tile * 8192 + vbl, dt * 4096 + ks * 1024), bb = tr_frag((int)lds0 + R_V + tile * 8192 + vbl, et * 4096 + ks * 1024);
      acc = __builtin_amdgcn_mfma_f32_32x32x16_bf16(a, bb, acc, 0, 0, 0); } }
  float* Uo = P.U + ((size_t)((b * 4 + h) * 64 + 2 * cp + wg)) * 4096 + (32 * dt) * 64 + 32 * et + (lane & 31);
#pragma unroll
  for (int r = 0; r < 16; ++r) Uo[crow(r, hi) * 64] = acc[r];
  asm volatile("s_waitcnt lgkmcnt(0)\n\ts_barrier" ::: "memory");
}

__device__ __forceinline__ void out_unit(const RetPtrs& P, int b, int h, int cp, LAS char* shm) {
  const int tid = tidx(), lane = tid & 63, r32 = lane & 31, hi = lane >> 5; const int wid = __builtin_amdgcn_readfirstlane(tid >> 6);
  const unsigned lds0 = (unsigned)(uintptr_t)shm;
  const float lg = gamma_log2(h);
  const long rowbase = (long)b * SEQ;
  dma_v4(P, b, h, cp, lds0, wid, lane);
#pragma unroll
  for (int it = 0; it < 2; ++it) { const int item = tid + 512 * it, row = item >> 2, c = item & 3; const int pos = 256 * cp + row;
    const bf16_t* src = P.proj + (rowbase + pos) * NPP + O_RK + h * 64 + 8 * c;
    const bf16x8 lo = *(const bf16x8*)src, hi8 = *(const bf16x8*)(src + 32);
    const float2* tb = P.tabr + pos * 32 + 8 * c;
    float y1[8], y2[8];
#pragma unroll
    for (int j = 0; j < 8; ++j) { const float2 cs = tb[j]; const float x1 = bf2f((bf16_t)lo[j]), x2 = bf2f((bf16_t)hi8[j]); y1[j] = (x1 * cs.x - x2 * cs.y) * 0.125f; y2[j] = (x1 * cs.y + x2 * cs.x) * 0.125f; }
    u32x4 w1, w2; w1.x = cvt_pk_bf16(y1[0], y1[1]); w1.y = cvt_pk_bf16(y1[2], y1[3]); w1.z = cvt_pk_bf16(y1[4], y1[5]); w1.w = cvt_pk_bf16(y1[6], y1[7]);
    w2.x = cvt_pk_bf16(y2[0], y2[1]); w2.y = cvt_pk_bf16(y2[2], y2[3]); w2.z = cvt_pk_bf16(y2[4], y2[5]); w2.w = cvt_pk_bf16(y2[6], y2[7]);
    LAS char* dst = shm + R_K + (row >> 6) * 8192 + c * 1024 + (row & 63) * 16;
    *(LAS u32x4*)dst = w1; *(LAS u32x4*)(dst + 4096) = w2; }
  { const int n0 = 2 * cp; const float cd = exp2f(lg * 128.0f);
    const float* Ub = P.U + (size_t)((b * 4 + h) * 64) * 4096 + tid * 8;
    f32x4 s0a = (f32x4){0.f, 0.f, 0.f, 0.f}, s0b = s0a;
    for (int m = 0; m < n0; ++m) { const f32x4 ua = *(const f32x4*)(Ub + (size_t)m * 4096), ub = *(const f32x4*)(Ub + (size_t)m * 4096 + 4); s0a = s0a * cd + ua; s0b = s0b * cd + ub; }
    const f32x4 ua = *(const f32x4*)(Ub + (size_t)n0 * 4096), ub = *(const f32x4*)(Ub + (size_t)n0 * 4096 + 4);
    const f32x4 s1a = s0a * cd + ua, s1b = s0b * cd + ub;
    const int d = tid >> 3, e0 = (tid & 7) * 8;
    LAS bf16_t* st0 = (LAS bf16_t*)(shm + R_ST), * st1 = st0 + 64 * ST_PITCH;
#pragma unroll
    for (int j = 0; j < 4; ++j) { st0[(e0 + j) * ST_PITCH + d] = (bf16_t)f2bf(s0a[j]); st0[(e0 + 4 + j) * ST_PITCH + d] = (bf16_t)f2bf(s0b[j]);
      st1[(e0 + j) * ST_PITCH + d] = (bf16_t)f2bf(s1a[j]); st1[(e0 + 4 + j) * ST_PITCH + d] = (bf16_t)f2bf(s1b[j]); } }
  const int wg = wid >> 2; const int qi = (wid & 3) * 32 + r32;
  const int qpos = 256 * cp + 128 * wg + qi;
  bf16x8 qr[4], qx[4];
  { const bf16_t* qrow = P.proj + (rowbase + qpos) * NPP + O_RQ + h * 64 + hi * 8;
    float qf[4][8];
#pragma unroll
    for (int d0 = 0; d0 < 4; ++d0) { const bf16x8 v = *(const bf16x8*)(qrow + d0 * 16);
#pragma unroll
      for (int j = 0; j < 8; ++j) qf[d0][j] = bf2f((bf16_t)v[j]); }
#pragma unroll
    for (int d0 = 0; d0 < 2; ++d0) { const float2* tb = P.tabr + qpos * 32 + 16 * d0 + 8 * hi;
#pragma unroll
      for (int j = 0; j < 8; ++j) { const float2 cs = tb[j]; const float x1 = qf[d0][j], x2 = qf[d0 + 2][j]; qf[d0][j] = x1 * cs.x - x2 * cs.y; qf[d0 + 2][j] = x1 * cs.y + x2 * cs.x; } }
    const float xi = exp2f(lg * (float)(qi + 1));
#pragma unroll
    for (int d0 = 0; d0 < 4; ++d0) { u32x4 w, x;
      w.x = cvt_pk_bf16(qf[d0][0], qf[d0][1]); w.y = cvt_pk_bf16(qf[d0][2], qf[d0][3]); w.z = cvt_pk_bf16(qf[d0][4], qf[d0][5]); w.w = cvt_pk_bf16(qf[d0][6], qf[d0][7]);
      x.x = cvt_pk_bf16(qf[d0][0] * xi, qf[d0][1] * xi); x.y = cvt_pk_bf16(qf[d0][2] * xi, qf[d0][3] * xi); x.z = cvt_pk_bf16(qf[d0][4] * xi, qf[d0][5] * xi); x.w = cvt_pk_bf16(qf[d0][6] * xi, qf[d0][7] * xi);
      qr[d0] = __builtin_bit_cast(bf16x8, w); qx[d0] = __builtin_bit_cast(bf16x8, x); } }
  asm volatile("s_waitcnt vmcnt(0) lgkmcnt(0)\n\ts_barrier" ::: "memory");
  f32x16 o[2]; o[0] = f32x16{}; o[1] = f32x16{};
  const int vb0 = (int)(lds0 + R_V) + ((lane >> 4) & 1) * 32 + (lane & 3) * 8 + (4 * hi + ((lane & 15) >> 2)) * 64;
#pragma unroll
  for (int tt = 0; tt < 2; ++tt) {
    if (tt * 64 <= (wid & 3) * 32 + 31) {
      const int tile = 2 * wg + tt;
      f32x16 p0 = f32x16{}, p1 = f32x16{};
      qkt<4>(p0, p1, shm + R_K + tile * 8192, qr, r32, hi);
#pragma unroll
      for (int r = 0; r < 16; ++r) { const int ki = tt * 64 + crow(r, hi);
        const float d0 = (qi >= ki) ? exp2f(lg * (float)(qi - ki)) : 0.f, d1 = (qi >= ki + 32) ? exp2f(lg * (float)(qi - ki - 32)) : 0.f;
        p0[r] *= d0; p1[r] *= d1; }
      u32x4 pw0, pw1, pw2, pw3;
      pw0 = (u32x4){cvt_pk_bf16(p0[0], p0[1]), cvt_pk_bf16(p0[2], p0[3]), cvt_pk_bf16(p0[4], p0[5]), cvt_pk_bf16(p0[6], p0[7])};
      pw1 = (u32x4){cvt_pk_bf16(p0[8], p0[9]), cvt_pk_bf16(p0[10], p0[11]), cvt_pk_bf16(p0[12], p0[13]), cvt_pk_bf16(p0[14], p0[15])};
      pw2 = (u32x4){cvt_pk_bf16(p1[0], p1[1]), cvt_pk_bf16(p1[2], p1[3]), cvt_pk_bf16(p1[4], p1[5]), cvt_pk_bf16(p1[6], p1[7])};
      pw3 = (u32x4){cvt_pk_bf16(p1[8], p1[9]), cvt_pk_bf16(p1[10], p1[11]), cvt_pk_bf16(p1[12], p1[13]), cvt_pk_bf16(p1[14], p1[15])};
      pv(o, vb0 + tile * 8192, __builtin_bit_cast(bf16x8, pw0), __builtin_bit_cast(bf16x8, pw1), __builtin_bit_cast(bf16x8, pw2), __builtin_bit_cast(bf16x8, pw3));
    }
  }
  { const LAS bf16_t* st = (const LAS bf16_t*)(shm + R_ST) + wg * 64 * ST_PITCH;
#pragma unroll
    for (int eb = 0; eb < 2; ++eb)
#pragma unroll
      for (int s = 0; s < 4; ++s) { const bf16x8 bfrag = *(const LAS bf16x8*)(st + (eb * 32 + r32) * ST_PITCH + 16 * s + 8 * hi);
        o[eb] = __builtin_amdgcn_mfma_f32_32x32x16_bf16(qx[s], bfrag, o[eb], 0, 0, 0); } }
  asm volatile("s_waitcnt lgkmcnt(0)\n\ts_barrier" ::: "memory");
  { LAS float* stg = (LAS float*)(shm + R_STG) + wid * (32 * 66);
#pragma unroll
    for (int r = 0; r < 16; ++r) { stg[crow(r, hi) * 66 + r32] = o[0][r]; stg[crow(r, hi) * 66 + 32 + r32] = o[1][r]; }
    asm volatile("s_waitcnt lgkmcnt(0)" ::: "memory");
    const int row = lane >> 1, half = lane & 1;
    float v[32]; float s1 = 0.f;
#pragma unroll
    for (int j = 0; j < 32; ++j) { v[j] = stg[row * 66 + half * 32 + j]; s1 += v[j]; }
    s1 += __shfl_xor(s1, 1);
    const float mu = s1 * (1.0f / 64.0f); float s2 = 0.f;
#pragma unroll
    for (int j = 0; j < 32; ++j) { v[j] -= mu; s2 += v[j] * v[j]; }
    s2 += __shfl_xor(s2, 1);
    const float rs = rsqrtf(s2 * (1.0f / 64.0f) + LN_EPS);
    const long grow = rowbase + 256 * cp + 128 * wg + (wid & 3) * 32 + row;
    const bf16_t* gp = P.proj + grow * NPP + O_RG + h * 64 + half * 32;
    const float* gw = P.gn_w + h * 64 + half * 32;
    bf16_t* op = P.concat + grow * DM + h * 64 + half * 32;
#pragma unroll
    for (int c = 0; c < 4; ++c) { const bf16x8 g8 = *(const bf16x8*)(gp + 8 * c); float ov[8];
#pragma unroll
      for (int j = 0; j < 8; ++j) { const float g = bf2f((bf16_t)g8[j]); const float silu = g / (1.0f + __expf(-g)); ov[j] = v[8 * c + j] * rs * gw[8 * c + j] * silu; }
      u32x4 w; w.x = cvt_pk_bf16(ov[0], ov[1]); w.y = cvt_pk_bf16(ov[2], ov[3]); w.z = cvt_pk_bf16(ov[4], ov[5]); w.w = cvt_pk_bf16(ov[6], ov[7]);
      *(u32x4*)(op + 8 * c) = w; } }
  asm volatile("s_waitcnt lgkmcnt(0)\n\ts_barrier" ::: "memory");
}
}
namespace moe {
constexpr int CAP = TOK;
struct MoePtrs { const float* Y; const float* ln_g; const float* ln_b; const float* router_w; const float* router_bias;
                 float* X1; bf16_t* X1B; unsigned* cnt; unsigned* list; float* gate; };

__device__ __forceinline__ void ln1_router_row(const MoePtrs& P, int row, int lane, const LAS float* rw4, LAS float* xs, LAS unsigned* sel) {
  const f32x4* yr = (const f32x4*)(P.Y + (size_t)row * DM) + lane;
  f32x4 v[4]; float s = 0.f;
#pragma unroll
  for (int j = 0; j < 4; ++j) { v[j] = yr[64 * j]; s += (v[j][0] + v[j][1]) + (v[j][2] + v[j][3]); }
  const float mean = wave_sum(s) * (1.f / DM); float s2 = 0.f;
#pragma unroll
  for (int j = 0; j < 4; ++j) { v[j] = v[j] - mean; s2 += (v[j][0] * v[j][0] + v[j][1] * v[j][1]) + (v[j][2] * v[j][2] + v[j][3] * v[j][3]); }
  const float rstd = rsqrtf(wave_sum(s2) * (1.f / DM) + LN_EPS);
  f32x4* xo = (f32x4*)(P.X1 + (size_t)row * DM) + lane; u32x2* xb = (u32x2*)(P.X1B + (size_t)row * DM) + lane;
#pragma unroll
  for (int j = 0; j < 4; ++j) { const int c0 = 4 * lane + 256 * j;
    const f32x4 g = *(const f32x4*)(P.ln_g + c0), bb = *(const f32x4*)(P.ln_b + c0);
    const f32x4 x = v[j] * rstd * g + bb;
    xo[64 * j] = x; u32x2 o; o.x = pk2(x[0], x[1]); o.y = pk2(x[2], x[3]); xb[64 * j] = o;
    *(LAS f32x4*)(xs + c0) = x; }
  asm volatile("s_waitcnt lgkmcnt(0)" ::: "memory");
  const int e_l = lane & 15, kq = lane >> 4; float acc = 0.f;
#pragma unroll 8
  for (int i = 0; i < 64; ++i) { const f32x4 x = *(const LAS f32x4*)(xs + 16 * i + 4 * kq); const f32x4 w = *(const LAS f32x4*)(rw4 + ((4 * i + kq) * 16 + e_l) * 4);
    acc = fmaf(x[0], w[0], acc); acc = fmaf(x[1], w[1], acc); acc = fmaf(x[2], w[2], acc); acc = fmaf(x[3], w[3], acc); }
  acc += __shfl_xor(acc, 16); acc += __shfl_xor(acc, 32);
  float sc[16], bi[16];
#pragma unroll
  for (int e = 0; e < 16; ++e) { const float lg = __shfl(acc, e); sc[e] = 1.f / (1.f + expf(-lg)); bi[e] = sc[e] + P.router_bias[e]; }
  int bestg = 0; float bestgs = -INFINITY;
#pragma unroll
  for (int gI = 0; gI < 4; ++gI) { float m1 = -INFINITY, m2 = -INFINITY;
#pragma unroll
    for (int k = 0; k < 4; ++k) { const float x = bi[gI * 4 + k]; if (x > m1) { m2 = m1; m1 = x; } else if (x > m2) { m2 = x; } }
    const float gs = m1 + m2; if (gs > bestgs) { bestgs = gs; bestg = gI; } }
  int i1 = 0, i2 = 0; float m1 = -INFINITY, m2 = -INFINITY, s1 = 0.f, s2v = 0.f;
#pragma unroll
  for (int e = 0; e < 16; ++e) { if ((e >> 2) == bestg) { const float x = bi[e]; if (x > m1) { m2 = m1; i2 = i1; s2v = s1; m1 = x; i1 = e; s1 = sc[e]; } else if (x > m2) { m2 = x; i2 = e; s2v = sc[e]; } } }
  if (lane == 0) { const float inv = 1.f / (s1 + s2v); sel[0] = (unsigned)i1; sel[1] = (unsigned)i2; ((LAS float*)sel)[2] = s1 * inv; ((LAS float*)sel)[3] = s2v * inv; }
}
__device__ __forceinline__ void p5_phase(const MoePtrs& P, LAS char* shm, int vcu, int G) {
  const int tid = tidx(), lane = tid & 63, wave = tid >> 6;
  LAS float* rw4 = (LAS float*)shm; LAS float* xs = (LAS float*)(shm + 65536) + wave * 1024;
  LAS unsigned* sel = (LAS unsigned*)(shm + 98304);
  LAS unsigned* wbase = sel + 4 * 128;
  for (int i = tid; i < DM * 16; i += 512) { const int k = i >> 4, e = i & 15; rw4[((k >> 2) * 16 + e) * 4 + (k & 3)] = P.router_w[i]; }
  __syncthreads();
  const int rows_per_wg = (TOK + G - 1) / G;
  const int row0 = vcu * rows_per_wg; int nrows = TOK - row0; if (nrows > rows_per_wg) nrows = rows_per_wg; if (nrows < 0) nrows = 0;
  for (int r = wave; r < nrows; r += 8) ln1_router_row(P, row0 + r, lane, rw4, xs, sel + 4 * r);
  __syncthreads();
  if (tid < 16) { unsigned c = 0; for (int r = 0; r < nrows; ++r) c += (sel[4 * r] == (unsigned)tid) + (sel[4 * r + 1] == (unsigned)tid);
    wbase[tid] = c ? atomicAdd(P.cnt + 64 * tid, c) : 0u; }
  __syncthreads();
  if (tid < 2 * nrows) { const int r = tid >> 1, sl = tid & 1; const unsigned e = sel[4 * r + sl]; unsigned rank = 0;
    for (int q = 0; q < tid; ++q) rank += (sel[4 * (q >> 1) + (q & 1)] == e);
    const size_t pos = (size_t)e * CAP + wbase[e] + rank;
    P.list[pos] = (unsigned)(row0 + r) * 2u + (unsigned)sl; P.gate[pos] = ((LAS float*)sel)[4 * r + 2 + sl]; }
  __syncthreads();
}

template <int MODE>
struct MoeOrder {
  static constexpr int NPN = MODE == 0 ? 2 : 4, LDA2 = (MODE == 0 ? DM : DEXP) * 2;
  static constexpr size_t BSTRIDE_E = MODE == 0 ? (size_t)512 * DM * 2 : (size_t)DM * DEXP * 2, BSTRIDE_PN = MODE == 0 ? (size_t)256 * DM * 2 : (size_t)256 * DEXP * 2;
  const unsigned* __restrict__ cnt; const unsigned* __restrict__ list; const char* A; const char* Bt;
  __device__ __forceinline__ bool next(int i, pg8::Unit& u) const {
    const int L = i * (int)gridDim.x + (int)blockIdx.x; const int tile = L / NPN; u.pn = L % NPN; u.pm = tile;
    int acc = 0, e = -1, mt = 0, valid = 0;
#pragma unroll
    for (int k = 0; k < NEXP; ++k) { const int cn = __builtin_amdgcn_readfirstlane((int)cnt[64 * k]); const int nt = (cn + 255) >> 8; if (e < 0 && tile < acc + nt) { e = k; mt = tile - acc; valid = cn - mt * 256; } acc += nt; }
    if (e < 0) return false;
    u.e = e; u.mt = mt; u.valid = valid > 256 ? 256 : valid; u.pad = 0;
    u.pA = MODE == 1 ? A + (size_t)tile * 256 * LDA2 : A;
    u.pB = Bt + (size_t)e * BSTRIDE_E + (size_t)u.pn * BSTRIDE_PN;
    return true;
  }
  __device__ __forceinline__ unsigned rowoff(const pg8::Unit& u, int r) const {
    unsigned slot = 0u; if (r < u.valid) slot = list[(size_t)u.e * CAP + u.mt * 256 + r];
    return (slot >> 1) * (unsigned)LDA2; }
};
struct EpiSwiglu {
  static constexpr bool PERM = true;
  bf16_t* A2; const float* gate;
  __device__ __forceinline__ void operator()(const f32x4 (&acc)[2][2][4][2], const pg8::Unit& u, int wr, int wc, int fr, int fq) const {
    { const int l_ = tidx() & 63; fr = l_ & 15; fq = l_ >> 4; }
    const int col0 = u.pn * 128 + wc * 32 + 8 * fq; const int lane = fq * 16 + fr;
    const int rb = wr * 64 + lane; const size_t gb = (size_t)u.e * CAP + u.mt * 256;
    float g0 = 0.f, g1 = 0.f; if (rb < u.valid) g0 = gate[gb + rb]; if (128 + rb < u.valid) g1 = gate[gb + 128 + rb];
#pragma unroll
    for (int ai = 0; ai < 2; ++ai)
#pragma unroll
      for (int m = 0; m < 4; ++m) { const int r = ai * 128 + wr * 64 + m * 16 + fr;
        const float g = __shfl(ai ? g1 : g0, m * 16 + fr);
        float a[8];
#pragma unroll
        for (int n = 0; n < 2; ++n)
#pragma unroll
          for (int i = 0; i < 4; ++i) { const float h1 = acc[ai][0][m][n][i], h2 = acc[ai][1][m][n][i]; a[4 * n + i] = h1 / (1.f + __expf(-h1)) * h2 * g; }
        u32x4 w; w.x = cvt_pk_bf16(a[0], a[1]); w.y = cvt_pk_bf16(a[2], a[3]); w.z = cvt_pk_bf16(a[4], a[5]); w.w = cvt_pk_bf16(a[6], a[7]);
        *(u32x4*)(A2 + ((size_t)u.pm * 256 + r) * 256 + col0) = w;
        asm volatile("" ::: "memory"); }
  }
};
struct EpiScatter {
  static constexpr bool PERM = true;
  bf16_t* YE; const unsigned* list;
  __device__ __forceinline__ void operator()(const f32x4 (&acc)[2][2][4][2], const pg8::Unit& u, int wr, int wc, int fr, int fq) const {
    { const int l_ = tidx() & 63; fr = l_ & 15; fq = l_ >> 4; }
    const int col0 = u.pn * 256 + wc * 32 + 8 * fq; const int lane = fq * 16 + fr;
    const int rb = wr * 64 + lane; const size_t gb = (size_t)u.e * CAP + u.mt * 256;
    unsigned s0 = (unsigned)(2 * TOK), s1 = (unsigned)(2 * TOK); if (rb < u.valid) s0 = list[gb + rb]; if (128 + rb < u.valid) s1 = list[gb + 128 + rb];
#pragma unroll
    for (int ai = 0; ai < 2; ++ai)
#pragma unroll
      for (int m = 0; m < 4; ++m) {
        const unsigned slot = (unsigned)__shfl((int)(ai ? s1 : s0), m * 16 + fr);
        { bf16_t* rowp = YE + (size_t)slot * DM + col0;
#pragma unroll
          for (int bj = 0; bj < 2; ++bj) { const f32x4 v0 = acc[ai][bj][m][0], v1 = acc[ai][bj][m][1];
            u32x4 w; w.x = cvt_pk_bf16(v0[0], v0[1]); w.y = cvt_pk_bf16(v0[2], v0[3]); w.z = cvt_pk_bf16(v1[0], v1[1]); w.w = cvt_pk_bf16(v1[2], v1[3]);
            *(u32x4*)(rowp + bj * 128) = w; } }
        asm volatile("" ::: "memory"); }
  }
};
struct Ln2Ptrs { const float* X1; const bf16_t* YE; const float* g; const float* b; float* out; bf16_t* XB; };
__device__ __forceinline__ void ln2_row(const Ln2Ptrs& P, int row, int lane) {
  const f32x4* xr = (const f32x4*)(P.X1 + (size_t)row * DM) + lane;
  const u32x2* y0 = (const u32x2*)(P.YE + (size_t)row * 2 * DM) + lane; const u32x2* y1 = y0 + DM / 4;
  f32x4 v[4]; float s = 0.f;
#pragma unroll
  for (int j = 0; j < 4; ++j) { const f32x4 x = xr[64 * j]; const u32x2 a = y0[64 * j], bq = y1[64 * j];
    f32x4 y; y[0] = __uint_as_float(a.x << 16) + __uint_as_float(bq.x << 16); y[1] = __uint_as_float(a.x & 0xffff0000u) + __uint_as_float(bq.x & 0xffff0000u);
    y[2] = __uint_as_float(a.y << 16) + __uint_as_float(bq.y << 16); y[3] = __uint_as_float(a.y & 0xffff0000u) + __uint_as_float(bq.y & 0xffff0000u);
    v[j] = x * ALPHA + y; s += (v[j][0] + v[j][1]) + (v[j][2] + v[j][3]); }
  const float mean = wave_sum(s) * (1.f / DM); float s2 = 0.f;
#pragma unroll
  for (int j = 0; j < 4; ++j) { v[j] = v[j] - mean; s2 += (v[j][0] * v[j][0] + v[j][1] * v[j][1]) + (v[j][2] * v[j][2] + v[j][3] * v[j][3]); }
  const float rstd = rsqrtf(wave_sum(s2) * (1.f / DM) + LN_EPS);
  f32x4* xo = (f32x4*)(P.out + (size_t)row * DM) + lane; u32x2* xb = (u32x2*)(P.XB + (size_t)row * DM) + lane;
#pragma unroll
  for (int j = 0; j < 4; ++j) { const int c0 = 4 * lane + 256 * j;
    const f32x4 g = *(const f32x4*)(P.g + c0), bb = *(const f32x4*)(P.b + c0);
    const f32x4 x = v[j] * rstd * g + bb;
    xo[64 * j] = x; u32x2 o; o.x = pk2(x[0], x[1]); o.y = pk2(x[2], x[3]); xb[64 * j] = o; }
}
}
#ifndef PROBE_PHASE
#define PROBE_PHASE 0
#endif
#define NREP(p) ((PROBE_PHASE == (p)) ? 2 : 1)
constexpr int LDS_BYTES = 147456;
constexpr int NTHREADS = 512;
constexpr int MISC_OFF = 131072;
constexpr int CW_QCTR = 64;
constexpr int CW_CNT = 8192;
constexpr int CW_BAR = 4096;

typedef GAS unsigned gu32;
#define RLX_AGENT __ATOMIC_RELAXED, __HIP_MEMORY_SCOPE_AGENT
#define XB_TMO      128
#define XB_XCNT(j)  (256  + 64 * (j))
#define XB_XSUB(j)  (1280 + 64 * (j))
#define XB_XGEN(j)  (2304 + 64 * (j))
#define XB_TOP      3328
#define XB_TOPGEN   3392
#define XCD_BAR_WORDS 3456
#define XB_SPIN_CAP (1u << 20)
__device__ __forceinline__ unsigned xb_ld(gu32* p)              { return __hip_atomic_load(p, __ATOMIC_RELAXED, __HIP_MEMORY_SCOPE_AGENT); }
__device__ __forceinline__ unsigned xb_add(gu32* p, unsigned v) { return __hip_atomic_fetch_add(p, v, __ATOMIC_RELAXED, __HIP_MEMORY_SCOPE_AGENT); }
__device__ __forceinline__ unsigned xb_xcc_id() { return (unsigned)__builtin_amdgcn_s_getreg((3 << 11) | 20) & 0xFu; }
#define XB_SPIN(cond, bar) do { unsigned _sp = 0; while (cond) { __builtin_amdgcn_s_sleep(1); \
    if ((++_sp & 255u) == 0u) { if (xb_ld(&(bar)[XB_TMO])) break; if (_sp > XB_SPIN_CAP) { (void)xb_add(&(bar)[XB_TMO], 1u); break; } } } } while (0)
struct XcdBarrier { gu32* bar; unsigned x; volatile LAS unsigned* st; };
__device__ __forceinline__ XcdBarrier xcd_barrier_post(gu32* bar, volatile LAS unsigned* st) {
    XcdBarrier b; b.bar = bar; b.x = xb_xcc_id(); b.st = st;
    if (tidx() == 0) (void)xb_add(&bar[XB_XCNT(b.x)], 1u);
    return b;
}
__device__ __forceinline__ void xcd_barrier_complete(gu32* bar, unsigned x, unsigned& nloc, unsigned& nx) {
    const unsigned G = gridDim.x * gridDim.y * gridDim.z;
    unsigned sum, cnt, mine, sp = 0u;
    for (;;) {
        sum = 0u; cnt = 0u; mine = 0u;
#pragma unroll
        for (unsigned j = 0; j < 16; ++j) { const unsigned c = xb_ld(&bar[XB_XCNT(j)]); sum += c; cnt += (c > 0u) ? 1u : 0u; mine = (j == x) ? c : mine; }
        if (sum == G) break;
        __builtin_amdgcn_s_sleep(1);
        if ((++sp & 255u) == 0u) { if (xb_ld(&bar[XB_TMO])) break; if (sp > XB_SPIN_CAP) { (void)xb_add(&bar[XB_TMO], 1u); break; } }
    }
    nloc = mine > 0u ? mine : 1u; nx = cnt > 0u ? cnt : 1u;
}
__device__ __forceinline__ void xcd_barrier(const XcdBarrier& b) {
    asm volatile("s_waitcnt vmcnt(0)" ::: "memory");
    __syncthreads();
    if (tidx() == 0) {
        gu32* bar = b.bar; unsigned bx_ = b.x;
        asm volatile("" : "+s"(bar), "+s"(bx_));
        __builtin_amdgcn_s_waitcnt(0);
        unsigned nloc = b.st[0], nx = b.st[1];
        if (nloc == 0u) { xcd_barrier_complete(bar, bx_, nloc, nx); b.st[0] = nloc; b.st[1] = nx; }
        const unsigned old = xb_add(&bar[XB_XSUB(bx_)], 1u);
        const unsigned gen = old / nloc;
        if (old + 1u == (gen + 1u) * nloc) {
            __builtin_amdgcn_fence(__ATOMIC_RELEASE, "agent");
            asm volatile("s_waitcnt vmcnt(0)" ::: "memory");
            const unsigned og = xb_add(&bar[XB_TOP], 1u);
            const unsigned tg = og / nx;
            if (og + 1u == (tg + 1u) * nx) xb_add(&bar[XB_TOPGEN], 1u);
            else XB_SPIN(xb_ld(&bar[XB_TOPGEN]) == tg, bar);
            __builtin_amdgcn_fence(__ATOMIC_ACQUIRE, "agent");
            xb_add(&bar[XB_XGEN(bx_)], 1u);
            asm volatile("s_waitcnt vmcnt(0)" ::: "memory");
        } else {
            XB_SPIN(xb_ld(&bar[XB_XGEN(bx_)]) == gen, bar);
            __builtin_amdgcn_fence(__ATOMIC_ACQUIRE, "agent");
            asm volatile("s_waitcnt vmcnt(0)" ::: "memory");
        }
    }
    __syncthreads();
}

struct Args { const float* in[17]; float* out; unsigned char* ws; };
#define CAS __attribute__((address_space(4)))
__device__ __forceinline__ const CAS char* kargs() { const CAS char* kp = (const CAS char*)__builtin_amdgcn_kernarg_segment_ptr(); asm volatile("" : "+s"(kp)); return kp; }

__global__ void __launch_bounds__(NTHREADS, 2) mk_fwd(Args a) {
    extern __shared__ __attribute__((aligned(16))) unsigned char lds[];
    LAS unsigned char* L = (LAS unsigned char*)lds;
    LAS char* shm = (LAS char*)lds;
    volatile LAS unsigned* MISC = (volatile LAS unsigned*)(L + MISC_OFF);
#define lane (tidx() & 63)
#define wave (__builtin_amdgcn_readfirstlane(tidx() >> 6))
    const int G = gridDim.x, bx = blockIdx.x;
    const int vcu = (G % 8 == 0) ? (bx % 8) * (G / 8) + bx / 8 : bx;
    for (int u = tidx(); u < (LDS_BYTES - MISC_OFF) / 4; u += NTHREADS) ((LAS unsigned*)(L + MISC_OFF))[u] = 0u;
    __syncthreads();

#define KPTR(off, ET) ((ET*)(ET GAS*)(*(const unsigned long long CAS*)(kargs() + (off))))
#define IN_(i) KPTR(8 * (i), const float)
#define g_x_in IN_(0)
#define g_w_in IN_(1)
#define g_ret_gn_w IN_(2)
#define g_swa_sinks IN_(3)
#define g_qn_w IN_(4)
#define g_kvn_w IN_(5)
#define g_w_uq IN_(6)
#define g_w_ukv IN_(7)
#define g_w_out IN_(8)
#define g_ln1_g IN_(9)
#define g_ln1_b IN_(10)
#define g_router_w IN_(11)
#define g_router_bias IN_(12)
#define g_wgu IN_(13)
#define g_wd IN_(14)
#define g_ln2_g IN_(15)
#define g_ln2_b IN_(16)
#define g_out KPTR(136, float)
#define g_ws KPTR(144, unsigned char)
#define g_CTL ((unsigned*)(g_ws + WS_CTL))
#define g_XB ((bf16_t*)(g_ws + WS_R0))
#define g_PROJ ((bf16_t*)(g_ws + WS_R1))
#define g_Y ((float*)(g_ws + WS_R1))
#define g_QM ((bf16_t*)(g_ws + WS_QM))
#define g_KVM ((bf16_t*)(g_ws + WS_KVM))
#define g_KPE ((bf16_t*)(g_ws + WS_KPE))
#define g_CONCAT ((bf16_t*)(g_ws + WS_R3))
#define g_X1 ((float*)(g_ws + WS_X1))
#define g_TABR ((const float2*)(g_ws + WS_TABR))
#define g_TABM ((const float2*)(g_ws + WS_TABM))
#define g_X1B ((bf16_t*)(g_ws + WS_R0))
#define g_A2 ((bf16_t*)(g_ws + WS_A2))
#define g_YE ((bf16_t*)(g_ws + WS_YE))
#define g_list ((unsigned*)(g_ws + WS_LIST))
#define g_gate ((float*)(g_ws + WS_GATE))

    XcdBarrier bar = xcd_barrier_post((gu32*)(g_CTL + CW_BAR), MISC + 8);
#define GRID_BAR() do { xcd_barrier(bar); if (PROBE_PHASE == 10) xcd_barrier(bar); } while (0)

    for (int rep_ = 0; rep_ < NREP(9); ++rep_)
    { P0Args pa; pa.x = g_x_in; pa.w_in = g_w_in; pa.qn_w = g_qn_w; pa.kvn_w = g_kvn_w; pa.w_uq = g_w_uq; pa.w_ukv = g_w_ukv; pa.w_out = g_w_out; pa.ws = g_ws;
      p0_all(pa, L, vcu, G);
      p0_experts(g_wgu, g_wd, g_ws, (LAS float*)(L + wave * 16384), vcu * 8 + wave, G * 8, lane); }
    GRID_BAR();

    for (int l = 0; l < DEPTH; ++l) {
        for (int rep_ = 0; rep_ < NREP(1); ++rep_)
        { pg8::Gemm g{g_XB, (const bf16_t*)(g_ws + WS_WIN) + (size_t)l * NPP * DM, DM, DM, DM, 0}; pg8::EpiBf16 E{g_PROJ, NPP, 0};
          pg8::StaticOrder S; S.init(g, TOK, NPP, G, bx);
          pg8::gemm_phase<pg8::EpiBf16, pg8::StaticOrder, true, false>(L, g, S, E); }
        GRID_BAR();
        for (int rep_ = 0; rep_ < NREP(2); ++rep_) {
        { pg8::Gemm g{g_PROJ + O_CQ, (const bf16_t*)(g_ws + WS_WUQ) + (size_t)l * NQMP * 384, NPP, 384, 384, 0}; pg8::EpiRms E{g_QM, NQMP, NPP, g_PROJ + O_CQ, 384, RMS_EPS};
          pg8::StaticOrder S; S.init(g, TOK, NQMP, G, bx);
          pg8::gemm_phase<pg8::EpiRms, pg8::StaticOrder, true, false>(L, g, S, E); }
        { pg8::Gemm g{g_PROJ + O_CKV, (const bf16_t*)(g_ws + WS_WUKV) + (size_t)l * NKVM * 256, NPP, 256, 256, 0}; pg8::EpiRms E{g_KVM, NKVM, NPP, g_PROJ + O_CKV, 256, RMS_EPS};
          pg8::StaticOrder S; S.init(g, TOK, NKVM, G, G - 1 - bx);
          pg8::gemm_phase<pg8::EpiRms, pg8::StaticOrder, true, false>(L, g, S, E); }
        for (int idx = vcu * NTHREADS + tidx(); idx < TOK * 16; idx += G * NTHREADS) {
          const int t = idx >> 4, i = idx & 15, pos = t % SEQ; const bf16_t* p = g_PROJ + (size_t)t * NPP + O_KR; const float2 cs = g_TABM[pos * 16 + i];
          const float x1 = bf2f(p[i]), x2 = bf2f(p[i + 16]);
          g_KPE[(size_t)t * 32 + i] = (bf16_t)f2bf(x1 * cs.x - x2 * cs.y); g_KPE[(size_t)t * 32 + i + 16] = (bf16_t)f2bf(x1 * cs.y + x2 * cs.x); }
        { ret::RetPtrs rp; rp.proj = g_PROJ; rp.tabr = g_TABR; rp.gn_w = g_ret_gn_w + l * 256; rp.U = (float*)(g_ws + WS_U); rp.concat = g_CONCAT;
          for (int u = G - 1 - bx; u < 256; u += G) ret::upd_unit(rp, u >> 7, (u >> 5) & 3, u & 31, shm); }
        }
        GRID_BAR();
        { att::AttnPtrs ap; ap.proj = g_PROJ; ap.qm = g_QM; ap.kvm = g_KVM; ap.kpe = g_KPE; ap.tabm = g_TABM; ap.sinks = g_swa_sinks + l * 6; ap.concat = g_CONCAT;
          ret::RetPtrs rp; rp.proj = g_PROJ; rp.tabr = g_TABR; rp.gn_w = g_ret_gn_w + l * 256; rp.U = (float*)(g_ws + WS_U); rp.concat = g_CONCAT;
          for (int rep_ = 0; rep_ < NREP(3); ++rep_)
          for (;;) {
            if (tidx() == 0) MISC[0] = atomicAdd(g_CTL + CW_QCTR + 64 * l + rep_, 1u);
            __syncthreads();
            const unsigned idx = MISC[0];
            __syncthreads();
            if (idx >= 1024u) break;
            if (idx < 384u) { const int qb = 31 - (int)(idx / 12u), bh = (int)(idx % 12u); att::attn_unit<0>(ap, bh / 6, bh % 6, qb, shm); }
            else if (idx < 768u) { const unsigned i2 = idx - 384u; const int qb = (int)(i2 / 12u), bh = (int)(i2 % 12u); att::attn_unit<1>(ap, bh / 6, bh % 6, qb, shm); }
            else { const int u = (int)(idx - 768u); ret::out_unit(rp, u >> 7, (u >> 5) & 3, u & 31, shm); }
          } }
        GRID_BAR();
        for (int rep_ = 0; rep_ < NREP(4); ++rep_)
        { pg8::Gemm g{g_CONCAT, (const bf16_t*)(g_ws + WS_WOUT) + (size_t)l * DM * DM, DM, DM, DM, 0}; pg8::EpiResid E{(l == 0) ? g_x_in : (const float*)g_out, g_Y, DM, ALPHA};
          pg8::StaticOrder S; S.init(g, TOK, DM, G, bx);
          pg8::gemm_phase<pg8::EpiResid, pg8::StaticOrder, true, false>(L, g, S, E); }
        GRID_BAR();
#define g_cnt (g_CTL + CW_CNT + 2048 * l)
        if (PROBE_PHASE == 5) { moe::MoePtrs mp; mp.Y = g_Y; mp.ln_g = g_ln1_g + l * DM; mp.ln_b = g_ln1_b + l * DM; mp.router_w = g_router_w; mp.router_bias = g_router_bias; mp.X1 = g_X1; mp.X1B = g_X1B;
          mp.cnt = g_CTL + CW_CNT + 2048 * l + 1024; mp.list = (unsigned*)(g_ws + WS_R1 + 64 * MiB); mp.gate = (float*)(g_ws + WS_R1 + 65 * MiB);
          moe::p5_phase(mp, shm, vcu, G); }
        { moe::MoePtrs mp; mp.Y = g_Y; mp.ln_g = g_ln1_g + l * DM; mp.ln_b = g_ln1_b + l * DM; mp.router_w = g_router_w; mp.router_bias = g_router_bias; mp.X1 = g_X1; mp.X1B = g_X1B; mp.cnt = g_cnt; mp.list = g_list; mp.gate = g_gate;
          moe::p5_phase(mp, shm, vcu, G); }
        GRID_BAR();
        for (int rep_ = 0; rep_ < NREP(6); ++rep_)
        { moe::MoeOrder<0> S; S.cnt = g_cnt; S.list = g_list; S.A = (const char*)g_X1B; S.Bt = (const char*)(g_ws + WS_WGU);
          pg8::Gemm g{nullptr, nullptr, DM, DM, DM, 0}; moe::EpiSwiglu E{g_A2, g_gate};
          pg8::gemm_phase<moe::EpiSwiglu, moe::MoeOrder<0>, true, true>(L, g, S, E); }
        GRID_BAR();
        for (int rep_ = 0; rep_ < NREP(7); ++rep_)
        { moe::MoeOrder<1> S; S.cnt = g_cnt; S.list = g_list; S.A = (const char*)g_A2; S.Bt = (const char*)(g_ws + WS_WD);
          pg8::Gemm g{nullptr, nullptr, DEXP, DEXP, DEXP, 0}; moe::EpiScatter E{g_YE, g_list};
          pg8::gemm_phase<moe::EpiScatter, moe::MoeOrder<1>, true, false>(L, g, S, E); }
        GRID_BAR();
        for (int rep_ = 0; rep_ < NREP(8); ++rep_)
        { moe::Ln2Ptrs lp; lp.X1 = g_X1; lp.YE = g_YE; lp.g = g_ln2_g + l * DM; lp.b = g_ln2_b + l * DM; lp.out = g_out; lp.XB = g_XB;
          for (int row = vcu * 8 + wave; row < TOK; row += G * 8) moe::ln2_row(lp, row, lane); }
        if (l + 1 < DEPTH) {
          p0_experts(g_wgu + (size_t)(l + 1) * NEXP * DM * 512, g_wd + (size_t)(l + 1) * NEXP * DEXP * DM, g_ws, (LAS float*)(L + wave * 16384), vcu * 8 + wave, G * 8, lane);
          GRID_BAR();
        }
    }
    if (xb_ld((gu32*)(g_CTL + CW_BAR + XB_TMO)) != 0u && bx == 0 && tidx() == 0) g_out[0] = __builtin_nanf("");
#undef g_out
#undef g_ws
#undef g_list
#undef g_gate
#undef g_cnt
}

extern "C" void kernel_launch(void* const* d_in, const int* in_sizes, int n_in, void* d_out, int out_size, void* d_ws, size_t ws_size, hipStream_t stream) {
    static int grid = 0;
    if (grid == 0) {
        if (n_in != 17 || ws_size < WS_END || out_size != TOK * DM) { fprintf(stderr, "kernel_launch: unexpected problem (n_in %d, ws %zu, out %d); nothing launched\n", n_in, ws_size, out_size); grid = -1; return; }
        int dev = 0, cus = 0, per_cu = 0;
        if (hipGetDevice(&dev) != hipSuccess || hipDeviceGetAttribute(&cus, hipDeviceAttributeMultiprocessorCount, dev) != hipSuccess) { grid = -1; return; }
        if (hipFuncSetAttribute((const void*)mk_fwd, hipFuncAttributeMaxDynamicSharedMemorySize, LDS_BYTES) != hipSuccess) { fprintf(stderr, "kernel_launch: hipFuncSetAttribute failed\n"); grid = -1; return; }
        if (hipOccupancyMaxActiveBlocksPerMultiprocessor(&per_cu, (const void*)mk_fwd, NTHREADS, LDS_BYTES) != hipSuccess || per_cu < 1) { fprintf(stderr, "kernel_launch: occupancy query says %d workgroups per CU\n", per_cu); (void)hipGetLastError(); grid = -1; return; }
        grid = cus;
    }
    if (grid < 0) return;
    (void)hipMemsetAsync((char*)d_ws + WS_CTL, 0, CTL_ZERO_BYTES, stream);
    Args a{};
    for (int i = 0; i < 17; ++i) a.in[i] = (const float*)d_in[i];
    a.out = (float*)d_out; a.ws = (unsigned char*)d_ws;
    hipLaunchKernelGGL(mk_fwd, dim3(grid), dim3(NTHREADS), LDS_BYTES, stream, a);
}
```

```cpp
#define PROBE_PHASE 0
#include <hip/hip_runtime.h>
#include <cstdio>
#include <cstdint>
#include <math.h>

constexpr int BATCH = 2, SEQ = 8192, TOK = BATCH * SEQ, DM = 1024, DEPTH = 2;
constexpr int NP = 2336, NPP = 2560;
constexpr int O_RQ = 0, O_RK = 256, O_RV = 512, O_RG = 768, O_SQ = 1024, O_SK = 1408, O_SV = 1536, O_CQ = 1664, O_CKV = 2048, O_KR = 2304;
constexpr int NQM = 576, NQMP = 768, NKVM = 768;
constexpr int NEXP = 16, DEXP = 256;
constexpr float LN_EPS = 1e-5f, RMS_EPS = 1e-6f;
constexpr float ALPHA = 1.4142135623730951f;
constexpr float LOG2E = 1.4426950408889634f;

typedef unsigned short bf16_t;
typedef short bf16x8 __attribute__((ext_vector_type(8)));
typedef float f32x4 __attribute__((ext_vector_type(4)));
typedef float f32x16 __attribute__((ext_vector_type(16)));
typedef unsigned u32x4 __attribute__((ext_vector_type(4)));
typedef unsigned u32x2 __attribute__((ext_vector_type(2)));
#define LAS __attribute__((address_space(3)))
#define GAS __attribute__((address_space(1)))

constexpr size_t MiB = 1u << 20;
constexpr size_t WS_CTL = 0, CTL_ZERO_BYTES = 1 * MiB;
constexpr size_t WS_LIST = 1 * MiB, WS_GATE = 2 * MiB;
constexpr size_t WS_TABR = 3 * MiB, WS_TABM = 5 * MiB;
constexpr size_t WS_WIN = 6 * MiB;
constexpr size_t WS_WUQ = 16 * MiB;
constexpr size_t WS_WUKV = 17 * MiB + 256 * 1024;
constexpr size_t WS_WOUT = 18 * MiB;
constexpr size_t WS_WGU = 22 * MiB;
constexpr size_t WS_WD = 38 * MiB;
constexpr size_t WS_R0 = 46 * MiB;
constexpr size_t WS_R1 = 78 * MiB;
constexpr size_t WS_A2 = WS_R1, WS_YE = WS_R1 + 18 * MiB;
constexpr size_t WS_R2 = 162 * MiB;
constexpr size_t WS_QM = WS_R2, WS_KVM = WS_R2 + 24 * MiB, WS_KPE = WS_R2 + 48 * MiB, WS_U = WS_R2 + 49 * MiB;
constexpr size_t WS_R3 = 219 * MiB;
constexpr size_t WS_X1 = WS_R2;
constexpr size_t WS_PARTS = 251 * MiB;
constexpr size_t WS_END = 252 * MiB;
static_assert(WS_WUQ + 2 * 768 * 384 * 2 <= WS_WUKV && WS_WUKV + 2 * 768 * 256 * 2 <= WS_WOUT, "ws map");
static_assert(WS_U + 8 * MiB <= WS_R3 && WS_X1 + 64 * MiB <= WS_END && WS_YE + 64 * MiB <= WS_R2, "ws map");

__device__ __forceinline__ float bf2f(bf16_t v) { return __uint_as_float(((unsigned)v) << 16); }
__device__ __forceinline__ unsigned f2bf(float f) { unsigned u = __float_as_uint(f); return (u + 0x7fffu + ((u >> 16) & 1u)) >> 16; }
__device__ __forceinline__ unsigned pk2(float lo, float hi) { return f2bf(lo) | (f2bf(hi) << 16); }
__device__ __forceinline__ unsigned cvt_pk_bf16(float lo, float hi) { unsigned r; asm volatile("v_cvt_pk_bf16_f32 %0, %1, %2" : "=v"(r) : "v"(lo), "v"(hi)); return r; }
__device__ __forceinline__ float wave_sum(float v) {
#pragma unroll
  for (int o = 1; o < 64; o <<= 1) v += __shfl_xor(v, o);
  return v;
}
#define LDS_WAIT() asm volatile("s_waitcnt lgkmcnt(0)" ::: "memory")
#define VM_WAIT() asm volatile("s_waitcnt vmcnt(0)" ::: "memory")

__device__ __forceinline__ int tidx() { int t = (int)threadIdx.x; asm volatile("" : "+v"(t)); return t; }
namespace pg8 {
constexpr int BM = 256, BK = 64, HALF = 128, HTB = HALF * BK * 2  , STAGE_BYTES = 8 * HTB, NXCD = 8, WGM = 8;

__host__ __device__ __forceinline__ int lds_byte(int r, int c) { const int st = (r >> 4) * 2 + (c >> 5), rr = r & 15, cc = c & 31, ob = rr * 64 + cc * 2; return st * 1024 + (ob ^ (((ob >> 9) & 1) << 5)); }
__host__ __device__ __forceinline__ void stage_rc(int b, int& R, int& C) { const int st = b / 1024, sb = b % 1024, swz = sb ^ (((sb >> 9) & 1) << 5); R = (st >> 1) * 16 + swz / 64; C = (st & 1) * 32 + (swz % 64) / 2; }
__host__ __device__ __forceinline__ int perm32(int rho) { const int n = rho >> 4, i = rho & 15; return 8 * (i >> 2) + 4 * n + (i & 3); }

struct Unit { int pm, pn; const char* pA; const char* pB; int e, mt, valid, pad; };
struct Gemm { const bf16_t* A; const bf16_t* Bt; int lda, ldb, K, pad; };

struct StaticOrder {
    int nM, nN, nwg, G, c; const char* A; const char* Bt; size_t tA, tB;
    __host__ __device__ void init(const Gemm& g, int M, int N, int G_, int c_) { nM = M / BM; nN = N / BM; nwg = nM * nN; G = G_; c = c_; A = (const char*)g.A; Bt = (const char*)g.Bt; tA = (size_t)BM * g.lda * 2; tB = (size_t)BM * g.ldb * 2; }
    __device__ __forceinline__ unsigned rowoff(const Unit&, int) const { return 0u; }
    __host__ __device__ bool next(int i, Unit& u) const {
        const long L = (long)i * G + c; if (L >= nwg) return false;
        int wgid = (int)L; { const int q = nwg / NXCD, r = nwg % NXCD, xcd = wgid % NXCD, off = wgid / NXCD; wgid = (xcd < r ? xcd * (q + 1) : r * (q + 1) + (xcd - r) * q) + off; }
        const int nig = WGM * nN, gid = wgid / nig, fm = gid * WGM, gsz = (nM - fm) < WGM ? (nM - fm) : WGM;
        u.pm = fm + ((wgid % nig) % gsz); u.pn = (wgid % nig) / gsz; u.pA = A + (size_t)u.pm * tA; u.pB = Bt + (size_t)u.pn * tB; u.e = 0; u.mt = 0; u.valid = BM; u.pad = 0; return true;
    }
};

struct EpiBf16 {
    static constexpr bool PERM = true;
    bf16_t* O; int ldc, pad;
    __device__ __forceinline__ void operator()(const f32x4 (&acc)[2][2][4][2], const Unit& u, int wr, int wc, int fr, int fq) const {
        const int row0 = u.pm * BM + wr * 64 + fr; const int col0 = u.pn * BM + wc * 32 + 8 * fq;
#pragma unroll
        for (int ai = 0; ai < 2; ++ai)
#pragma unroll
            for (int m = 0; m < 4; ++m) { bf16_t* rowp = O + (size_t)(row0 + ai * HALF + m * 16) * ldc + col0;
#pragma unroll
                for (int bj = 0; bj < 2; ++bj) { const f32x4 v0 = acc[ai][bj][m][0], v1 = acc[ai][bj][m][1];
                    u32x4 w; w.x = cvt_pk_bf16(v0[0], v0[1]); w.y = cvt_pk_bf16(v0[2], v0[3]); w.z = cvt_pk_bf16(v1[0], v1[1]); w.w = cvt_pk_bf16(v1[2], v1[3]);
                    *(u32x4*)(rowp + bj * HALF) = w; } }
    }
};
struct EpiBf16Norm {
    static constexpr bool PERM = true;
    bf16_t* O; float* parts; int ldc, pad;
    __device__ __forceinline__ void operator()(const f32x4 (&acc)[2][2][4][2], const Unit& u, int wr, int wc, int fr, int fq) const {
        const int row0 = u.pm * BM + wr * 64 + fr; const int col0 = u.pn * BM + wc * 32 + 8 * fq;
        const bool nrm = (u.pn >= 6 && u.pn <= 8);
#pragma unroll
        for (int ai = 0; ai < 2; ++ai)
#pragma unroll
            for (int m = 0; m < 4; ++m) { const int row = row0 + ai * HALF + m * 16; bf16_t* rowp = O + (size_t)row * ldc + col0; float ss = 0.f;
#pragma unroll
                for (int bj = 0; bj < 2; ++bj) { const f32x4 v0 = acc[ai][bj][m][0], v1 = acc[ai][bj][m][1];
                    if (bj == 1 || u.pn != 6) ss += (v0[0] * v0[0] + v0[1] * v0[1]) + (v0[2] * v0[2] + v0[3] * v0[3]) + (v1[0] * v1[0] + v1[1] * v1[1]) + (v1[2] * v1[2] + v1[3] * v1[3]);
                    u32x4 w; w.x = cvt_pk_bf16(v0[0], v0[1]); w.y = cvt_pk_bf16(v0[2], v0[3]); w.z = cvt_pk_bf16(v1[0], v1[1]); w.w = cvt_pk_bf16(v1[2], v1[3]);
                    *(u32x4*)(rowp + bj * HALF) = w; }
                if (nrm) { ss += __shfl_xor(ss, 16); ss += __shfl_xor(ss, 32); if (fq == 0) parts[(size_t)row * 12 + 4 * (u.pn - 6) + wc] = ss; } }
    }
};
struct EpiRms {
    static constexpr bool PERM = true;
    bf16_t* O; const float* parts; int ldc, s0, ns; float inv_k, eps; int pad;
    __device__ __forceinline__ void operator()(const f32x4 (&acc)[2][2][4][2], const Unit& u, int wr, int wc, int fr, int fq) const {
        const int row0 = u.pm * BM + wr * 64 + fr; const int col0 = u.pn * BM + wc * 32 + 8 * fq;
#pragma unroll
        for (int ai = 0; ai < 2; ++ai)
#pragma unroll
            for (int m = 0; m < 4; ++m) { const int row = row0 + ai * HALF + m * 16;
                const f32x4* pp = (const f32x4*)(parts + (size_t)row * 12 + s0); f32x4 a = pp[0]; float ss = (a[0] + a[1]) + (a[2] + a[3]);
                if (ns == 8) { const f32x4 b = pp[1]; ss += (b[0] + b[1]) + (b[2] + b[3]); }
                const float r = rsqrtf(ss * inv_k + eps);
                bf16_t* rowp = O + (size_t)row * ldc + col0;
#pragma unroll
                for (int bj = 0; bj < 2; ++bj) { const f32x4 v0 = acc[ai][bj][m][0] * r, v1 = acc[ai][bj][m][1] * r;
                    u32x4 w; w.x = cvt_pk_bf16(v0[0], v0[1]); w.y = cvt_pk_bf16(v0[2], v0[3]); w.z = cvt_pk_bf16(v1[0], v1[1]); w.w = cvt_pk_bf16(v1[2], v1[3]);
                    *(u32x4*)(rowp + bj * HALF) = w; } }
    }
};
struct EpiResid {
    static constexpr bool PERM = true;
    const float* XF; const bf16_t* XH; bf16_t* Y; int ldc; float alpha;
    __device__ __forceinline__ void operator()(const f32x4 (&acc)[2][2][4][2], const Unit& u, int wr, int wc, int fr, int fq) const {
        const int col0 = u.pn * BM + wc * 32 + 8 * fq;
#pragma unroll
        for (int ai = 0; ai < 2; ++ai)
#pragma unroll
            for (int m = 0; m < 4; ++m) { const size_t off = (size_t)(u.pm * BM + ai * HALF + wr * 64 + m * 16 + fr) * ldc + col0;
#pragma unroll
                for (int bj = 0; bj < 2; ++bj) { f32x4 x0, x1;
                    if (XF) { x0 = *(const f32x4*)(XF + off + bj * HALF); x1 = *(const f32x4*)(XF + off + bj * HALF + 4); }
                    else { const u32x4 h = *(const u32x4*)(XH + off + bj * HALF);
                        x0 = (f32x4){__uint_as_float(h.x << 16), __uint_as_float(h.x & 0xffff0000u), __uint_as_float(h.y << 16), __uint_as_float(h.y & 0xffff0000u)};
                        x1 = (f32x4){__uint_as_float(h.z << 16), __uint_as_float(h.z & 0xffff0000u), __uint_as_float(h.w << 16), __uint_as_float(h.w & 0xffff0000u)}; }
                    const f32x4 v0 = x0 * alpha + acc[ai][bj][m][0], v1 = x1 * alpha + acc[ai][bj][m][1];
                    u32x4 w; w.x = cvt_pk_bf16(v0[0], v0[1]); w.y = cvt_pk_bf16(v0[2], v0[3]); w.z = cvt_pk_bf16(v1[0], v1[1]); w.w = cvt_pk_bf16(v1[2], v1[3]);
                    *(u32x4*)(Y + off + bj * HALF) = w; } }
    }
};

template <class Epi, class Sched, bool ALIGN_EPI, bool GATHER>
__device__ __forceinline__ void gemm_phase(LAS unsigned char* lds, const Gemm g, const Sched& S, const Epi& E) {
    const int tid = tidx(), wid = __builtin_amdgcn_readfirstlane(tid >> 6), lane = tid & 63, wr = wid >> 2, wc = wid & 3, fr = lane & 15, fq = lane >> 4;
    int nt = g.K / BK; asm volatile("" : "+s"(nt));
    unsigned voffA[2], voffB[2]; int RA[2];
#pragma unroll
    for (int i = 0; i < 2; ++i) { int R, C; stage_rc(tid * 16 + i * 8192, R, C); const int Rb = Epi::PERM ? ((R & ~31) + perm32(R & 31)) : R;
        RA[i] = R; voffA[i] = GATHER ? (unsigned)C * 2u : (unsigned)(R * g.lda + C) * 2u; voffB[i] = (unsigned)(Rb * g.ldb + C) * 2u; }
    const size_t kstep = (size_t)(BK * 2);
    const size_t hstepA = GATHER ? (size_t)0 : (size_t)HALF * g.lda * 2, hstepB = (size_t)HALF * g.ldb * 2;
    const unsigned ldsw = (unsigned)wid * 1024u;
    const int aoff = lds_byte(wr * 64 + fr, fq * 8), boff = lds_byte(wc * 32 + fr, fq * 8);
#define PG8_SA(b, h) (((b) * 2 + (h)) * HTB)
#define PG8_SB(b, h) ((4 + (b) * 2 + (h)) * HTB)
#define PG8_STAGE(bufoff, gbase, voff) do { _Pragma("unroll") for (int _i = 0; _i < 2; ++_i) \
        __builtin_amdgcn_global_load_lds((const unsigned*)((const char*)(gbase) + (voff)[_i]), (LAS unsigned*)(lds + (bufoff) + ldsw + _i * 8192), 16, 0, 0); } while (0)
#define PG8_STAGE_A(bufoff, gbase, h, vg) do { _Pragma("unroll") for (int _i = 0; _i < 2; ++_i) \
        __builtin_amdgcn_global_load_lds((const unsigned*)((const char*)(gbase) + (GATHER ? (size_t)0 : (h) * hstepA) + (GATHER ? (vg)[h][_i] : voffA[_i])), (LAS unsigned*)(lds + (bufoff) + ldsw + _i * 8192), 16, 0, 0); } while (0)
#define PG8_GOFF(vg, u) do { if (GATHER) { _Pragma("unroll") for (int _h = 0; _h < 2; ++_h) _Pragma("unroll") for (int _i = 0; _i < 2; ++_i) (vg)[_h][_i] = S.rowoff(u, _h * HALF + RA[_i]) + voffA[_i]; } } while (0)
#define PG8_LDA(dst, b, h) do { _Pragma("unroll") for (int m = 0; m < 4; ++m) _Pragma("unroll") for (int k = 0; k < 2; ++k) dst[m][k] = *(const LAS bf16x8*)(lds + PG8_SA(b, h) + aoff + m * 2048 + k * 1024); } while (0)
#define PG8_LDB(dst, b, h) do { _Pragma("unroll") for (int n = 0; n < 2; ++n) _Pragma("unroll") for (int k = 0; k < 2; ++k) dst[n][k] = *(const LAS bf16x8*)(lds + PG8_SB(b, h) + boff + n * 2048 + k * 1024); } while (0)
#define PG8_MMA(ai, bj, At, Bt) do { __builtin_amdgcn_s_setprio(1); _Pragma("unroll") for (int m = 0; m < 4; ++m) _Pragma("unroll") for (int n = 0; n < 2; ++n) _Pragma("unroll") for (int k = 0; k < 2; ++k) \
        acc[ai][bj][m][n] = __builtin_amdgcn_mfma_f32_16x16x32_bf16(Bt[n][k], At[m][k], acc[ai][bj][m][n], 0, 0, 0); __builtin_amdgcn_s_setprio(0); } while (0)
#define PG8_WAIT_V(n) asm volatile("s_waitcnt vmcnt(" #n ")" ::: "memory")
#define PG8_WAIT_L(n) asm volatile("s_waitcnt lgkmcnt(" #n ")" ::: "memory")
#define PG8_BAR __builtin_amdgcn_s_barrier()
#define PG8_SCHED __builtin_amdgcn_sched_barrier(0)
    Unit cur, nxt; int ui = 0;
    if (!S.next(0, cur)) return;
    f32x4 acc[2][2][4][2];
#pragma unroll
    for (int a = 0; a < 2; ++a)
#pragma unroll
        for (int b = 0; b < 2; ++b)
#pragma unroll
            for (int m = 0; m < 4; ++m)
#pragma unroll
                for (int n = 0; n < 2; ++n) acc[a][b][m][n] = (f32x4){0.f, 0.f, 0.f, 0.f};
    bf16x8 At[4][2], B0[2][2], B1[2][2];
    const char* cA = cur.pA; const char* cB = cur.pB;
    unsigned vgc[2][2] = {{0u, 0u}, {0u, 0u}};
    PG8_GOFF(vgc, cur);
    PG8_STAGE(PG8_SB(0, 0), cB, voffB); PG8_STAGE(PG8_SB(0, 1), cB + hstepB, voffB); PG8_STAGE_A(PG8_SA(0, 0), cA, 0, vgc); PG8_STAGE_A(PG8_SA(0, 1), cA, 1, vgc);
    if (wr == 1) PG8_BAR;
    PG8_WAIT_V(2); PG8_BAR;
    PG8_STAGE(PG8_SB(1, 0), cB + kstep, voffB); PG8_STAGE_A(PG8_SA(1, 0), cA + kstep, 0, vgc); PG8_STAGE(PG8_SB(1, 1), cB + hstepB + kstep, voffB);
    PG8_WAIT_V(6); PG8_BAR;
    for (;;) {
        const bool has_next = S.next(ui + 1, nxt);
        const char* nA = has_next ? nxt.pA : cA; const char* nB = has_next ? nxt.pB : cB;

#pragma unroll 1
        for (int t = 0; t < nt; t += 2) {
            const bool last = (t == nt - 2);
            const char* a1 = cA + (size_t)(t + 1) * kstep;
            const char* a2 = last ? nA : cA + (size_t)(t + 2) * kstep; const char* b2 = last ? nB : cB + (size_t)(t + 2) * kstep;
            const char* a3 = a2 + kstep; const char* b3 = b2 + kstep;
            unsigned vgn[2][2] = {{0u, 0u}, {0u, 0u}};
            if (GATHER) { if (last && has_next) { PG8_GOFF(vgn, nxt); PG8_SCHED; } }
            PG8_LDB(B0, 0, 0); PG8_LDB(B1, 0, 1); PG8_SCHED; PG8_LDA(At, 0, 0); PG8_STAGE_A(PG8_SA(1, 1), a1, 1, vgc);
            if (GATHER) { if (last && has_next) {
#pragma unroll
                for (int _h = 0; _h < 2; ++_h) { vgc[_h][0] = vgn[_h][0]; vgc[_h][1] = vgn[_h][1]; } } }
            PG8_WAIT_V(8); PG8_WAIT_L(0); PG8_BAR; PG8_MMA(0, 0, At, B0); PG8_MMA(0, 1, At, B1); PG8_BAR; PG8_SCHED;
            PG8_LDA(At, 0, 1); PG8_STAGE(PG8_SB(0, 0), b2, voffB); PG8_STAGE(PG8_SB(0, 1), b2 + hstepB, voffB); PG8_STAGE_A(PG8_SA(0, 0), a2, 0, vgc);
            PG8_WAIT_V(8); PG8_WAIT_L(0); PG8_BAR; PG8_MMA(1, 0, At, B0); PG8_MMA(1, 1, At, B1); PG8_BAR; PG8_SCHED;
            PG8_LDB(B0, 1, 0); PG8_LDB(B1, 1, 1); PG8_SCHED; PG8_LDA(At, 1, 0); PG8_STAGE_A(PG8_SA(0, 1), a2, 1, vgc);
            PG8_WAIT_V(8); PG8_WAIT_L(0); PG8_BAR; PG8_MMA(0, 0, At, B0); PG8_MMA(0, 1, At, B1); PG8_BAR; PG8_SCHED;
            PG8_LDA(At, 1, 1); PG8_STAGE(PG8_SB(1, 0), b3, voffB); PG8_STAGE(PG8_SB(1, 1), b3 + hstepB, voffB); PG8_STAGE_A(PG8_SA(1, 0), a3, 0, vgc);
            PG8_WAIT_V(8); PG8_WAIT_L(0); PG8_BAR; PG8_MMA(1, 0, At, B0); PG8_MMA(1, 1, At, B1); PG8_BAR; PG8_SCHED;
        }
        if constexpr (ALIGN_EPI) { if (wr == 0) PG8_BAR; }
        E(acc, cur, wr, wc, fr, fq);
        if (!has_next) break;
#pragma unroll
        for (int a = 0; a < 2; ++a)
#pragma unroll
            for (int b = 0; b < 2; ++b)
#pragma unroll
                for (int m = 0; m < 4; ++m)
#pragma unroll
                    for (int n = 0; n < 2; ++n) acc[a][b][m][n] = (f32x4){0.f, 0.f, 0.f, 0.f};
        cur = nxt; cA = nA; cB = nB; ++ui;

        if constexpr (ALIGN_EPI) { if (wr == 1) PG8_BAR; }
    }
    PG8_WAIT_V(0);
    if constexpr (!ALIGN_EPI) { if (wr == 0) PG8_BAR; }
    PG8_BAR;
#undef PG8_SA
#undef PG8_SB
#undef PG8_STAGE
#undef PG8_STAGE_A
#undef PG8_GOFF
#undef PG8_LDA
#undef PG8_LDB
#undef PG8_MMA
#undef PG8_WAIT_V
#undef PG8_WAIT_L
#undef PG8_BAR
#undef PG8_SCHED
}
}
__device__ __forceinline__ void p0_transpose_item(const float* __restrict__ W, int K, int N, bf16_t* WT, int row_off, LAS float* scr, int kb, int nb, int lane, const float* __restrict__ kscale) {
    const int k0 = 64 * kb, n0 = 32 * nb;
#pragma unroll 8
    for (int i = 0; i < 32; ++i) { const int kk = 2 * i + (lane >> 5); float w = W[(size_t)(k0 + kk) * N + n0 + (lane & 31)]; if (kscale) w *= kscale[k0 + kk]; scr[kk * 33 + (lane & 31)] = w; }
    LDS_WAIT(); asm volatile("" ::: "memory");
    const int c = lane & 7;
#pragma unroll
    for (int j = 0; j < 4; ++j) { const int n = (lane >> 3) + 8 * j; const LAS float* s = scr + (8 * c) * 33 + n;
        u32x4 o; o.x = pk2(s[0 * 33], s[1 * 33]); o.y = pk2(s[2 * 33], s[3 * 33]); o.z = pk2(s[4 * 33], s[5 * 33]); o.w = pk2(s[6 * 33], s[7 * 33]);
        *(u32x4*)(WT + (size_t)(row_off + n0 + n) * K + k0 + 8 * c) = o; }
    LDS_WAIT(); asm volatile("" ::: "memory");
}
__device__ __forceinline__ void p0_convert(const float* W, int K, int N, bf16_t* WT, LAS float* scr, int gw, int NGW, int lane, const float* kscale, int rowmap) {
    const int nblk = N / 32, nitems = (K / 64) * nblk;
    for (int it = gw; it < nitems; it += NGW) { const int kb = it / nblk, nb = it % nblk; int row_off = 0;
        if (rowmap == 1) { const int c0 = nb * 32; const int cc = (c0 < 256) ? c0 : c0 - 256; const int pn = cc >> 7, j = (cc & 127) + ((c0 < 256) ? 0 : 128); row_off = (256 * pn + j) - c0; }
        p0_transpose_item(W, K, N, WT, row_off, scr, kb, nb, lane, kscale); }
}
__device__ __forceinline__ void p0_zero_rows(bf16_t* WT, int K, int r0, int r1, int gtid, int NGT) {
    const size_t n16 = (size_t)(r1 - r0) * K * 2 / 16; u32x4* p = (u32x4*)(WT + (size_t)r0 * K);
    for (size_t i = gtid; i < n16; i += NGT) p[i] = (u32x4){0u, 0u, 0u, 0u};
}
struct P0Args { const float *x, *w_in, *qn_w, *kvn_w, *w_uq, *w_ukv, *w_out; unsigned char* ws; };
__device__ __forceinline__ void p0_experts(const float* wgu_l, const float* wd_l, unsigned char* ws, LAS float* scr, int gw, int NGW, int lane) {
    for (int it = gw; it < NEXP * 384; it += NGW) {
        if (it < NEXP * 256) { const int e = it >> 8, r = it & 255, kb = r >> 4, nb = r & 15; const int c0 = nb * 32; const int cc = (c0 < 256) ? c0 : c0 - 256; const int row_off = (256 * (cc >> 7) + (cc & 127) + ((c0 < 256) ? 0 : 128)) - c0;
            p0_transpose_item(wgu_l + (size_t)e * DM * 512, DM, 512, (bf16_t*)(ws + WS_WGU) + (size_t)e * 512 * DM, row_off, scr, kb, nb, lane, nullptr); }
        else { const int i2 = it - NEXP * 256; const int e = i2 >> 7, r = i2 & 127, kb = r >> 5, nb = r & 31;
            p0_transpose_item(wd_l + (size_t)e * DEXP * DM, DEXP, DM, (bf16_t*)(ws + WS_WD) + (size_t)e * DM * DEXP, 0, scr, kb, nb, lane, nullptr); }
    }
}
__device__ __forceinline__ void p0_all(const P0Args& a, LAS unsigned char* lds, int vcu, int G) {
    const int tid = tidx(), lane = tid & 63, wave = tid >> 6;
    LAS float* scr = (LAS float*)(lds + wave * 16384);
    const int gw = vcu * 8 + wave, NGW = G * 8, gtid = vcu * 512 + tid, NGT = G * 512;
    for (int l = 0; l < DEPTH; ++l) {
        bf16_t* win_t = (bf16_t*)(a.ws + WS_WIN) + (size_t)l * NPP * DM;
        p0_convert(a.w_in + (size_t)l * DM * NP, DM, NP, win_t, scr, gw, NGW, lane, nullptr, 0);
        p0_zero_rows(win_t, DM, NP, NPP, gtid, NGT);
        bf16_t* wuq_t = (bf16_t*)(a.ws + WS_WUQ) + (size_t)l * NQMP * 384;
        p0_convert(a.w_uq + (size_t)l * 384 * NQM, 384, NQM, wuq_t, scr, gw, NGW, lane, a.qn_w + l * 384, 0);
        p0_zero_rows(wuq_t, 384, NQM, NQMP, gtid, NGT);
        p0_convert(a.w_ukv + (size_t)l * 256 * NKVM, 256, NKVM, (bf16_t*)(a.ws + WS_WUKV) + (size_t)l * NKVM * 256, scr, gw, NGW, lane, a.kvn_w + l * 256, 0);
        p0_convert(a.w_out + (size_t)l * DM * DM, DM, DM, (bf16_t*)(a.ws + WS_WOUT) + (size_t)l * DM * DM, scr, gw, NGW, lane, nullptr, 0);
    }
    { const f32x4* xs = (const f32x4*)a.x; u32x2* xb = (u32x2*)(a.ws + WS_R0); const size_t n4 = (size_t)TOK * DM / 4;
      for (size_t i = gtid; i < n4; i += NGT) { const f32x4 v = xs[i]; u32x2 o; o.x = pk2(v[0], v[1]); o.y = pk2(v[2], v[3]); xb[i] = o; } }
    { float2* tr = (float2*)(a.ws + WS_TABR); float2* tm = (float2*)(a.ws + WS_TABM);
      for (int idx = gtid; idx < SEQ * 32; idx += NGT) { const int pos = idx >> 5, i = idx & 31;
          const float invf = (float)exp(-log(10000.0) * (double)(2 * i) / 64.0); const double ang = (double)((float)pos * invf);
          tr[idx] = make_float2((float)cos(ang), (float)sin(ang)); }
      for (int idx = gtid; idx < SEQ * 16; idx += NGT) { const int pos = idx >> 4, i = idx & 15;
          const float invf = (float)exp(-log(10000.0) * (double)(2 * i) / 32.0); const double ang = (double)((float)pos * invf);
          tm[idx] = make_float2((float)cos(ang), (float)sin(ang)); } }
}
namespace att {
__device__ __forceinline__ int crow(int r, int hi) { return (r & 3) + 8 * (r >> 2) + 4 * hi; }
#define ATT_SBAR() __builtin_amdgcn_sched_barrier(0)
#define ATT_WAIT_BAR0() asm volatile("s_waitcnt vmcnt(0) lgkmcnt(0)\n\ts_barrier" ::: "memory")
constexpr int KSLOT = 12288, VSLOT = 8192;
constexpr int NSLOT = 3;
constexpr int LDS_K = 0, LDS_V = NSLOT * KSLOT, LDS_WS = LDS_V + NSLOT * VSLOT, LDS_OST = LDS_WS + 8 * 256, LDS_BYTES = LDS_OST + 8 * 4096;
__device__ __forceinline__ void glds16(const void* gsrc, unsigned lds_dst) { unsigned keep;
  asm volatile("s_mov_b32 %0, m0\n\ts_mov_b32 m0, %2\n\ts_nop 0\n\tglobal_load_lds_dwordx4 %1, off\n\ts_mov_b32 m0, %0" : "=&s"(keep) : "v"(gsrc), "s"(lds_dst) : "memory"); }
__device__ __forceinline__ float max3f(float a, float b, float c) { float r; asm("v_max3_f32 %0, %1, %2, %3" : "=v"(r) : "v"(a), "v"(b), "v"(c)); return r; }
__device__ __forceinline__ float rowmax(const f32x16& p0, const f32x16& p1) {
  float a = max3f(p0[0], p0[1], p1[0]), b = max3f(p0[2], p0[3], p1[1]); a = max3f(a, p1[2], p1[3]);
#pragma unroll
  for (int r = 4; r < 16; r += 4) { a = max3f(a, p0[r], p0[r + 1]); b = max3f(b, p0[r + 2], p0[r + 3]); a = max3f(a, p1[r], p1[r + 1]); b = max3f(b, p1[r + 2], p1[r + 3]); }
  const float m = fmaxf(a, b);
  auto rr = __builtin_amdgcn_permlane32_swap(__float_as_uint(m), __float_as_uint(m), false, false);
  return fmaxf(__uint_as_float(rr[0]), __uint_as_float(rr[1]));
}
template <int NCH>
__device__ __forceinline__ void qkt(f32x16& p0, f32x16& p1, const LAS char* Kslot, const bf16x8* qr, int r32, int hi) {
  const LAS char* kb = Kslot + hi * 1024 + r32 * 16;
#pragma unroll
  for (int d0 = 0; d0 < NCH; ++d0) {
    const bf16x8 b0 = *(const LAS bf16x8*)(kb + d0 * 2048);
    const bf16x8 b1 = *(const LAS bf16x8*)(kb + d0 * 2048 + 512);
    p0 = __builtin_amdgcn_mfma_f32_32x32x16_bf16(b0, qr[d0], p0, 0, 0, 0);
    p1 = __builtin_amdgcn_mfma_f32_32x32x16_bf16(b1, qr[d0], p1, 0, 0, 0);
  }
}
typedef short s16x4 __attribute__((ext_vector_type(4)));
__device__ __forceinline__ void pv(f32x16* o, int vb, bf16x8 pa0, bf16x8 pa1, bf16x8 pa2, bf16x8 pa3) {
#pragma unroll
  for (int d0 = 0; d0 < 2; ++d0) { s16x4 lo[4], hi[4];
#pragma unroll
    for (int ks = 0; ks < 4; ++ks) {
      asm volatile("ds_read_b64_tr_b16 %0,%1 offset:%c2" : "=&v"(lo[ks]) : "v"(vb), "i"(d0 * 4096 + ks * 1024) : "memory");
      asm volatile("ds_read_b64_tr_b16 %0,%1 offset:%c2" : "=&v"(hi[ks]) : "v"(vb), "i"(d0 * 4096 + ks * 1024 + 512) : "memory"); }
    asm volatile("s_waitcnt lgkmcnt(0)" ::: "memory"); ATT_SBAR();
#define ATT_PK(k) (bf16x8){lo[k][0], lo[k][1], lo[k][2], lo[k][3], hi[k][0], hi[k][1], hi[k][2], hi[k][3]}
    o[d0] = __builtin_amdgcn_mfma_f32_32x32x16_bf16(pa0, ATT_PK(0), o[d0], 0, 0, 0);
    o[d0] = __builtin_amdgcn_mfma_f32_32x32x16_bf16(pa1, ATT_PK(1), o[d0], 0, 0, 0);
    o[d0] = __builtin_amdgcn_mfma_f32_32x32x16_bf16(pa2, ATT_PK(2), o[d0], 0, 0, 0);
    o[d0] = __builtin_amdgcn_mfma_f32_32x32x16_bf16(pa3, ATT_PK(3), o[d0], 0, 0, 0);
#undef ATT_PK
  }
}
struct AttnPtrs { const bf16_t* proj; const bf16_t* qm; const bf16_t* kvm; const bf16_t* kpe; const float2* tabm; const float* sinks; bf16_t* concat; };

typedef short v4i16_t __attribute__((ext_vector_type(4)));
__device__ __forceinline__ s16x4 vtr(const LAS char* p) { return __builtin_bit_cast(s16x4, __builtin_amdgcn_ds_read_tr16_b64_v4i16((LAS v4i16_t*)p)); }
template <int NCH>
__device__ __forceinline__ void qkt_c(f32x16& p0, f32x16& p1, const LAS char* Kslot, const bf16x8* qr, const f32x16& c, int r32, int hi) {
  const LAS char* kb = Kslot + hi * 1024 + r32 * 16;
#pragma unroll
  for (int d0 = 0; d0 < NCH; ++d0) {
    const bf16x8 b0 = *(const LAS bf16x8*)(kb + d0 * 2048);
    const bf16x8 b1 = *(const LAS bf16x8*)(kb + d0 * 2048 + 512);
    if (d0 == 0) { p0 = __builtin_amdgcn_mfma_f32_32x32x16_bf16(b0, qr[0], c, 0, 0, 0); p1 = __builtin_amdgcn_mfma_f32_32x32x16_bf16(b1, qr[0], c, 0, 0, 0); }
    else { p0 = __builtin_amdgcn_mfma_f32_32x32x16_bf16(b0, qr[d0], p0, 0, 0, 0); p1 = __builtin_amdgcn_mfma_f32_32x32x16_bf16(b1, qr[d0], p1, 0, 0, 0); }
  }
}
template <int MODE>
__device__ __forceinline__ void attn_unit(const AttnPtrs& P, int b, int h, int qb, LAS char* shm) {
  constexpr int NCH = (MODE == 0) ? 6 : 4;
  constexpr float THR = 8.0f;
  const int tid = tidx(), lane = tid & 63, r32 = lane & 31, hi = lane >> 5; const int wid = __builtin_amdgcn_readfirstlane(tid >> 6);
  const long rowbase = (long)b * SEQ; const int q0 = qb * 256;
  const unsigned lds0 = (unsigned)(uintptr_t)shm;
  LAS float* wsf = (LAS float*)(shm + LDS_WS) + wid * 64;
  const bf16_t *Qp, *Kp, *Vp; int ldq, ldk; bf16_t* Op;
  if (MODE == 0) { Qp = P.qm + h * 96; ldq = NQMP; Kp = P.kvm + h * 128; Vp = P.kvm + h * 128 + 64; ldk = NKVM; Op = P.concat + 640 + h * 64; }
  else { Qp = P.proj + O_SQ + h * 64; ldq = NPP; Kp = P.proj + O_SK + (h / 3) * 64; Vp = P.proj + O_SV + (h / 3) * 64; ldk = NPP; Op = P.concat + 256 + h * 64; }
  const bf16_t* ksrc = Kp + (rowbase + lane) * ldk + wid * 8;
  const bf16_t* krsrc = P.kpe + (rowbase + lane) * 32 + (wid & 3) * 8;
  const bf16_t* vsrc = Vp + (rowbase + 16 * (wid & 3) + (lane >> 2)) * ldk + (wid >> 2) * 32 + (lane & 3) * 8;
  const unsigned kdst = lds0 + LDS_K + wid * 1024, krdst = lds0 + LDS_K + (8 + (wid & 3)) * 1024, vdst = lds0 + LDS_V + wid * 1024;
#define ATT_DMA_K(t, s) do { glds16(ksrc + (long)(t) * 64 * ldk, (unsigned)__builtin_amdgcn_readfirstlane(kdst + (s) * KSLOT)); \
    if (MODE == 0 && wid < 4) glds16(krsrc + (long)(t) * 64 * 32, (unsigned)__builtin_amdgcn_readfirstlane(krdst + (s) * KSLOT)); } while (0)
#define ATT_DMA_V(t, s) glds16(vsrc + (long)(t) * 64 * ldk, (unsigned)__builtin_amdgcn_readfirstlane(vdst + (s) * VSLOT))
  const LAS char* vp0 = shm + LDS_V + ((lane >> 4) & 1) * 32 + (lane & 3) * 8 + (4 * hi + ((lane & 15) >> 2)) * 64;
  int t_lo, t_hi;
  if (MODE == 0) { t_lo = 0; t_hi = (q0 + 256) / 64; } else { t_lo = q0 / 64 - 2; if (t_lo < 0) t_lo = 0; t_hi = q0 / 64 + 4; }
  ATT_DMA_K(t_lo, 0); ATT_DMA_V(t_lo, 0); ATT_DMA_K(t_lo + 1, 1); ATT_DMA_V(t_lo + 1, 1); ATT_DMA_K(t_lo + 2, 2);
  const int qpos = q0 + wid * 32 + r32;
  bf16x8 qr[NCH];
  { const float c2 = (MODE == 0 ? 0.10206207261596575f : 0.125f) * LOG2E;
    const bf16_t* qrow = Qp + (rowbase + qpos) * ldq + hi * 8;
    float qf[NCH][8];
#pragma unroll
    for (int d0 = 0; d0 < NCH; ++d0) { const bf16x8 v = *reinterpret_cast<const bf16x8*>(qrow + d0 * 16);
#pragma unroll
      for (int j = 0; j < 8; ++j) qf[d0][j] = bf2f((bf16_t)v[j]); }
    if (MODE == 0) {
      const float2* tb = P.tabm + qpos * 16 + hi * 8;
#pragma unroll
      for (int j = 0; j < 8; ++j) { const float2 cs = tb[j]; const float x1 = qf[NCH - 2][j], x2 = qf[NCH - 1][j]; qf[NCH - 2][j] = x1 * cs.x - x2 * cs.y; qf[NCH - 1][j] = x1 * cs.y + x2 * cs.x; }
    }
#pragma unroll
    for (int d0 = 0; d0 < NCH; ++d0) { u32x4 w; w.x = cvt_pk_bf16(qf[d0][0] * c2, qf[d0][1] * c2); w.y = cvt_pk_bf16(qf[d0][2] * c2, qf[d0][3] * c2); w.z = cvt_pk_bf16(qf[d0][4] * c2, qf[d0][5] * c2); w.w = cvt_pk_bf16(qf[d0][6] * c2, qf[d0][7] * c2);
      qr[d0] = __builtin_bit_cast(bf16x8, w); }
  }
  float mhat, l_run;
  if (MODE == 0) { mhat = 0.f; l_run = 0.f; } else { mhat = P.sinks[h] * LOG2E; l_run = (hi == 0) ? 1.f : 0.f; }
  f32x16 negm;
#pragma unroll
  for (int r = 0; r < 16; ++r) negm[r] = -mhat;
  f32x16 o[2]; o[0] = f32x16{}; o[1] = f32x16{};
  const int qw0 = q0 + wid * 32;
  ATT_WAIT_BAR0();
  f32x16 pc0, pc1, pn0, pn1;
  qkt_c<NCH>(pc0, pc1, shm + LDS_K, qr, negm, r32, hi);
  asm volatile("s_waitcnt lgkmcnt(0)\n\ts_barrier" ::: "memory");
  int s = 0;
  for (int t = t_lo; t < t_hi; ++t) {
    const int s1 = (s == 2) ? 0 : s + 1, s2 = (s == 0) ? 2 : s - 1;
    const bool has_next = (t + 1 < t_hi);
    if (t + 3 < t_hi) ATT_DMA_K(t + 3, s);
    if (t + 2 < t_hi) ATT_DMA_V(t + 2, s2);
    if (has_next) qkt_c<NCH>(pn0, pn1, shm + LDS_K + s1 * KSLOT, qr, negm, r32, hi);
    const int k0 = t * 64;
    bool active, need_mask;
    if (MODE == 0) { active = true; need_mask = (k0 + 63 > qw0); }
    else { active = (k0 <= qw0 + 31) && (k0 + 63 >= qw0 - 127); need_mask = (k0 + 63 > qw0) || (k0 < qw0 + 31 - 127); }
    if (active) {
      if (need_mask) {
#pragma unroll
        for (int r = 0; r < 16; ++r) { const int kv = k0 + crow(r, hi);
          bool bad0 = kv > qpos, bad1 = kv + 32 > qpos;
          if (MODE == 1) { bad0 = bad0 || (kv < qpos - 127); bad1 = bad1 || (kv + 32 < qpos - 127); }
          if (bad0) pc0[r] = -1e30f; if (bad1) pc1[r] = -1e30f; }
      }
      const float rm = rowmax(pc0, pc1);
      const bool first = (MODE == 0) && (t == t_lo);
      if (first || __any(rm > THR)) {
        const float dl = first ? rm : fmaxf(rm, 0.f);
        mhat += dl;
#pragma unroll
        for (int r = 0; r < 16; ++r) { pc0[r] -= dl; pc1[r] -= dl; }
        if (has_next) {
#pragma unroll
          for (int r = 0; r < 16; ++r) { pn0[r] -= dl; pn1[r] -= dl; } }
#pragma unroll
        for (int r = 0; r < 16; ++r) negm[r] = -mhat;
        const float f = __builtin_amdgcn_exp2f(-dl);
        l_run *= f;
        if (hi == 0) wsf[r32] = f;
#pragma unroll
        for (int r = 0; r < 16; ++r) { const float g = wsf[crow(r, hi)]; o[0][r] *= g; o[1][r] *= g; }
      }
      float psum = 0.f;
#pragma unroll
      for (int r = 0; r < 16; ++r) { pc0[r] = __builtin_amdgcn_exp2f(pc0[r]); pc1[r] = __builtin_amdgcn_exp2f(pc1[r]); psum += pc0[r] + pc1[r]; }
      l_run += psum;
      u32x4 pw0, pw1, pw2, pw3;
      pw0 = (u32x4){cvt_pk_bf16(pc0[0], pc0[1]), cvt_pk_bf16(pc0[2], pc0[3]), cvt_pk_bf16(pc0[4], pc0[5]), cvt_pk_bf16(pc0[6], pc0[7])};
      pw1 = (u32x4){cvt_pk_bf16(pc0[8], pc0[9]), cvt_pk_bf16(pc0[10], pc0[11]), cvt_pk_bf16(pc0[12], pc0[13]), cvt_pk_bf16(pc0[14], pc0[15])};
      pw2 = (u32x4){cvt_pk_bf16(pc1[0], pc1[1]), cvt_pk_bf16(pc1[2], pc1[3]), cvt_pk_bf16(pc1[4], pc1[5]), cvt_pk_bf16(pc1[6], pc1[7])};
      pw3 = (u32x4){cvt_pk_bf16(pc1[8], pc1[9]), cvt_pk_bf16(pc1[10], pc1[11]), cvt_pk_bf16(pc1[12], pc1[13]), cvt_pk_bf16(pc1[14], pc1[15])};
      const bf16x8 pa[4] = {__builtin_bit_cast(bf16x8, pw0), __builtin_bit_cast(bf16x8, pw1), __builtin_bit_cast(bf16x8, pw2), __builtin_bit_cast(bf16x8, pw3)};
      const LAS char* vp = vp0 + s * VSLOT;
#pragma unroll
      for (int d0 = 0; d0 < 2; ++d0)
#pragma unroll
        for (int ks = 0; ks < 4; ++ks) { const s16x4 lo = vtr(vp + d0 * 4096 + ks * 1024), hi4 = vtr(vp + d0 * 4096 + ks * 1024 + 512);
          const bf16x8 vf = (bf16x8){lo[0], lo[1], lo[2], lo[3], hi4[0], hi4[1], hi4[2], hi4[3]};
          o[d0] = __builtin_amdgcn_mfma_f32_32x32x16_bf16(pa[ks], vf, o[d0], 0, 0, 0); }
    }
    if (t + 3 < t_hi) { if (MODE == 0 && wid < 4) asm volatile("s_waitcnt vmcnt(3) lgkmcnt(0)\n\ts_barrier" ::: "memory"); else asm volatile("s_waitcnt vmcnt(2) lgkmcnt(0)\n\ts_barrier" ::: "memory"); }
    else ATT_WAIT_BAR0();
    pc0 = pn0; pc1 = pn1; s = s1;
  }
  { auto rr = __builtin_amdgcn_permlane32_swap(__float_as_uint(l_run), __float_as_uint(l_run), false, false); l_run = __uint_as_float(rr[0]) + __uint_as_float(rr[1]); }
  if (hi == 0) wsf[32 + r32] = l_run;
  float rli[16];
#pragma unroll
  for (int r = 0; r < 16; ++r) rli[r] = 1.0f / wsf[32 + crow(r, hi)];
  bf16_t* Ow = Op + (rowbase + q0 + wid * 32) * DM;
  { LAS bf16_t* stg = (LAS bf16_t*)(shm + LDS_OST) + wid * 2048;
#pragma unroll
    for (int r = 0; r < 16; ++r) { const int orow = crow(r, hi);
#pragma unroll
      for (int d0 = 0; d0 < 2; ++d0) stg[orow * 64 + d0 * 32 + r32] = (bf16_t)f2bf(o[d0][r] * rli[r]); }
#pragma unroll
    for (int i = 0; i < 4; ++i) { const int row = i * 8 + (lane >> 3), ch = lane & 7; const u32x4 v = *(const LAS u32x4*)(stg + row * 64 + ch * 8); *(u32x4*)(Ow + (long)row * DM + ch * 8) = v; } }
  asm volatile("s_waitcnt lgkmcnt(0)\n\ts_barrier" ::: "memory");
#undef ATT_DMA_K
#undef ATT_DMA_V
}
}
namespace ret {
using att::crow; using att::glds16; using att::qkt; using att::pv; using att::s16x4;
struct RetPtrs { const bf16_t* proj; const float2* tabr; const float* gn_w; float* U; bf16_t* concat; };
constexpr int R_V = 0, R_K = 32768, R_ST = 65536, R_STG = 0;
constexpr int ST_PITCH = 72;
__device__ __forceinline__ float gamma_log2(int h) { return log2f(1.0f - exp2f(-5.0f - (float)h)); }

__device__ __forceinline__ void dma_v4(const RetPtrs& P, int b, int h, int cp, unsigned lds0, int wid, int lane) {
  const bf16_t* vsrc = P.proj + ((long)b * SEQ + 256 * cp + 16 * (wid & 3) + (lane >> 2)) * NPP + O_RV + h * 64 + (wid >> 2) * 32 + (lane & 3) * 8;
#pragma unroll
  for (int tt = 0; tt < 4; ++tt) glds16(vsrc + (long)tt * 64 * NPP, (unsigned)__builtin_amdgcn_readfirstlane(lds0 + R_V + tt * 8192 + wid * 1024));
}
__device__ __forceinline__ bf16x8 tr_frag(int vb, int off) { s16x4 lo, hi;
  asm volatile("ds_read_b64_tr_b16 %0,%1" : "=&v"(lo) : "v"(vb + off) : "memory");
  asm volatile("ds_read_b64_tr_b16 %0,%1" : "=&v"(hi) : "v"(vb + off + 512) : "memory");
  asm volatile("s_waitcnt lgkmcnt(0)" : "+v"(lo), "+v"(hi) :: "memory");
  return (bf16x8){lo[0], lo[1], lo[2], lo[3], hi[0], hi[1], hi[2], hi[3]}; }

__device__ __forceinline__ void upd_unit(const RetPtrs& P, int b, int h, int cp, LAS char* shm) {
  const int tid = tidx(), lane = tid & 63, hi = lane >> 5; const int wid = __builtin_amdgcn_readfirstlane(tid >> 6);
  const unsigned lds0 = (unsigned)(uintptr_t)shm;
  const float lg = gamma_log2(h);
  dma_v4(P, b, h, cp, lds0, wid, lane);
#pragma unroll
  for (int it = 0; it < 2; ++it) { const int item = tid + 512 * it, row = item >> 2, c = item & 3; const int pos = 256 * cp + row;
    const bf16_t* src = P.proj + ((long)b * SEQ + pos) * NPP + O_RK + h * 64 + 8 * c;
    const bf16x8 lo = *(const bf16x8*)src, hi8 = *(const bf16x8*)(src + 32);
    const float2* tb = P.tabr + pos * 32 + 8 * c;
    const float sc = 0.125f * exp2f(lg * (float)(127 - (row & 127)));
    float y1[8], y2[8];
#pragma unroll
    for (int j = 0; j < 8; ++j) { const float2 cs = tb[j]; const float x1 = bf2f((bf16_t)lo[j]), x2 = bf2f((bf16_t)hi8[j]); y1[j] = (x1 * cs.x - x2 * cs.y) * sc; y2[j] = (x1 * cs.y + x2 * cs.x) * sc; }
    u32x4 w1, w2; w1.x = cvt_pk_bf16(y1[0], y1[1]); w1.y = cvt_pk_bf16(y1[2], y1[3]); w1.z = cvt_pk_bf16(y1[4], y1[5]); w1.w = cvt_pk_bf16(y1[6], y1[7]);
    w2.x = cvt_pk_bf16(y2[0], y2[1]); w2.y = cvt_pk_bf16(y2[2], y2[3]); w2.z = cvt_pk_bf16(y2[4], y2[5]); w2.w = cvt_pk_bf16(y2[6], y2[7]);
    LAS char* dst = shm + R_K + (row >> 6) * 8192 + (row & 63) * 64 + c * 16;
    *(LAS u32x4*)dst = w1; *(LAS u32x4*)(dst + 4096) = w2; }
  asm volatile("s_waitcnt vmcnt(0) lgkmcnt(0)\n\ts_barrier" ::: "memory");
  const int wg = wid >> 2, dt = (wid >> 1) & 1, et = wid & 1;
  const int vbl = ((lane >> 4) & 1) * 32 + (lane & 3) * 8 + (4 * hi + ((lane & 15) >> 2)) * 64;
  f32x16 acc = f32x16{};
#pragma unroll
  for (int tt = 0; tt < 2; ++tt) { const int tile = 2 * wg + tt;
#pragma unroll
    for (int ks = 0; ks < 4; ++ks) { const bf16x8 a = tr_frag((int)lds0 + R_K + tile * 8192 + vbl, dt * 4096 + ks * 1024), bb = tr_frag((int)lds0 + R_V + tile * 8192 + vbl, et * 4096 + ks * 1024);
      acc = __builtin_amdgcn_mfma_f32_32x32x16_bf16(a, bb, acc, 0, 0, 0); } }
  float* Uo = P.U + ((size_t)((b * 4 + h) * 64 + 2 * cp + wg)) * 4096 + (32 * dt) * 64 + 32 * et + (lane & 31);
#pragma unroll
  for (int r = 0; r < 16; ++r) Uo[crow(r, hi) * 64] = acc[r];
  asm volatile("s_waitcnt lgkmcnt(0)\n\ts_barrier" ::: "memory");
}

__device__ __forceinline__ void out_unit(const RetPtrs& P, int b, int h, int cp, LAS char* shm) {
  const int tid = tidx(), lane = tid & 63, r32 = lane & 31, hi = lane >> 5; const int wid = __builtin_amdgcn_readfirstlane(tid >> 6);
  const unsigned lds0 = (unsigned)(uintptr_t)shm;
  const float lg = gamma_log2(h);
  const long rowbase = (long)b * SEQ;
  dma_v4(P, b, h, cp, lds0, wid, lane);
#pragma unroll
  for (int it = 0; it < 2; ++it) { const int item = tid + 512 * it, row = item >> 2, c = item & 3; const int pos = 256 * cp + row;
    const bf16_t* src = P.proj + (rowbase + pos) * NPP + O_RK + h * 64 + 8 * c;
    const bf16x8 lo = *(const bf16x8*)src, hi8 = *(const bf16x8*)(src + 32);
    const float2* tb = P.tabr + pos * 32 + 8 * c;
    float y1[8], y2[8];
#pragma unroll
    for (int j = 0; j < 8; ++j) { const float2 cs = tb[j]; const float x1 = bf2f((bf16_t)lo[j]), x2 = bf2f((bf16_t)hi8[j]); y1[j] = (x1 * cs.x - x2 * cs.y) * 0.125f; y2[j] = (x1 * cs.y + x2 * cs.x) * 0.125f; }
    u32x4 w1, w2; w1.x = cvt_pk_bf16(y1[0], y1[1]); w1.y = cvt_pk_bf16(y1[2], y1[3]); w1.z = cvt_pk_bf16(y1[4], y1[5]); w1.w = cvt_pk_bf16(y1[6], y1[7]);
    w2.x = cvt_pk_bf16(y2[0], y2[1]); w2.y = cvt_pk_bf16(y2[2], y2[3]); w2.z = cvt_pk_bf16(y2[4], y2[5]); w2.w = cvt_pk_bf16(y2[6], y2[7]);
    LAS char* dst = shm + R_K + (row >> 6) * 8192 + c * 1024 + (row & 63) * 16;
    *(LAS u32x4*)dst = w1; *(LAS u32x4*)(dst + 4096) = w2; }
  { const int n0 = 2 * cp; const float cd = exp2f(lg * 128.0f);
    const float* Ub = P.U + (size_t)((b * 4 + h) * 64) * 4096 + tid * 8;
    f32x4 s0a = (f32x4){0.f, 0.f, 0.f, 0.f}, s0b = s0a;
    for (int m = 0; m < n0; ++m) { const f32x4 ua = *(const f32x4*)(Ub + (size_t)m * 4096), ub = *(const f32x4*)(Ub + (size_t)m * 4096 + 4); s0a = s0a * cd + ua; s0b = s0b * cd + ub; }
    const f32x4 ua = *(const f32x4*)(Ub + (size_t)n0 * 4096), ub = *(const f32x4*)(Ub + (size_t)n0 * 4096 + 4);
    const f32x4 s1a = s0a * cd + ua, s1b = s0b * cd + ub;
    const int d = tid >> 3, e0 = (tid & 7) * 8;
    LAS bf16_t* st0 = (LAS bf16_t*)(shm + R_ST), * st1 = st0 + 64 * ST_PITCH;
#pragma unroll
    for (int j = 0; j < 4; ++j) { st0[(e0 + j) * ST_PITCH + d] = (bf16_t)f2bf(s0a[j]); st0[(e0 + 4 + j) * ST_PITCH + d] = (bf16_t)f2bf(s0b[j]);
      st1[(e0 + j) * ST_PITCH + d] = (bf16_t)f2bf(s1a[j]); st1[(e0 + 4 + j) * ST_PITCH + d] = (bf16_t)f2bf(s1b[j]); } }
  const int wg = wid >> 2; const int qi = (wid & 3) * 32 + r32;
  const int qpos = 256 * cp + 128 * wg + qi;
  bf16x8 qr[4], qx[4];
  { const bf16_t* qrow = P.proj + (rowbase + qpos) * NPP + O_RQ + h * 64 + hi * 8;
    float qf[4][8];
#pragma unroll
    for (int d0 = 0; d0 < 4; ++d0) { const bf16x8 v = *(const bf16x8*)(qrow + d0 * 16);
#pragma unroll
      for (int j = 0; j < 8; ++j) qf[d0][j] = bf2f((bf16_t)v[j]); }
#pragma unroll
    for (int d0 = 0; d0 < 2; ++d0) { const float2* tb = P.tabr + qpos * 32 + 16 * d0 + 8 * hi;
#pragma unroll
      for (int j = 0; j < 8; ++j) { const float2 cs = tb[j]; const float x1 = qf[d0][j], x2 = qf[d0 + 2][j]; qf[d0][j] = x1 * cs.x - x2 * cs.y; qf[d0 + 2][j] = x1 * cs.y + x2 * cs.x; } }
    const float xi = exp2f(lg * (float)(qi + 1));
#pragma unroll
    for (int d0 = 0; d0 < 4; ++d0) { u32x4 w, x;
      w.x = cvt_pk_bf16(qf[d0][0], qf[d0][1]); w.y = cvt_pk_bf16(qf[d0][2], qf[d0][3]); w.z = cvt_pk_bf16(qf[d0][4], qf[d0][5]); w.w = cvt_pk_bf16(qf[d0][6], qf[d0][7]);
      x.x = cvt_pk_bf16(qf[d0][0] * xi, qf[d0][1] * xi); x.y = cvt_pk_bf16(qf[d0][2] * xi, qf[d0][3] * xi); x.z = cvt_pk_bf16(qf[d0][4] * xi, qf[d0][5] * xi); x.w = cvt_pk_bf16(qf[d0][6] * xi, qf[d0][7] * xi);
      qr[d0] = __builtin_bit_cast(bf16x8, w); qx[d0] = __builtin_bit_cast(bf16x8, x); } }
  asm volatile("s_waitcnt vmcnt(0) lgkmcnt(0)\n\ts_barrier" ::: "memory");
  f32x16 o[2]; o[0] = f32x16{}; o[1] = f32x16{};
  const int vb0 = (int)(lds0 + R_V) + ((lane >> 4) & 1) * 32 + (lane & 3) * 8 + (4 * hi + ((lane & 15) >> 2)) * 64;
#pragma unroll
  for (int tt = 0; tt < 2; ++tt) {
    if (tt * 64 <= (wid & 3) * 32 + 31) {
      const int tile = 2 * wg + tt;
      f32x16 p0 = f32x16{}, p1 = f32x16{};
      qkt<4>(p0, p1, shm + R_K + tile * 8192, qr, r32, hi);
#pragma unroll
      for (int r = 0; r < 16; ++r) { const int ki = tt * 64 + crow(r, hi);
        const float d0 = (qi >= ki) ? exp2f(lg * (float)(qi - ki)) : 0.f, d1 = (qi >= ki + 32) ? exp2f(lg * (float)(qi - ki - 32)) : 0.f;
        p0[r] *= d0; p1[r] *= d1; }
      u32x4 pw0, pw1, pw2, pw3;
      pw0 = (u32x4){cvt_pk_bf16(p0[0], p0[1]), cvt_pk_bf16(p0[2], p0[3]), cvt_pk_bf16(p0[4], p0[5]), cvt_pk_bf16(p0[6], p0[7])};
      pw1 = (u32x4){cvt_pk_bf16(p0[8], p0[9]), cvt_pk_bf16(p0[10], p0[11]), cvt_pk_bf16(p0[12], p0[13]), cvt_pk_bf16(p0[14], p0[15])};
      pw2 = (u32x4){cvt_pk_bf16(p1[0], p1[1]), cvt_pk_bf16(p1[2], p1[3]), cvt_pk_bf16(p1[4], p1[5]), cvt_pk_bf16(p1[6], p1[7])};
      pw3 = (u32x4){cvt_pk_bf16(p1[8], p1[9]), cvt_pk_bf16(p1[10], p1[11]), cvt_pk_bf16(p1[12], p1[13]), cvt_pk_bf16(p1[14], p1[15])};
      pv(o, vb0 + tile * 8192, __builtin_bit_cast(bf16x8, pw0), __builtin_bit_cast(bf16x8, pw1), __builtin_bit_cast(bf16x8, pw2), __builtin_bit_cast(bf16x8, pw3));
    }
  }
  { const LAS bf16_t* st = (const LAS bf16_t*)(shm + R_ST) + wg * 64 * ST_PITCH;
#pragma unroll
    for (int eb = 0; eb < 2; ++eb)
#pragma unroll
      for (int s = 0; s < 4; ++s) { const bf16x8 bfrag = *(const LAS bf16x8*)(st + (eb * 32 + r32) * ST_PITCH + 16 * s + 8 * hi);
        o[eb] = __builtin_amdgcn_mfma_f32_32x32x16_bf16(qx[s], bfrag, o[eb], 0, 0, 0); } }
  asm volatile("s_waitcnt lgkmcnt(0)\n\ts_barrier" ::: "memory");
  { LAS float* stg = (LAS float*)(shm + R_STG) + wid * (32 * 66);
#pragma unroll
    for (int r = 0; r < 16; ++r) { stg[crow(r, hi) * 66 + r32] = o[0][r]; stg[crow(r, hi) * 66 + 32 + r32] = o[1][r]; }
    asm volatile("s_waitcnt lgkmcnt(0)" ::: "memory");
    const int row = lane >> 1, half = lane & 1;
    float v[32]; float s1 = 0.f;
#pragma unroll
    for (int j = 0; j < 32; ++j) { v[j] = stg[row * 66 + half * 32 + j]; s1 += v[j]; }
    s1 += __shfl_xor(s1, 1);
    const float mu = s1 * (1.0f / 64.0f); float s2 = 0.f;
#pragma unroll
    for (int j = 0; j < 32; ++j) { v[j] -= mu; s2 += v[j] * v[j]; }
    s2 += __shfl_xor(s2, 1);
    const float rs = rsqrtf(s2 * (1.0f / 64.0f) + LN_EPS);
    const long grow = rowbase + 256 * cp + 128 * wg + (wid & 3) * 32 + row;
    const bf16_t* gp = P.proj + grow * NPP + O_RG + h * 64 + half * 32;
    const float* gw = P.gn_w + h * 64 + half * 32;
    bf16_t* op = P.concat + grow * DM + h * 64 + half * 32;
#pragma unroll
    for (int c = 0; c < 4; ++c) { const bf16x8 g8 = *(const bf16x8*)(gp + 8 * c); float ov[8];
#pragma unroll
      for (int j = 0; j < 8; ++j) { const float g = bf2f((bf16_t)g8[j]); const float silu = g / (1.0f + __expf(-g)); ov[j] = v[8 * c + j] * rs * gw[8 * c + j] * silu; }
      u32x4 w; w.x = cvt_pk_bf16(ov[0], ov[1]); w.y = cvt_pk_bf16(ov[2], ov[3]); w.z = cvt_pk_bf16(ov[4], ov[5]); w.w = cvt_pk_bf16(ov[6], ov[7]);
      *(u32x4*)(op + 8 * c) = w; } }
  asm volatile("s_waitcnt lgkmcnt(0)\n\ts_barrier" ::: "memory");
}
}
namespace moe {
constexpr int CAP = TOK;
struct MoePtrs { const bf16_t* Y; const float* ln_g; const float* ln_b; const float* router_w; const float* router_bias;
                 float* X1; bf16_t* X1B; unsigned* cnt; unsigned* list; float* gate; };

__device__ __forceinline__ void ln1_router_row(const MoePtrs& P, int row, int lane, const LAS float* rw4, LAS float* xs, LAS unsigned* sel, const u32x2 (&yh)[4]) {
  f32x4 v[4]; float s = 0.f;
#pragma unroll
  for (int j = 0; j < 4; ++j) { const u32x2 h = yh[j]; v[j] = (f32x4){__uint_as_float(h.x << 16), __uint_as_float(h.x & 0xffff0000u), __uint_as_float(h.y << 16), __uint_as_float(h.y & 0xffff0000u)}; s += (v[j][0] + v[j][1]) + (v[j][2] + v[j][3]); }
  const float mean = wave_sum(s) * (1.f / DM); float s2 = 0.f;
#pragma unroll
  for (int j = 0; j < 4; ++j) { v[j] = v[j] - mean; s2 += (v[j][0] * v[j][0] + v[j][1] * v[j][1]) + (v[j][2] * v[j][2] + v[j][3] * v[j][3]); }
  const float rstd = rsqrtf(wave_sum(s2) * (1.f / DM) + LN_EPS);
  u32x2* xb = (u32x2*)(P.X1B + (size_t)row * DM) + lane;
#pragma unroll
  for (int j = 0; j < 4; ++j) { const int c0 = 4 * lane + 256 * j;
    const f32x4 g = *(const f32x4*)(P.ln_g + c0), bb = *(const f32x4*)(P.ln_b + c0);
    const f32x4 x = v[j] * rstd * g + bb;
    u32x2 o; o.x = pk2(x[0], x[1]); o.y = pk2(x[2], x[3]); xb[64 * j] = o;
    *(LAS f32x4*)(xs + c0) = x; }
  asm volatile("s_waitcnt lgkmcnt(0)" ::: "memory");
  const int e_l = lane & 15, kq = lane >> 4; float acc = 0.f;
#pragma unroll 8
  for (int i = 0; i < 64; ++i) { const f32x4 x = *(const LAS f32x4*)(xs + 16 * i + 4 * kq); const f32x4 w = *(const LAS f32x4*)(rw4 + ((4 * i + kq) * 16 + e_l) * 4);
    acc = fmaf(x[0], w[0], acc); acc = fmaf(x[1], w[1], acc); acc = fmaf(x[2], w[2], acc); acc = fmaf(x[3], w[3], acc); }
  acc += __shfl_xor(acc, 16); acc += __shfl_xor(acc, 32);
  float sc[16], bi[16];
#pragma unroll
  for (int e = 0; e < 16; ++e) { const float lg = __shfl(acc, e); sc[e] = 1.f / (1.f + expf(-lg)); bi[e] = sc[e] + P.router_bias[e]; }
  int bestg = 0; float bestgs = -INFINITY;
#pragma unroll
  for (int gI = 0; gI < 4; ++gI) { float m1 = -INFINITY, m2 = -INFINITY;
#pragma unroll
    for (int k = 0; k < 4; ++k) { const float x = bi[gI * 4 + k]; if (x > m1) { m2 = m1; m1 = x; } else if (x > m2) { m2 = x; } }
    const float gs = m1 + m2; if (gs > bestgs) { bestgs = gs; bestg = gI; } }
  int i1 = 0, i2 = 0; float m1 = -INFINITY, m2 = -INFINITY, s1 = 0.f, s2v = 0.f;
#pragma unroll
  for (int e = 0; e < 16; ++e) { if ((e >> 2) == bestg) { const float x = bi[e]; if (x > m1) { m2 = m1; i2 = i1; s2v = s1; m1 = x; i1 = e; s1 = sc[e]; } else if (x > m2) { m2 = x; i2 = e; s2v = sc[e]; } } }
  if (lane == 0) { const float inv = 1.f / (s1 + s2v); sel[0] = (unsigned)i1; sel[1] = (unsigned)i2; ((LAS float*)sel)[2] = s1 * inv; ((LAS float*)sel)[3] = s2v * inv; }
}
__device__ __forceinline__ void p5_phase(const MoePtrs& P, LAS char* shm, int vcu, int G) {
  const int tid = tidx(), lane = tid & 63, wave = tid >> 6;
  LAS float* rw4 = (LAS float*)shm; LAS float* xs = (LAS float*)(shm + 65536) + wave * 1024;
  LAS unsigned* sel = (LAS unsigned*)(shm + 98304);
  LAS unsigned* wbase = sel + 4 * 128;
  for (int i = tid; i < DM * 16; i += 512) { const int k = i >> 4, e = i & 15; rw4[((k >> 2) * 16 + e) * 4 + (k & 3)] = P.router_w[i]; }
  __syncthreads();
  const int rows_per_wg = (TOK + G - 1) / G;
  const int row0 = vcu * rows_per_wg; int nrows = TOK - row0; if (nrows > rows_per_wg) nrows = rows_per_wg; if (nrows < 0) nrows = 0;
  { u32x2 ycur[4], ynxt[4];
#pragma unroll
    for (int j = 0; j < 4; ++j) { ynxt[j] = (u32x2){0u, 0u}; if (wave < nrows) ynxt[j] = ((const u32x2*)(P.Y + (size_t)(row0 + wave) * DM) + lane)[64 * j]; }
    for (int r = wave; r < nrows; r += 8) {
#pragma unroll
      for (int j = 0; j < 4; ++j) ycur[j] = ynxt[j];
      if (r + 8 < nrows) {
#pragma unroll
        for (int j = 0; j < 4; ++j) ynxt[j] = ((const u32x2*)(P.Y + (size_t)(row0 + r + 8) * DM) + lane)[64 * j]; }
      ln1_router_row(P, row0 + r, lane, rw4, xs, sel + 4 * r, ycur); } }
  __syncthreads();
  LAS unsigned* wcnt = wbase + 16;
  unsigned e = 99u, myrank = 0u;
  if (wave < 2) { if (tid < 2 * nrows) e = sel[4 * (tid >> 1) + (tid & 1)];
    const unsigned long long lt = (lane == 0) ? 0ull : (~0ull >> (64 - lane));
#pragma unroll
    for (int k = 0; k < 16; ++k) { const unsigned long long mk = __ballot(e == (unsigned)k); if (e == (unsigned)k) myrank = (unsigned)__popcll(mk & lt); if (lane == k) wcnt[wave * 16 + k] = (unsigned)__popcll(mk); } }
  __syncthreads();
  if (tid < 16) { const unsigned c = wcnt[tid] + wcnt[16 + tid]; wbase[tid] = c ? atomicAdd(P.cnt + 64 * tid, c) : 0u; }
  __syncthreads();
  if (tid < 2 * nrows) { const int r = tid >> 1, sl = tid & 1;
    const size_t pos = (size_t)e * CAP + wbase[e] + (wave == 1 ? wcnt[e] : 0u) + myrank;
    P.list[pos] = (unsigned)(row0 + r) * 2u + (unsigned)sl; P.gate[pos] = ((LAS float*)sel)[4 * r + 2 + sl]; }
  __syncthreads();
}

template <int MODE>
struct MoeOrder {
  static constexpr int NPN = MODE == 0 ? 2 : 4, LDA2 = (MODE == 0 ? DM : DEXP) * 2;
  static constexpr size_t BSTRIDE_E = MODE == 0 ? (size_t)512 * DM * 2 : (size_t)DM * DEXP * 2, BSTRIDE_PN = MODE == 0 ? (size_t)256 * DM * 2 : (size_t)256 * DEXP * 2;
  const unsigned* __restrict__ cnt; const unsigned* __restrict__ list; const char* A; const char* Bt;
  __device__ __forceinline__ bool next(int i, pg8::Unit& u) const {
    const int L = i * (int)gridDim.x + (int)blockIdx.x; const int tile = L / NPN; u.pn = L % NPN; u.pm = tile;
    int acc = 0, e = -1, mt = 0, valid = 0;
#pragma unroll
    for (int k = 0; k < NEXP; ++k) { const int cn = __builtin_amdgcn_readfirstlane((int)cnt[64 * k]); const int nt = (cn + 255) >> 8; if (e < 0 && tile < acc + nt) { e = k; mt = tile - acc; valid = cn - mt * 256; } acc += nt; }
    if (e < 0) return false;
    u.e = e; u.mt = mt; u.valid = valid > 256 ? 256 : valid; u.pad = 0;
    u.pA = MODE == 1 ? A + (size_t)tile * 256 * LDA2 : A;
    u.pB = Bt + (size_t)e * BSTRIDE_E + (size_t)u.pn * BSTRIDE_PN;
    return true;
  }
  __device__ __forceinline__ unsigned rowoff(const pg8::Unit& u, int r) const {
    unsigned slot = 0u; if (r < u.valid) slot = list[(size_t)u.e * CAP + u.mt * 256 + r];
    return (slot >> 1) * (unsigned)LDA2; }
};
struct EpiSwiglu {
  static constexpr bool PERM = true;
  bf16_t* A2; const float* gate;
  __device__ __forceinline__ void operator()(const f32x4 (&acc)[2][2][4][2], const pg8::Unit& u, int wr, int wc, int fr, int fq) const {
    { const int l_ = tidx() & 63; fr = l_ & 15; fq = l_ >> 4; }
    const int col0 = u.pn * 128 + wc * 32 + 8 * fq; const int lane = fq * 16 + fr;
    const int rb = wr * 64 + lane; const size_t gb = (size_t)u.e * CAP + u.mt * 256;
    float g0 = 0.f, g1 = 0.f; if (rb < u.valid) g0 = gate[gb + rb]; if (128 + rb < u.valid) g1 = gate[gb + 128 + rb];
#pragma unroll
    for (int ai = 0; ai < 2; ++ai)
#pragma unroll
      for (int m = 0; m < 4; ++m) { const int r = ai * 128 + wr * 64 + m * 16 + fr;
        const float g = __shfl(ai ? g1 : g0, m * 16 + fr);
        float a[8];
#pragma unroll
        for (int n = 0; n < 2; ++n)
#pragma unroll
          for (int i = 0; i < 4; ++i) { const float h1 = acc[ai][0][m][n][i], h2 = acc[ai][1][m][n][i]; a[4 * n + i] = h1 / (1.f + __expf(-h1)) * h2 * g; }
        u32x4 w; w.x = cvt_pk_bf16(a[0], a[1]); w.y = cvt_pk_bf16(a[2], a[3]); w.z = cvt_pk_bf16(a[4], a[5]); w.w = cvt_pk_bf16(a[6], a[7]);
        *(u32x4*)(A2 + ((size_t)u.pm * 256 + r) * 256 + col0) = w;
        asm volatile("" ::: "memory"); }
  }
};
struct EpiScatter {
  static constexpr bool PERM = true;
  bf16_t* YE; const unsigned* list;
  __device__ __forceinline__ void operator()(const f32x4 (&acc)[2][2][4][2], const pg8::Unit& u, int wr, int wc, int fr, int fq) const {
    { const int l_ = tidx() & 63; fr = l_ & 15; fq = l_ >> 4; }
    const int col0 = u.pn * 256 + wc * 32 + 8 * fq; const int lane = fq * 16 + fr;
    const int rb = wr * 64 + lane; const size_t gb = (size_t)u.e * CAP + u.mt * 256;
    unsigned s0 = (unsigned)(2 * TOK), s1 = (unsigned)(2 * TOK); if (rb < u.valid) s0 = list[gb + rb]; if (128 + rb < u.valid) s1 = list[gb + 128 + rb];
#pragma unroll
    for (int ai = 0; ai < 2; ++ai)
#pragma unroll
      for (int m = 0; m < 4; ++m) {
        const unsigned slot = (unsigned)__shfl((int)(ai ? s1 : s0), m * 16 + fr);
        { bf16_t* rowp = YE + (size_t)slot * DM + col0;
#pragma unroll
          for (int bj = 0; bj < 2; ++bj) { const f32x4 v0 = acc[ai][bj][m][0], v1 = acc[ai][bj][m][1];
            u32x4 w; w.x = cvt_pk_bf16(v0[0], v0[1]); w.y = cvt_pk_bf16(v0[2], v0[3]); w.z = cvt_pk_bf16(v1[0], v1[1]); w.w = cvt_pk_bf16(v1[2], v1[3]);
            *(u32x4*)(rowp + bj * 128) = w; } }
        asm volatile("" ::: "memory"); }
  }
};
struct Ln2Ptrs { const bf16_t* X1; const bf16_t* YE; const float* g; const float* b; float* out; bf16_t* XB; };
#define LN2_LOAD(P, row, lane, X, Y0, Y1) do { const u32x2* xr_ = (const u32x2*)((P).X1 + (size_t)(row) * DM) + (lane); \
  const u32x2* y0_ = (const u32x2*)((P).YE + (size_t)(row) * 2 * DM) + (lane); const u32x2* y1_ = y0_ + DM / 4; \
  _Pragma("unroll") for (int j = 0; j < 4; ++j) { X[j] = xr_[64 * j]; Y0[j] = y0_[64 * j]; Y1[j] = y1_[64 * j]; } } while (0)
__device__ __forceinline__ void ln2_row(const Ln2Ptrs& P, int row, int lane, const u32x2 (&inx)[4], const u32x2 (&iny0)[4], const u32x2 (&iny1)[4]) {
  f32x4 v[4]; float s = 0.f;
#pragma unroll
  for (int j = 0; j < 4; ++j) { const u32x2 xh = inx[j]; const f32x4 x = (f32x4){__uint_as_float(xh.x << 16), __uint_as_float(xh.x & 0xffff0000u), __uint_as_float(xh.y << 16), __uint_as_float(xh.y & 0xffff0000u)}; const u32x2 a = iny0[j], bq = iny1[j];
    f32x4 y; y[0] = __uint_as_float(a.x << 16) + __uint_as_float(bq.x << 16); y[1] = __uint_as_float(a.x & 0xffff0000u) + __uint_as_float(bq.x & 0xffff0000u);
    y[2] = __uint_as_float(a.y << 16) + __uint_as_float(bq.y << 16); y[3] = __uint_as_float(a.y & 0xffff0000u) + __uint_as_float(bq.y & 0xffff0000u);
    v[j] = x * ALPHA + y; s += (v[j][0] + v[j][1]) + (v[j][2] + v[j][3]); }
  const float mean = wave_sum(s) * (1.f / DM); float s2 = 0.f;
#pragma unroll
  for (int j = 0; j < 4; ++j) { v[j] = v[j] - mean; s2 += (v[j][0] * v[j][0] + v[j][1] * v[j][1]) + (v[j][2] * v[j][2] + v[j][3] * v[j][3]); }
  const float rstd = rsqrtf(wave_sum(s2) * (1.f / DM) + LN_EPS);
  f32x4* xo = (f32x4*)(P.out + (size_t)row * DM) + lane; u32x2* xb = (u32x2*)(P.XB + (size_t)row * DM) + lane;
#pragma unroll
  for (int j = 0; j < 4; ++j) { const int c0 = 4 * lane + 256 * j;
    const f32x4 g = *(const f32x4*)(P.g + c0), bb = *(const f32x4*)(P.b + c0);
    const f32x4 x = v[j] * rstd * g + bb;
    if (P.out) xo[64 * j] = x; else { u32x2 o; o.x = pk2(x[0], x[1]); o.y = pk2(x[2], x[3]); xb[64 * j] = o; } }
}
}
#ifndef PROBE_PHASE
#define PROBE_PHASE 0
#endif
#define NREP(p) ((PROBE_PHASE == (p)) ? 2 : 1)
constexpr int LDS_BYTES = 147456;
constexpr int NTHREADS = 512;
constexpr int MISC_OFF = 131072;
constexpr int CW_QCTR = 64;
constexpr int CW_CNT = 8192;
constexpr int CW_BAR = 4096;

typedef GAS unsigned gu32;
#define RLX_AGENT __ATOMIC_RELAXED, __HIP_MEMORY_SCOPE_AGENT
#define XB_TMO      128
#define XB_XCNT(j)  (256  + 64 * (j))
#define XB_XSUB(j)  (1280 + 64 * (j))
#define XB_XGEN(j)  (2304 + 64 * (j))
#define XB_TOP      3328
#define XB_TOPGEN   3392
#define XCD_BAR_WORDS 3456
#define XB_SPIN_CAP (1u << 20)
__device__ __forceinline__ unsigned xb_ld(gu32* p)              { return __hip_atomic_load(p, __ATOMIC_RELAXED, __HIP_MEMORY_SCOPE_AGENT); }
__device__ __forceinline__ unsigned xb_add(gu32* p, unsigned v) { return __hip_atomic_fetch_add(p, v, __ATOMIC_RELAXED, __HIP_MEMORY_SCOPE_AGENT); }
__device__ __forceinline__ unsigned xb_xcc_id() { return (unsigned)__builtin_amdgcn_s_getreg((3 << 11) | 20) & 0xFu; }
#define XB_SPIN(cond, bar) do { unsigned _sp = 0; while (cond) { __builtin_amdgcn_s_sleep(1); \
    if ((++_sp & 255u) == 0u) { if (xb_ld(&(bar)[XB_TMO])) break; if (_sp > XB_SPIN_CAP) { (void)xb_add(&(bar)[XB_TMO], 1u); break; } } } } while (0)
struct XcdBarrier { gu32* bar; unsigned x; volatile LAS unsigned* st; };
__device__ __forceinline__ XcdBarrier xcd_barrier_post(gu32* bar, volatile LAS unsigned* st) {
    XcdBarrier b; b.bar = bar; b.x = xb_xcc_id(); b.st = st;
    if (tidx() == 0) (void)xb_add(&bar[XB_XCNT(b.x)], 1u);
    return b;
}
__device__ __forceinline__ void xcd_barrier_complete(gu32* bar, unsigned x, unsigned& nloc, unsigned& nx) {
    const unsigned G = gridDim.x * gridDim.y * gridDim.z;
    unsigned sum, cnt, mine, sp = 0u;
    for (;;) {
        sum = 0u; cnt = 0u; mine = 0u;
#pragma unroll
        for (unsigned j = 0; j < 16; ++j) { const unsigned c = xb_ld(&bar[XB_XCNT(j)]); sum += c; cnt += (c > 0u) ? 1u : 0u; mine = (j == x) ? c : mine; }
        if (sum == G) break;
        __builtin_amdgcn_s_sleep(1);
        if ((++sp & 255u) == 0u) { if (xb_ld(&bar[XB_TMO])) break; if (sp > XB_SPIN_CAP) { (void)xb_add(&bar[XB_TMO], 1u); break; } }
    }
    nloc = mine > 0u ? mine : 1u; nx = cnt > 0u ? cnt : 1u;
}
__device__ __forceinline__ void xcd_barrier(const XcdBarrier& b) {
    asm volatile("s_waitcnt vmcnt(0)" ::: "memory");
    __syncthreads();
    if (tidx() == 0) {
        gu32* bar = b.bar; unsigned bx_ = b.x;
        asm volatile("" : "+s"(bar), "+s"(bx_));
        __builtin_amdgcn_s_waitcnt(0);
        unsigned nloc = b.st[0], nx = b.st[1];
        if (nloc == 0u) { xcd_barrier_complete(bar, bx_, nloc, nx); b.st[0] = nloc; b.st[1] = nx; }
        const unsigned old = xb_add(&bar[XB_XSUB(bx_)], 1u);
        const unsigned gen = old / nloc;
        if (old + 1u == (gen + 1u) * nloc) {
            __builtin_amdgcn_fence(__ATOMIC_RELEASE, "agent");
            asm volatile("s_waitcnt vmcnt(0)" ::: "memory");
            const unsigned og = xb_add(&bar[XB_TOP], 1u);
            const unsigned tg = og / nx;
            if (og + 1u == (tg + 1u) * nx) xb_add(&bar[XB_TOPGEN], 1u);
            else XB_SPIN(xb_ld(&bar[XB_TOPGEN]) == tg, bar);
            __builtin_amdgcn_fence(__ATOMIC_ACQUIRE, "agent");
            xb_add(&bar[XB_XGEN(bx_)], 1u);
            asm volatile("s_waitcnt vmcnt(0)" ::: "memory");
        } else {
            XB_SPIN(xb_ld(&bar[XB_XGEN(bx_)]) == gen, bar);
            __builtin_amdgcn_fence(__ATOMIC_ACQUIRE, "agent");
            asm volatile("s_waitcnt vmcnt(0)" ::: "memory");
        }
    }
    __syncthreads();
}

struct Args { const float* in[17]; float* out; unsigned char* ws; };
#define CAS __attribute__((address_space(4)))
__device__ __forceinline__ const CAS char* kargs() { const CAS char* kp = (const CAS char*)__builtin_amdgcn_kernarg_segment_ptr(); asm volatile("" : "+s"(kp)); return kp; }

__global__ void __launch_bounds__(NTHREADS, 2) mk_fwd(Args a) {
    extern __shared__ __attribute__((aligned(16))) unsigned char lds[];
    LAS unsigned char* L = (LAS unsigned char*)lds;
    LAS char* shm = (LAS char*)lds;
    volatile LAS unsigned* MISC = (volatile LAS unsigned*)(L + MISC_OFF);
#define lane (tidx() & 63)
#define wave (__builtin_amdgcn_readfirstlane(tidx() >> 6))
    const int G = gridDim.x, bx = blockIdx.x;
    const int vcu = (G % 8 == 0) ? (bx % 8) * (G / 8) + bx / 8 : bx;
    for (int u = tidx(); u < (LDS_BYTES - MISC_OFF) / 4; u += NTHREADS) ((LAS unsigned*)(L + MISC_OFF))[u] = 0u;
    __syncthreads();

#define KPTR(off, ET) ((ET*)(ET GAS*)(*(const unsigned long long CAS*)(kargs() + (off))))
#define IN_(i) KPTR(8 * (i), const float)
#define g_x_in IN_(0)
#define g_w_in IN_(1)
#define g_ret_gn_w IN_(2)
#define g_swa_sinks IN_(3)
#define g_qn_w IN_(4)
#define g_kvn_w IN_(5)
#define g_w_uq IN_(6)
#define g_w_ukv IN_(7)
#define g_w_out IN_(8)
#define g_ln1_g IN_(9)
#define g_ln1_b IN_(10)
#define g_router_w IN_(11)
#define g_router_bias IN_(12)
#define g_wgu IN_(13)
#define g_wd IN_(14)
#define g_ln2_g IN_(15)
#define g_ln2_b IN_(16)
#define g_out KPTR(136, float)
#define g_ws KPTR(144, unsigned char)
#define g_CTL ((unsigned*)(g_ws + WS_CTL))
#define g_XB ((bf16_t*)(g_ws + WS_R0))
#define g_PROJ ((bf16_t*)(g_ws + WS_R1))
#define g_Y ((bf16_t*)(g_ws + WS_R1))
#define g_QM ((bf16_t*)(g_ws + WS_QM))
#define g_KVM ((bf16_t*)(g_ws + WS_KVM))
#define g_KPE ((bf16_t*)(g_ws + WS_KPE))
#define g_CONCAT ((bf16_t*)(g_ws + WS_R3))
#define g_X1 ((float*)(g_ws + WS_X1))
#define g_TABR ((const float2*)(g_ws + WS_TABR))
#define g_TABM ((const float2*)(g_ws + WS_TABM))
#define g_X1B ((bf16_t*)(g_ws + WS_R0))
#define g_A2 ((bf16_t*)(g_ws + WS_A2))
#define g_YE ((bf16_t*)(g_ws + WS_YE))
#define g_list ((unsigned*)(g_ws + WS_LIST))
#define g_gate ((float*)(g_ws + WS_GATE))

    XcdBarrier bar = xcd_barrier_post((gu32*)(g_CTL + CW_BAR), MISC + 8);
#define GRID_BAR() do { xcd_barrier(bar); if (PROBE_PHASE == 10) xcd_barrier(bar); } while (0)

    for (int rep_ = 0; rep_ < NREP(9); ++rep_)
    { P0Args pa; pa.x = g_x_in; pa.w_in = g_w_in; pa.qn_w = g_qn_w; pa.kvn_w = g_kvn_w; pa.w_uq = g_w_uq; pa.w_ukv = g_w_ukv; pa.w_out = g_w_out; pa.ws = g_ws;
      p0_all(pa, L, vcu, G);
      p0_experts(g_wgu, g_wd, g_ws, (LAS float*)(L + wave * 16384), vcu * 8 + wave, G * 8, lane); }
    GRID_BAR();

    for (int l = 0; l < DEPTH; ++l) {
        for (int rep_ = 0; rep_ < NREP(1); ++rep_)
        { pg8::Gemm g{g_XB, (const bf16_t*)(g_ws + WS_WIN) + (size_t)l * NPP * DM, DM, DM, DM, 0}; pg8::EpiBf16Norm E{g_PROJ, (float*)(g_ws + WS_PARTS), NPP, 0};
          pg8::StaticOrder S; S.init(g, TOK, NPP, G, bx);
          pg8::gemm_phase<pg8::EpiBf16Norm, pg8::StaticOrder, true, false>(L, g, S, E); }
        GRID_BAR();
        for (int rep_ = 0; rep_ < NREP(2); ++rep_) {
        { pg8::Gemm g{g_PROJ + O_CQ, (const bf16_t*)(g_ws + WS_WUQ) + (size_t)l * NQMP * 384, NPP, 384, 384, 0}; pg8::EpiRms E{g_QM, (const float*)(g_ws + WS_PARTS), NQMP, 0, 8, 1.0f / 384.0f, RMS_EPS, 0};
          pg8::StaticOrder S; S.init(g, TOK, NQMP, G, bx);
          pg8::gemm_phase<pg8::EpiRms, pg8::StaticOrder, true, false>(L, g, S, E); }
        { pg8::Gemm g{g_PROJ + O_CKV, (const bf16_t*)(g_ws + WS_WUKV) + (size_t)l * NKVM * 256, NPP, 256, 256, 0}; pg8::EpiRms E{g_KVM, (const float*)(g_ws + WS_PARTS), NKVM, 8, 4, 1.0f / 256.0f, RMS_EPS, 0};
          pg8::StaticOrder S; S.init(g, TOK, NKVM, G, G - 1 - bx);
          pg8::gemm_phase<pg8::EpiRms, pg8::StaticOrder, true, false>(L, g, S, E); }
        for (int idx = vcu * NTHREADS + tidx(); idx < TOK * 16; idx += G * NTHREADS) {
          const int t = idx >> 4, i = idx & 15, pos = t % SEQ; const bf16_t* p = g_PROJ + (size_t)t * NPP + O_KR; const float2 cs = g_TABM[pos * 16 + i];
          const float x1 = bf2f(p[i]), x2 = bf2f(p[i + 16]);
          g_KPE[(size_t)t * 32 + i] = (bf16_t)f2bf(x1 * cs.x - x2 * cs.y); g_KPE[(size_t)t * 32 + i + 16] = (bf16_t)f2bf(x1 * cs.y + x2 * cs.x); }
        { ret::RetPtrs rp; rp.proj = g_PROJ; rp.tabr = g_TABR; rp.gn_w = g_ret_gn_w + l * 256; rp.U = (float*)(g_ws + WS_U); rp.concat = g_CONCAT;
          for (int u = G - 1 - bx; u < 256; u += G) ret::upd_unit(rp, u >> 7, (u >> 5) & 3, u & 31, shm); }
        }
        GRID_BAR();
        { att::AttnPtrs ap; ap.proj = g_PROJ; ap.qm = g_QM; ap.kvm = g_KVM; ap.kpe = g_KPE; ap.tabm = g_TABM; ap.sinks = g_swa_sinks + l * 6; ap.concat = g_CONCAT;
          ret::RetPtrs rp; rp.proj = g_PROJ; rp.tabr = g_TABR; rp.gn_w = g_ret_gn_w + l * 256; rp.U = (float*)(g_ws + WS_U); rp.concat = g_CONCAT;
          for (int rep_ = 0; rep_ < NREP(3); ++rep_)
          for (;;) {
            if (tidx() == 0) MISC[0] = atomicAdd(g_CTL + CW_QCTR + 64 * l + rep_, 1u);
            __syncthreads();
            const unsigned idx = MISC[0];
            __syncthreads();
            if (idx >= 1024u) break;
            if (idx < 384u) { const int qb = 31 - (int)(idx / 12u), bh = (int)(idx % 12u); att::attn_unit<0>(ap, bh / 6, bh % 6, qb, shm); }
            else if (idx < 768u) { const unsigned i2 = idx - 384u; const int qb = (int)(i2 / 12u), bh = (int)(i2 % 12u); att::attn_unit<1>(ap, bh / 6, bh % 6, qb, shm); }
            else { const int u = (int)(idx - 768u); ret::out_unit(rp, u >> 7, (u >> 5) & 3, u & 31, shm); }
          } }
        GRID_BAR();
        for (int rep_ = 0; rep_ < NREP(4); ++rep_)
        { pg8::Gemm g{g_CONCAT, (const bf16_t*)(g_ws + WS_WOUT) + (size_t)l * DM * DM, DM, DM, DM, 0}; pg8::EpiResid E{(l == 0) ? g_x_in : (const float*)nullptr, g_XB, g_Y, DM, ALPHA};
          pg8::StaticOrder S; S.init(g, TOK, DM, G, bx);
          pg8::gemm_phase<pg8::EpiResid, pg8::StaticOrder, true, false>(L, g, S, E); }
        GRID_BAR();
#define g_cnt (g_CTL + CW_CNT + 2048 * l)
        if (PROBE_PHASE == 5) { moe::MoePtrs mp; mp.Y = g_Y; mp.ln_g = g_ln1_g + l * DM; mp.ln_b = g_ln1_b + l * DM; mp.router_w = g_router_w; mp.router_bias = g_router_bias; mp.X1 = nullptr; mp.X1B = g_X1B;
          mp.cnt = g_CTL + CW_CNT + 2048 * l + 1024; mp.list = (unsigned*)(g_ws + WS_R1 + 64 * MiB); mp.gate = (float*)(g_ws + WS_R1 + 65 * MiB);
          moe::p5_phase(mp, shm, vcu, G); }
        { moe::MoePtrs mp; mp.Y = g_Y; mp.ln_g = g_ln1_g + l * DM; mp.ln_b = g_ln1_b + l * DM; mp.router_w = g_router_w; mp.router_bias = g_router_bias; mp.X1 = nullptr; mp.X1B = g_X1B; mp.cnt = g_cnt; mp.list = g_list; mp.gate = g_gate;
          moe::p5_phase(mp, shm, vcu, G); }
        GRID_BAR();
        for (int rep_ = 0; rep_ < NREP(6); ++rep_)
        { moe::MoeOrder<0> S; S.cnt = g_cnt; S.list = g_list; S.A = (const char*)g_X1B; S.Bt = (const char*)(g_ws + WS_WGU);
          pg8::Gemm g{nullptr, nullptr, DM, DM, DM, 0}; moe::EpiSwiglu E{g_A2, g_gate};
          pg8::gemm_phase<moe::EpiSwiglu, moe::MoeOrder<0>, true, true>(L, g, S, E); }
        GRID_BAR();
        for (int rep_ = 0; rep_ < NREP(7); ++rep_)
        { moe::MoeOrder<1> S; S.cnt = g_cnt; S.list = g_list; S.A = (const char*)g_A2; S.Bt = (const char*)(g_ws + WS_WD);
          pg8::Gemm g{nullptr, nullptr, DEXP, DEXP, DEXP, 0}; moe::EpiScatter E{g_YE, g_list};
          pg8::gemm_phase<moe::EpiScatter, moe::MoeOrder<1>, true, false>(L, g, S, E); }
        GRID_BAR();
        for (int rep_ = 0; rep_ < NREP(8); ++rep_)
        { moe::Ln2Ptrs lp; lp.X1 = g_X1B; lp.YE = g_YE; lp.g = g_ln2_g + l * DM; lp.b = g_ln2_b + l * DM; lp.out = (l + 1 < DEPTH) ? (float*)nullptr : g_out; lp.XB = g_XB;
          u32x2 cx[4], cy0[4], cy1[4], nx[4], ny0[4], ny1[4]; int row = vcu * 8 + wave; const int ln_ = lane;
#pragma unroll
          for (int j = 0; j < 4; ++j) { nx[j] = (u32x2){0u, 0u}; ny0[j] = nx[j]; ny1[j] = nx[j]; }
          if (row < TOK) LN2_LOAD(lp, row, ln_, nx, ny0, ny1);
          for (; row < TOK; row += G * 8) {
#pragma unroll
            for (int j = 0; j < 4; ++j) { cx[j] = nx[j]; cy0[j] = ny0[j]; cy1[j] = ny1[j]; }
            if (row + G * 8 < TOK) LN2_LOAD(lp, row + G * 8, ln_, nx, ny0, ny1);
            moe::ln2_row(lp, row, ln_, cx, cy0, cy1); } }
        if (l + 1 < DEPTH) {
          p0_experts(g_wgu + (size_t)(l + 1) * NEXP * DM * 512, g_wd + (size_t)(l + 1) * NEXP * DEXP * DM, g_ws, (LAS float*)(L + wave * 16384), vcu * 8 + wave, G * 8, lane);
          GRID_BAR();
        }
    }
    if (xb_ld((gu32*)(g_CTL + CW_BAR + XB_TMO)) != 0u && bx == 0 && tidx() == 0) g_out[0] = __builtin_nanf("");
#undef g_out
#undef g_ws
#undef g_list
#undef g_gate
#undef g_cnt
}

extern "C" void kernel_launch(void* const* d_in, const int* in_sizes, int n_in, void* d_out, int out_size, void* d_ws, size_t ws_size, hipStream_t stream) {
    static int grid = 0;
    if (grid == 0) {
        if (n_in != 17 || ws_size < WS_END || out_size != TOK * DM) { fprintf(stderr, "kernel_launch: unexpected problem (n_in %d, ws %zu, out %d); nothing launched\n", n_in, ws_size, out_size); grid = -1; return; }
        int dev = 0, cus = 0, per_cu = 0;
        if (hipGetDevice(&dev) != hipSuccess || hipDeviceGetAttribute(&cus, hipDeviceAttributeMultiprocessorCount, dev) != hipSuccess) { grid = -1; return; }
        if (hipFuncSetAttribute((const void*)mk_fwd, hipFuncAttributeMaxDynamicSharedMemorySize, LDS_BYTES) != hipSuccess) { fprintf(stderr, "kernel_launch: hipFuncSetAttribute failed\n"); grid = -1; return; }
        if (hipOccupancyMaxActiveBlocksPerMultiprocessor(&per_cu, (const void*)mk_fwd, NTHREADS, LDS_BYTES) != hipSuccess || per_cu < 1) { fprintf(stderr, "kernel_launch: occupancy query says %d workgroups per CU\n", per_cu); (void)hipGetLastError(); grid = -1; return; }
        grid = cus;
    }
    if (grid < 0) return;
    (void)hipMemsetAsync((char*)d_ws + WS_CTL, 0, CTL_ZERO_BYTES, stream);
    Args a{};
    for (int i = 0; i < 17; ++i) a.in[i] = (const float*)d_in[i];
    a.out = (float*)d_out; a.ws = (unsigned char*)d_ws;
    hipLaunchKernelGGL(mk_fwd, dim3(grid), dim3(NTHREADS), LDS_BYTES, stream, a);
}
```

```cpp
#define PROBE_PHASE 0
#include <hip/hip_runtime.h>
#include <cstdio>
#include <cstdint>
#include <math.h>
#include <type_traits>

constexpr int BATCH = 2, SEQ = 8192, TOK = BATCH * SEQ, DM = 1024, DEPTH = 2;
constexpr int NP = 2336, NPP = 2560;
constexpr int O_RQ = 0, O_RK = 256, O_RV = 512, O_RG = 768, O_SQ = 1024, O_SK = 1408, O_SV = 1536, O_CQ = 1664, O_CKV = 2048, O_KR = 2304;
constexpr int NQM = 576, NQMP = 768, NKVM = 768;
constexpr int NEXP = 16, DEXP = 256;
constexpr float LN_EPS = 1e-5f, RMS_EPS = 1e-6f;
constexpr float ALPHA = 1.4142135623730951f;
constexpr float LOG2E = 1.4426950408889634f;

typedef unsigned short bf16_t;
typedef short bf16x8 __attribute__((ext_vector_type(8)));
typedef float f32x4 __attribute__((ext_vector_type(4)));
typedef float f32x16 __attribute__((ext_vector_type(16)));
typedef unsigned u32x4 __attribute__((ext_vector_type(4)));
typedef unsigned u32x2 __attribute__((ext_vector_type(2)));
#define LAS __attribute__((address_space(3)))
#define GAS __attribute__((address_space(1)))

constexpr size_t MiB = 1u << 20;
constexpr size_t WS_CTL = 0, CTL_ZERO_BYTES = 1 * MiB;
constexpr size_t WS_LIST = 1 * MiB, WS_GATE = 2 * MiB;
constexpr size_t WS_TABR = 3 * MiB, WS_TABM = 5 * MiB;
constexpr size_t WS_WIN = 6 * MiB;
constexpr size_t WS_WUQ = 16 * MiB;
constexpr size_t WS_WUKV = 17 * MiB + 256 * 1024;
constexpr size_t WS_WOUT = 18 * MiB;
constexpr size_t WS_WGU = 22 * MiB;
constexpr size_t WS_WD = 38 * MiB;
constexpr size_t WS_R0 = 46 * MiB;
constexpr size_t WS_R1 = 78 * MiB;
constexpr size_t WS_A2 = WS_R1, WS_YE = WS_R1 + 18 * MiB;
constexpr size_t WS_R2 = 162 * MiB;
constexpr size_t WS_QM = WS_R2, WS_KVM = WS_R2 + 24 * MiB, WS_KPE = WS_R2 + 48 * MiB, WS_U = WS_R2 + 49 * MiB;
constexpr size_t WS_R3 = 219 * MiB;
constexpr size_t WS_X1 = WS_R2;
constexpr size_t WS_PARTS = 251 * MiB;
constexpr size_t WS_END = 252 * MiB;
static_assert(WS_WUQ + 2 * 768 * 384 * 2 <= WS_WUKV && WS_WUKV + 2 * 768 * 256 * 2 <= WS_WOUT, "ws map");
static_assert(WS_U + 8 * MiB <= WS_R3 && WS_X1 + 64 * MiB <= WS_END && WS_YE + 64 * MiB <= WS_R2, "ws map");

__device__ __forceinline__ float bf2f(bf16_t v) { return __uint_as_float(((unsigned)v) << 16); }
__device__ __forceinline__ unsigned f2bf(float f) { unsigned u = __float_as_uint(f); return (u + 0x7fffu + ((u >> 16) & 1u)) >> 16; }
__device__ __forceinline__ unsigned pk2(float lo, float hi) { return f2bf(lo) | (f2bf(hi) << 16); }
__device__ __forceinline__ unsigned cvt_pk_bf16(float lo, float hi) { unsigned r; asm volatile("v_cvt_pk_bf16_f32 %0, %1, %2" : "=v"(r) : "v"(lo), "v"(hi)); return r; }
__device__ __forceinline__ float wave_sum(float v) {
#pragma unroll
  for (int o = 1; o < 64; o <<= 1) v += __shfl_xor(v, o);
  return v;
}
#define LDS_WAIT() asm volatile("s_waitcnt lgkmcnt(0)" ::: "memory")
#define VM_WAIT() asm volatile("s_waitcnt vmcnt(0)" ::: "memory")

__device__ __forceinline__ int tidx() { int t = (int)threadIdx.x; asm volatile("" : "+v"(t)); return t; }
namespace pg8 {
constexpr int BM = 256, BK = 64, HALF = 128, HTB = HALF * BK * 2  , STAGE_BYTES = 8 * HTB, NXCD = 8, WGM = 8;

__host__ __device__ __forceinline__ int lds_byte(int r, int c) { const int st = (r >> 4) * 2 + (c >> 5), rr = r & 15, cc = c & 31, ob = rr * 64 + cc * 2; return st * 1024 + (ob ^ (((ob >> 9) & 1) << 5)); }
__host__ __device__ __forceinline__ void stage_rc(int b, int& R, int& C) { const int st = b / 1024, sb = b % 1024, swz = sb ^ (((sb >> 9) & 1) << 5); R = (st >> 1) * 16 + swz / 64; C = (st & 1) * 32 + (swz % 64) / 2; }
__host__ __device__ __forceinline__ int perm32(int rho) { const int n = rho >> 4, i = rho & 15; return 8 * (i >> 2) + 4 * n + (i & 3); }

struct Unit { int pm, pn; const char* pA; const char* pB; int e, mt, valid, pad; };
struct Gemm { const bf16_t* A; const bf16_t* Bt; int lda, ldb, K, pad; };

struct StaticOrder {
    int nM, nN, nwg, G, c; const char* A; const char* Bt; size_t tA, tB;
    __host__ __device__ void init(const Gemm& g, int M, int N, int G_, int c_) { nM = M / BM; nN = N / BM; nwg = nM * nN; G = G_; c = c_; A = (const char*)g.A; Bt = (const char*)g.Bt; tA = (size_t)BM * g.lda * 2; tB = (size_t)BM * g.ldb * 2; }
    __device__ __forceinline__ unsigned rowoff(const Unit&, int) const { return 0u; }
    __host__ __device__ bool next(int i, Unit& u) const {
        const long L = (long)i * G + c; if (L >= nwg) return false;
        int wgid = (int)L; { const int q = nwg / NXCD, r = nwg % NXCD, xcd = wgid % NXCD, off = wgid / NXCD; wgid = (xcd < r ? xcd * (q + 1) : r * (q + 1) + (xcd - r) * q) + off; }
        const int nig = WGM * nN, gid = wgid / nig, fm = gid * WGM, gsz = (nM - fm) < WGM ? (nM - fm) : WGM;
        u.pm = fm + ((wgid % nig) % gsz); u.pn = (wgid % nig) / gsz; u.pA = A + (size_t)u.pm * tA; u.pB = Bt + (size_t)u.pn * tB; u.e = 0; u.mt = 0; u.valid = BM; u.pad = 0; return true;
    }
};

struct EpiBf16 {
    static constexpr bool PERM = true;
    bf16_t* O; int ldc, pad;
    __device__ __forceinline__ void operator()(const f32x4 (&acc)[2][2][4][2], const Unit& u, int wr, int wc, int fr, int fq) const {
        const int row0 = u.pm * BM + wr * 64 + fr; const int col0 = u.pn * BM + wc * 32 + 8 * fq;
#pragma unroll
        for (int ai = 0; ai < 2; ++ai)
#pragma unroll
            for (int m = 0; m < 4; ++m) { bf16_t* rowp = O + (size_t)(row0 + ai * HALF + m * 16) * ldc + col0;
#pragma unroll
                for (int bj = 0; bj < 2; ++bj) { const f32x4 v0 = acc[ai][bj][m][0], v1 = acc[ai][bj][m][1];
                    u32x4 w; w.x = cvt_pk_bf16(v0[0], v0[1]); w.y = cvt_pk_bf16(v0[2], v0[3]); w.z = cvt_pk_bf16(v1[0], v1[1]); w.w = cvt_pk_bf16(v1[2], v1[3]);
                    *(u32x4*)(rowp + bj * HALF) = w; } }
    }
};
struct EpiBf16Norm {
    static constexpr bool PERM = true;
    bf16_t* O; float* parts; int ldc, pad;
    __device__ __forceinline__ void operator()(const f32x4 (&acc)[2][2][4][2], const Unit& u, int wr, int wc, int fr, int fq) const {
        const int row0 = u.pm * BM + wr * 64 + fr; const int col0 = u.pn * BM + wc * 32 + 8 * fq;
        const bool nrm = (u.pn >= 6 && u.pn <= 8);
#pragma unroll
        for (int ai = 0; ai < 2; ++ai)
#pragma unroll
            for (int m = 0; m < 4; ++m) { const int row = row0 + ai * HALF + m * 16; bf16_t* rowp = O + (size_t)row * ldc + col0; float ss = 0.f;
#pragma unroll
                for (int bj = 0; bj < 2; ++bj) { const f32x4 v0 = acc[ai][bj][m][0], v1 = acc[ai][bj][m][1];
                    if (bj == 1 || u.pn != 6) ss += (v0[0] * v0[0] + v0[1] * v0[1]) + (v0[2] * v0[2] + v0[3] * v0[3]) + (v1[0] * v1[0] + v1[1] * v1[1]) + (v1[2] * v1[2] + v1[3] * v1[3]);
                    u32x4 w; w.x = cvt_pk_bf16(v0[0], v0[1]); w.y = cvt_pk_bf16(v0[2], v0[3]); w.z = cvt_pk_bf16(v1[0], v1[1]); w.w = cvt_pk_bf16(v1[2], v1[3]);
                    *(u32x4*)(rowp + bj * HALF) = w; }
                if (nrm) { ss += __shfl_xor(ss, 16); ss += __shfl_xor(ss, 32); if (fq == 0) parts[(size_t)row * 12 + 4 * (u.pn - 6) + wc] = ss; } }
    }
};
struct EpiRms {
    static constexpr bool PERM = true;
    bf16_t* O; const float* parts; int ldc, s0, ns; float inv_k, eps; int pad;
    __device__ __forceinline__ void operator()(const f32x4 (&acc)[2][2][4][2], const Unit& u, int wr, int wc, int fr, int fq) const {
        const int row0 = u.pm * BM + wr * 64 + fr; const int col0 = u.pn * BM + wc * 32 + 8 * fq;
#pragma unroll
        for (int ai = 0; ai < 2; ++ai)
#pragma unroll
            for (int m = 0; m < 4; ++m) { const int row = row0 + ai * HALF + m * 16;
                const f32x4* pp = (const f32x4*)(parts + (size_t)row * 12 + s0); f32x4 a = pp[0]; float ss = (a[0] + a[1]) + (a[2] + a[3]);
                if (ns == 8) { const f32x4 b = pp[1]; ss += (b[0] + b[1]) + (b[2] + b[3]); }
                const float r = rsqrtf(ss * inv_k + eps);
                bf16_t* rowp = O + (size_t)row * ldc + col0;
#pragma unroll
                for (int bj = 0; bj < 2; ++bj) { const f32x4 v0 = acc[ai][bj][m][0] * r, v1 = acc[ai][bj][m][1] * r;
                    u32x4 w; w.x = cvt_pk_bf16(v0[0], v0[1]); w.y = cvt_pk_bf16(v0[2], v0[3]); w.z = cvt_pk_bf16(v1[0], v1[1]); w.w = cvt_pk_bf16(v1[2], v1[3]);
                    *(u32x4*)(rowp + bj * HALF) = w; } }
    }
};
struct EpiResid {
    static constexpr bool PERM = true;
    const float* XF; const bf16_t* XH; bf16_t* Y; int ldc; float alpha;
    __device__ __forceinline__ void operator()(const f32x4 (&acc)[2][2][4][2], const Unit& u, int wr, int wc, int fr, int fq) const {
        const int col0 = u.pn * BM + wc * 32 + 8 * fq;
#pragma unroll
        for (int ai = 0; ai < 2; ++ai)
#pragma unroll
            for (int m = 0; m < 4; ++m) { const size_t off = (size_t)(u.pm * BM + ai * HALF + wr * 64 + m * 16 + fr) * ldc + col0;
#pragma unroll
                for (int bj = 0; bj < 2; ++bj) { f32x4 x0, x1;
                    if (XF) { x0 = *(const f32x4*)(XF + off + bj * HALF); x1 = *(const f32x4*)(XF + off + bj * HALF + 4); }
                    else { const u32x4 h = *(const u32x4*)(XH + off + bj * HALF);
                        x0 = (f32x4){__uint_as_float(h.x << 16), __uint_as_float(h.x & 0xffff0000u), __uint_as_float(h.y << 16), __uint_as_float(h.y & 0xffff0000u)};
                        x1 = (f32x4){__uint_as_float(h.z << 16), __uint_as_float(h.z & 0xffff0000u), __uint_as_float(h.w << 16), __uint_as_float(h.w & 0xffff0000u)}; }
                    const f32x4 v0 = x0 * alpha + acc[ai][bj][m][0], v1 = x1 * alpha + acc[ai][bj][m][1];
                    u32x4 w; w.x = cvt_pk_bf16(v0[0], v0[1]); w.y = cvt_pk_bf16(v0[2], v0[3]); w.z = cvt_pk_bf16(v1[0], v1[1]); w.w = cvt_pk_bf16(v1[2], v1[3]);
                    *(u32x4*)(Y + off + bj * HALF) = w; } }
    }
};

template <class Epi, class Sched, bool ALIGN_EPI, bool GATHER>
__device__ __forceinline__ void gemm_phase(LAS unsigned char* lds, const Gemm g, const Sched& S, const Epi& E) {
    const int tid = tidx(), wid = __builtin_amdgcn_readfirstlane(tid >> 6), lane = tid & 63, wr = wid >> 2, wc = wid & 3, fr = lane & 15, fq = lane >> 4;
    int nt = g.K / BK; asm volatile("" : "+s"(nt));
    unsigned voffA[2], voffB[2]; int RA[2];
#pragma unroll
    for (int i = 0; i < 2; ++i) { int R, C; stage_rc(tid * 16 + i * 8192, R, C); const int Rb = Epi::PERM ? ((R & ~31) + perm32(R & 31)) : R;
        RA[i] = R; voffA[i] = GATHER ? (unsigned)C * 2u : (unsigned)(R * g.lda + C) * 2u; voffB[i] = (unsigned)(Rb * g.ldb + C) * 2u; }
    const size_t kstep = (size_t)(BK * 2);
    const size_t hstepA = GATHER ? (size_t)0 : (size_t)HALF * g.lda * 2, hstepB = (size_t)HALF * g.ldb * 2;
    const unsigned ldsw = (unsigned)wid * 1024u;
    const int aoff = lds_byte(wr * 64 + fr, fq * 8), boff = lds_byte(wc * 32 + fr, fq * 8);
#define PG8_SA(b, h) (((b) * 2 + (h)) * HTB)
#define PG8_SB(b, h) ((4 + (b) * 2 + (h)) * HTB)
#define PG8_STAGE(bufoff, gbase, voff) do { _Pragma("unroll") for (int _i = 0; _i < 2; ++_i) \
        __builtin_amdgcn_global_load_lds((const unsigned*)((const char*)(gbase) + (voff)[_i]), (LAS unsigned*)(lds + (bufoff) + ldsw + _i * 8192), 16, 0, 0); } while (0)
#define PG8_STAGE_A(bufoff, gbase, h, vg) do { _Pragma("unroll") for (int _i = 0; _i < 2; ++_i) \
        __builtin_amdgcn_global_load_lds((const unsigned*)((const char*)(gbase) + (GATHER ? (size_t)0 : (h) * hstepA) + (GATHER ? (vg)[h][_i] : voffA[_i])), (LAS unsigned*)(lds + (bufoff) + ldsw + _i * 8192), 16, 0, 0); } while (0)
#define PG8_GOFF(vg, u) do { if (GATHER) { _Pragma("unroll") for (int _h = 0; _h < 2; ++_h) _Pragma("unroll") for (int _i = 0; _i < 2; ++_i) (vg)[_h][_i] = S.rowoff(u, _h * HALF + RA[_i]) + voffA[_i]; } } while (0)
#define PG8_LDA(dst, b, h) do { _Pragma("unroll") for (int m = 0; m < 4; ++m) _Pragma("unroll") for (int k = 0; k < 2; ++k) dst[m][k] = *(const LAS bf16x8*)(lds + PG8_SA(b, h) + aoff + m * 2048 + k * 1024); } while (0)
#define PG8_LDB(dst, b, h) do { _Pragma("unroll") for (int n = 0; n < 2; ++n) _Pragma("unroll") for (int k = 0; k < 2; ++k) dst[n][k] = *(const LAS bf16x8*)(lds + PG8_SB(b, h) + boff + n * 2048 + k * 1024); } while (0)
#define PG8_MMA(ai, bj, At, Bt) do { __builtin_amdgcn_s_setprio(1); _Pragma("unroll") for (int m = 0; m < 4; ++m) _Pragma("unroll") for (int n = 0; n < 2; ++n) _Pragma("unroll") for (int k = 0; k < 2; ++k) \
        acc[ai][bj][m][n] = __builtin_amdgcn_mfma_f32_16x16x32_bf16(Bt[n][k], At[m][k], acc[ai][bj][m][n], 0, 0, 0); __builtin_amdgcn_s_setprio(0); } while (0)
#define PG8_WAIT_V(n) asm volatile("s_waitcnt vmcnt(" #n ")" ::: "memory")
#define PG8_WAIT_L(n) asm volatile("s_waitcnt lgkmcnt(" #n ")" ::: "memory")
#define PG8_BAR __builtin_amdgcn_s_barrier()
#define PG8_SCHED __builtin_amdgcn_sched_barrier(0)
    Unit cur, nxt; int ui = 0;
    if (!S.next(0, cur)) return;
    f32x4 acc[2][2][4][2];
#pragma unroll
    for (int a = 0; a < 2; ++a)
#pragma unroll
        for (int b = 0; b < 2; ++b)
#pragma unroll
            for (int m = 0; m < 4; ++m)
#pragma unroll
                for (int n = 0; n < 2; ++n) acc[a][b][m][n] = (f32x4){0.f, 0.f, 0.f, 0.f};
    bf16x8 At[4][2], B0[2][2], B1[2][2];
    const char* cA = cur.pA; const char* cB = cur.pB;
    unsigned vgc[2][2] = {{0u, 0u}, {0u, 0u}};
    PG8_GOFF(vgc, cur);
    PG8_STAGE(PG8_SB(0, 0), cB, voffB); PG8_STAGE(PG8_SB(0, 1), cB + hstepB, voffB); PG8_STAGE_A(PG8_SA(0, 0), cA, 0, vgc); PG8_STAGE_A(PG8_SA(0, 1), cA, 1, vgc);
    if (wr == 1) PG8_BAR;
    PG8_WAIT_V(2); PG8_BAR;
    PG8_STAGE(PG8_SB(1, 0), cB + kstep, voffB); PG8_STAGE_A(PG8_SA(1, 0), cA + kstep, 0, vgc); PG8_STAGE(PG8_SB(1, 1), cB + hstepB + kstep, voffB);
    PG8_WAIT_V(6); PG8_BAR;
    for (;;) {
        const bool has_next = S.next(ui + 1, nxt);
        const char* nA = has_next ? nxt.pA : cA; const char* nB = has_next ? nxt.pB : cB;

#pragma unroll 1
        for (int t = 0; t < nt; t += 2) {
            const bool last = (t == nt - 2);
            const char* a1 = cA + (size_t)(t + 1) * kstep;
            const char* a2 = last ? nA : cA + (size_t)(t + 2) * kstep; const char* b2 = last ? nB : cB + (size_t)(t + 2) * kstep;
            const char* a3 = a2 + kstep; const char* b3 = b2 + kstep;
            unsigned vgn[2][2] = {{0u, 0u}, {0u, 0u}};
            if (GATHER) { if (last && has_next) { PG8_GOFF(vgn, nxt); PG8_SCHED; } }
            PG8_LDB(B0, 0, 0); PG8_LDB(B1, 0, 1); PG8_SCHED; PG8_LDA(At, 0, 0); PG8_STAGE_A(PG8_SA(1, 1), a1, 1, vgc);
            if (GATHER) { if (last && has_next) {
#pragma unroll
                for (int _h = 0; _h < 2; ++_h) { vgc[_h][0] = vgn[_h][0]; vgc[_h][1] = vgn[_h][1]; } } }
            PG8_WAIT_V(8); PG8_WAIT_L(0); PG8_BAR; PG8_MMA(0, 0, At, B0); PG8_MMA(0, 1, At, B1); PG8_BAR; PG8_SCHED;
            PG8_LDA(At, 0, 1); PG8_STAGE(PG8_SB(0, 0), b2, voffB); PG8_STAGE(PG8_SB(0, 1), b2 + hstepB, voffB); PG8_STAGE_A(PG8_SA(0, 0), a2, 0, vgc);
            PG8_WAIT_V(8); PG8_WAIT_L(0); PG8_BAR; PG8_MMA(1, 0, At, B0); PG8_MMA(1, 1, At, B1); PG8_BAR; PG8_SCHED;
            PG8_LDB(B0, 1, 0); PG8_LDB(B1, 1, 1); PG8_SCHED; PG8_LDA(At, 1, 0); PG8_STAGE_A(PG8_SA(0, 1), a2, 1, vgc);
            PG8_WAIT_V(8); PG8_WAIT_L(0); PG8_BAR; PG8_MMA(0, 0, At, B0); PG8_MMA(0, 1, At, B1); PG8_BAR; PG8_SCHED;
            PG8_LDA(At, 1, 1); PG8_STAGE(PG8_SB(1, 0), b3, voffB); PG8_STAGE(PG8_SB(1, 1), b3 + hstepB, voffB); PG8_STAGE_A(PG8_SA(1, 0), a3, 0, vgc);
            PG8_WAIT_V(8); PG8_WAIT_L(0); PG8_BAR; PG8_MMA(1, 0, At, B0); PG8_MMA(1, 1, At, B1); PG8_BAR; PG8_SCHED;
        }
        if constexpr (ALIGN_EPI) { if (wr == 0) PG8_BAR; }
        E(acc, cur, wr, wc, fr, fq);
        if (!has_next) break;
#pragma unroll
        for (int a = 0; a < 2; ++a)
#pragma unroll
            for (int b = 0; b < 2; ++b)
#pragma unroll
                for (int m = 0; m < 4; ++m)
#pragma unroll
                    for (int n = 0; n < 2; ++n) acc[a][b][m][n] = (f32x4){0.f, 0.f, 0.f, 0.f};
        cur = nxt; cA = nA; cB = nB; ++ui;

        if constexpr (ALIGN_EPI) { if (wr == 1) PG8_BAR; }
    }
    PG8_WAIT_V(0);
    if constexpr (!ALIGN_EPI) { if (wr == 0) PG8_BAR; }
    PG8_BAR;
#undef PG8_SA
#undef PG8_SB
#undef PG8_STAGE
#undef PG8_STAGE_A
#undef PG8_GOFF
#undef PG8_LDA
#undef PG8_LDB
#undef PG8_MMA
#undef PG8_WAIT_V
#undef PG8_WAIT_L
#undef PG8_BAR
#undef PG8_SCHED
}
}
__device__ __forceinline__ void p0_transpose_item(const float* __restrict__ W, int K, int N, bf16_t* WT, int row_off, LAS float* scr, int kb, int nb, int lane, const float* __restrict__ kscale) {
    const int k0 = 64 * kb, n0 = 32 * nb;
    float wv[32];
#pragma unroll
    for (int i = 0; i < 32; ++i) { const int kk = 2 * i + (lane >> 5); wv[i] = W[(size_t)(k0 + kk) * N + n0 + (lane & 31)]; }
#pragma unroll
    for (int i = 0; i < 32; ++i) { const int kk = 2 * i + (lane >> 5); float w = wv[i]; if (kscale) w *= kscale[k0 + kk]; scr[kk * 33 + (lane & 31)] = w; }
    LDS_WAIT(); asm volatile("" ::: "memory");
    const int c = lane & 7;
#pragma unroll
    for (int j = 0; j < 4; ++j) { const int n = (lane >> 3) + 8 * j; const LAS float* s = scr + (8 * c) * 33 + n;
        u32x4 o; o.x = pk2(s[0 * 33], s[1 * 33]); o.y = pk2(s[2 * 33], s[3 * 33]); o.z = pk2(s[4 * 33], s[5 * 33]); o.w = pk2(s[6 * 33], s[7 * 33]);
        *(u32x4*)(WT + (size_t)(row_off + n0 + n) * K + k0 + 8 * c) = o; }
    LDS_WAIT(); asm volatile("" ::: "memory");
}
__device__ __forceinline__ void p0_convert(const float* W, int K, int N, bf16_t* WT, LAS float* scr, int gw, int NGW, int lane, const float* kscale, int rowmap) {
    const int nblk = N / 32, nitems = (K / 64) * nblk;
    for (int it = gw; it < nitems; it += NGW) { const int kb = it / nblk, nb = it % nblk; int row_off = 0;
        if (rowmap == 1) { const int c0 = nb * 32; const int cc = (c0 < 256) ? c0 : c0 - 256; const int pn = cc >> 7, j = (cc & 127) + ((c0 < 256) ? 0 : 128); row_off = (256 * pn + j) - c0; }
        p0_transpose_item(W, K, N, WT, row_off, scr, kb, nb, lane, kscale); }
}
__device__ __forceinline__ void p0_zero_rows(bf16_t* WT, int K, int r0, int r1, int gtid, int NGT) {
    const size_t n16 = (size_t)(r1 - r0) * K * 2 / 16; u32x4* p = (u32x4*)(WT + (size_t)r0 * K);
    for (size_t i = gtid; i < n16; i += NGT) p[i] = (u32x4){0u, 0u, 0u, 0u};
}
struct P0Args { const float *x, *w_in, *qn_w, *kvn_w, *w_uq, *w_ukv, *w_out; unsigned char* ws; };
__device__ __forceinline__ void p0_experts(const float* wgu_l, const float* wd_l, unsigned char* ws, LAS float* scr, int gw, int NGW, int lane) {
    for (int it = gw; it < NEXP * 384; it += NGW) {
        if (it < NEXP * 256) { const int e = it >> 8, r = it & 255, kb = r >> 4, nb = r & 15; const int c0 = nb * 32; const int cc = (c0 < 256) ? c0 : c0 - 256; const int row_off = (256 * (cc >> 7) + (cc & 127) + ((c0 < 256) ? 0 : 128)) - c0;
            p0_transpose_item(wgu_l + (size_t)e * DM * 512, DM, 512, (bf16_t*)(ws + WS_WGU) + (size_t)e * 512 * DM, row_off, scr, kb, nb, lane, nullptr); }
        else { const int i2 = it - NEXP * 256; const int e = i2 >> 7, r = i2 & 127, kb = r >> 5, nb = r & 31;
            p0_transpose_item(wd_l + (size_t)e * DEXP * DM, DEXP, DM, (bf16_t*)(ws + WS_WD) + (size_t)e * DM * DEXP, 0, scr, kb, nb, lane, nullptr); }
    }
}
__device__ __forceinline__ void p0_all(const P0Args& a, LAS unsigned char* lds, int vcu, int G) {
    const int tid = tidx(), lane = tid & 63, wave = tid >> 6;
    LAS float* scr = (LAS float*)(lds + wave * 16384);
    const int gw = vcu * 8 + wave, NGW = G * 8, gtid = vcu * 512 + tid, NGT = G * 512;
    for (int l = 0; l < DEPTH; ++l) {
        bf16_t* win_t = (bf16_t*)(a.ws + WS_WIN) + (size_t)l * NPP * DM;
        p0_convert(a.w_in + (size_t)l * DM * NP, DM, NP, win_t, scr, gw, NGW, lane, nullptr, 0);
        p0_zero_rows(win_t, DM, NP, NPP, gtid, NGT);
        bf16_t* wuq_t = (bf16_t*)(a.ws + WS_WUQ) + (size_t)l * NQMP * 384;
        p0_convert(a.w_uq + (size_t)l * 384 * NQM, 384, NQM, wuq_t, scr, gw, NGW, lane, a.qn_w + l * 384, 0);
        p0_zero_rows(wuq_t, 384, NQM, NQMP, gtid, NGT);
        p0_convert(a.w_ukv + (size_t)l * 256 * NKVM, 256, NKVM, (bf16_t*)(a.ws + WS_WUKV) + (size_t)l * NKVM * 256, scr, gw, NGW, lane, a.kvn_w + l * 256, 0);
        p0_convert(a.w_out + (size_t)l * DM * DM, DM, DM, (bf16_t*)(a.ws + WS_WOUT) + (size_t)l * DM * DM, scr, gw, NGW, lane, nullptr, 0);
    }
    { const f32x4* xs = (const f32x4*)a.x; u32x2* xb = (u32x2*)(a.ws + WS_R0); const size_t n4 = (size_t)TOK * DM / 4;
      for (size_t i = gtid; i < n4; i += NGT) { const f32x4 v = xs[i]; u32x2 o; o.x = pk2(v[0], v[1]); o.y = pk2(v[2], v[3]); xb[i] = o; } }
    { float2* tr = (float2*)(a.ws + WS_TABR); float2* tm = (float2*)(a.ws + WS_TABM);
      for (int idx = gtid; idx < SEQ * 32; idx += NGT) { const int pos = idx >> 5, i = idx & 31;
          const float invf = (float)exp(-log(10000.0) * (double)(2 * i) / 64.0); const double ang = (double)((float)pos * invf);
          tr[idx] = make_float2((float)cos(ang), (float)sin(ang)); }
      for (int idx = gtid; idx < SEQ * 16; idx += NGT) { const int pos = idx >> 4, i = idx & 15;
          const float invf = (float)exp(-log(10000.0) * (double)(2 * i) / 32.0); const double ang = (double)((float)pos * invf);
          tm[idx] = make_float2((float)cos(ang), (float)sin(ang)); } }
}
namespace att {
__device__ __forceinline__ int crow(int r, int hi) { return (r & 3) + 8 * (r >> 2) + 4 * hi; }
#define ATT_SBAR() __builtin_amdgcn_sched_barrier(0)
#define ATT_WAIT_BAR0() asm volatile("s_waitcnt vmcnt(0) lgkmcnt(0)\n\ts_barrier" ::: "memory")
constexpr int KSLOT = 12288, VSLOT = 8192;
constexpr int NSLOT = 3;
constexpr int LDS_K = 0, LDS_V = NSLOT * KSLOT, LDS_WS = LDS_V + NSLOT * VSLOT, LDS_OST = LDS_WS + 8 * 256, LDS_BYTES = LDS_OST + 8 * 4096;
__device__ __forceinline__ void glds16(const void* gsrc, unsigned lds_dst) { unsigned keep;
  asm volatile("s_mov_b32 %0, m0\n\ts_mov_b32 m0, %2\n\ts_nop 0\n\tglobal_load_lds_dwordx4 %1, off\n\ts_mov_b32 m0, %0" : "=&s"(keep) : "v"(gsrc), "s"(lds_dst) : "memory"); }
__device__ __forceinline__ float max3f(float a, float b, float c) { float r; asm("v_max3_f32 %0, %1, %2, %3" : "=v"(r) : "v"(a), "v"(b), "v"(c)); return r; }
__device__ __forceinline__ float rowmax(const f32x16& p0, const f32x16& p1) {
  float a = max3f(p0[0], p0[1], p1[0]), b = max3f(p0[2], p0[3], p1[1]); a = max3f(a, p1[2], p1[3]);
#pragma unroll
  for (int r = 4; r < 16; r += 4) { a = max3f(a, p0[r], p0[r + 1]); b = max3f(b, p0[r + 2], p0[r + 3]); a = max3f(a, p1[r], p1[r + 1]); b = max3f(b, p1[r + 2], p1[r + 3]); }
  const float m = fmaxf(a, b);
  auto rr = __builtin_amdgcn_permlane32_swap(__float_as_uint(m), __float_as_uint(m), false, false);
  return fmaxf(__uint_as_float(rr[0]), __uint_as_float(rr[1]));
}
template <int NCH>
__device__ __forceinline__ void qkt(f32x16& p0, f32x16& p1, const LAS char* Kslot, const bf16x8* qr, int r32, int hi) {
  const LAS char* kb = Kslot + hi * 1024 + r32 * 16;
#pragma unroll
  for (int d0 = 0; d0 < NCH; ++d0) {
    const bf16x8 b0 = *(const LAS bf16x8*)(kb + d0 * 2048);
    const bf16x8 b1 = *(const LAS bf16x8*)(kb + d0 * 2048 + 512);
    p0 = __builtin_amdgcn_mfma_f32_32x32x16_bf16(b0, qr[d0], p0, 0, 0, 0);
    p1 = __builtin_amdgcn_mfma_f32_32x32x16_bf16(b1, qr[d0], p1, 0, 0, 0);
  }
}
typedef short s16x4 __attribute__((ext_vector_type(4)));
__device__ __forceinline__ void pv(f32x16* o, int vb, bf16x8 pa0, bf16x8 pa1, bf16x8 pa2, bf16x8 pa3) {
#pragma unroll
  for (int d0 = 0; d0 < 2; ++d0) { s16x4 lo[4], hi[4];
#pragma unroll
    for (int ks = 0; ks < 4; ++ks) {
      asm volatile("ds_read_b64_tr_b16 %0,%1 offset:%c2" : "=&v"(lo[ks]) : "v"(vb), "i"(d0 * 4096 + ks * 1024) : "memory");
      asm volatile("ds_read_b64_tr_b16 %0,%1 offset:%c2" : "=&v"(hi[ks]) : "v"(vb), "i"(d0 * 4096 + ks * 1024 + 512) : "memory"); }
    asm volatile("s_waitcnt lgkmcnt(0)" ::: "memory"); ATT_SBAR();
#define ATT_PK(k) (bf16x8){lo[k][0], lo[k][1], lo[k][2], lo[k][3], hi[k][0], hi[k][1], hi[k][2], hi[k][3]}
    o[d0] = __builtin_amdgcn_mfma_f32_32x32x16_bf16(pa0, ATT_PK(0), o[d0], 0, 0, 0);
    o[d0] = __builtin_amdgcn_mfma_f32_32x32x16_bf16(pa1, ATT_PK(1), o[d0], 0, 0, 0);
    o[d0] = __builtin_amdgcn_mfma_f32_32x32x16_bf16(pa2, ATT_PK(2), o[d0], 0, 0, 0);
    o[d0] = __builtin_amdgcn_mfma_f32_32x32x16_bf16(pa3, ATT_PK(3), o[d0], 0, 0, 0);
#undef ATT_PK
  }
}
struct AttnPtrs { const bf16_t* proj; const bf16_t* qm; const bf16_t* kvm; const bf16_t* kpe; const float2* tabm; const float* sinks; bf16_t* concat; };

typedef short v4i16_t __attribute__((ext_vector_type(4)));
__device__ __forceinline__ s16x4 vtr(const LAS char* p) { return __builtin_bit_cast(s16x4, __builtin_amdgcn_ds_read_tr16_b64_v4i16((LAS v4i16_t*)p)); }
template <int NCH>
__device__ __forceinline__ void qkt_c(f32x16& p0, f32x16& p1, const LAS char* Kslot, const bf16x8* qr, const f32x16& c, int r32, int hi) {
  const LAS char* kb = Kslot + hi * 1024 + r32 * 16;
#pragma unroll
  for (int d0 = 0; d0 < NCH; ++d0) {
    const bf16x8 b0 = *(const LAS bf16x8*)(kb + d0 * 2048);
    const bf16x8 b1 = *(const LAS bf16x8*)(kb + d0 * 2048 + 512);
    if (d0 == 0) { p0 = __builtin_amdgcn_mfma_f32_32x32x16_bf16(b0, qr[0], c, 0, 0, 0); p1 = __builtin_amdgcn_mfma_f32_32x32x16_bf16(b1, qr[0], c, 0, 0, 0); }
    else { p0 = __builtin_amdgcn_mfma_f32_32x32x16_bf16(b0, qr[d0], p0, 0, 0, 0); p1 = __builtin_amdgcn_mfma_f32_32x32x16_bf16(b1, qr[d0], p1, 0, 0, 0); }
  }
}
template <int MODE, bool QKF>
__device__ __forceinline__ void att_step(f32x16& pc0, f32x16& pc1, f32x16& pn0, f32x16& pn1, f32x16 (&o)[2], f32x16& negm, float& mhat, float& l_run, const bf16x8 (&qr)[(MODE == 0) ? 6 : 4],
                                         LAS char* shm, LAS float* wsf, const LAS char* vp0, int t, int t_lo, bool has_next, int s, int s1, int qpos, int qw0, int r32, int hi) {
    constexpr int NCH = (MODE == 0) ? 6 : 4; constexpr float THR = 8.0f;
    if (QKF) { if (has_next) qkt_c<NCH>(pn0, pn1, shm + LDS_K + s1 * KSLOT, qr, negm, r32, hi); }
    const int k0 = t * 64;
    bool active, need_mask;
    if (MODE == 0) { active = true; need_mask = (k0 + 63 > qw0); }
    else { active = (k0 <= qw0 + 31) && (k0 + 63 >= qw0 - 127); need_mask = (k0 + 63 > qw0) || (k0 < qw0 + 31 - 127); }
    if (active) {
      if (need_mask) {
#pragma unroll
        for (int r = 0; r < 16; ++r) { const int kv = k0 + crow(r, hi);
          bool bad0 = kv > qpos, bad1 = kv + 32 > qpos;
          if (MODE == 1) { bad0 = bad0 || (kv < qpos - 127); bad1 = bad1 || (kv + 32 < qpos - 127); }
          if (bad0) pc0[r] = -1e30f; if (bad1) pc1[r] = -1e30f; }
      }
      const float rm = rowmax(pc0, pc1);
      const bool first = (MODE == 0) && (t == t_lo);
      if (first || __any(rm > THR)) {
        const float dl = first ? rm : fmaxf(rm, 0.f);
        mhat += dl;
#pragma unroll
        for (int r = 0; r < 16; ++r) { pc0[r] -= dl; pc1[r] -= dl; }
        if (QKF && has_next) {
#pragma unroll
          for (int r = 0; r < 16; ++r) { pn0[r] -= dl; pn1[r] -= dl; } }
#pragma unroll
        for (int r = 0; r < 16; ++r) negm[r] = -mhat;
        const float f = __builtin_amdgcn_exp2f(-dl);
        l_run *= f;
        if (hi == 0) wsf[r32] = f;
#pragma unroll
        for (int r = 0; r < 16; ++r) { const float g = wsf[crow(r, hi)]; o[0][r] *= g; o[1][r] *= g; }
      }
      float psum = 0.f;
#pragma unroll
      for (int r = 0; r < 16; ++r) { pc0[r] = __builtin_amdgcn_exp2f(pc0[r]); pc1[r] = __builtin_amdgcn_exp2f(pc1[r]); psum += pc0[r] + pc1[r]; }
      l_run += psum;
      u32x4 pw0, pw1, pw2, pw3;
      pw0 = (u32x4){cvt_pk_bf16(pc0[0], pc0[1]), cvt_pk_bf16(pc0[2], pc0[3]), cvt_pk_bf16(pc0[4], pc0[5]), cvt_pk_bf16(pc0[6], pc0[7])};
      pw1 = (u32x4){cvt_pk_bf16(pc0[8], pc0[9]), cvt_pk_bf16(pc0[10], pc0[11]), cvt_pk_bf16(pc0[12], pc0[13]), cvt_pk_bf16(pc0[14], pc0[15])};
      pw2 = (u32x4){cvt_pk_bf16(pc1[0], pc1[1]), cvt_pk_bf16(pc1[2], pc1[3]), cvt_pk_bf16(pc1[4], pc1[5]), cvt_pk_bf16(pc1[6], pc1[7])};
      pw3 = (u32x4){cvt_pk_bf16(pc1[8], pc1[9]), cvt_pk_bf16(pc1[10], pc1[11]), cvt_pk_bf16(pc1[12], pc1[13]), cvt_pk_bf16(pc1[14], pc1[15])};
      const bf16x8 pa[4] = {__builtin_bit_cast(bf16x8, pw0), __builtin_bit_cast(bf16x8, pw1), __builtin_bit_cast(bf16x8, pw2), __builtin_bit_cast(bf16x8, pw3)};
      const LAS char* vp = vp0 + s * VSLOT;
#pragma unroll
      for (int d0 = 0; d0 < 2; ++d0)
#pragma unroll
        for (int ks = 0; ks < 4; ++ks) { const s16x4 lo = vtr(vp + d0 * 4096 + ks * 1024), hi4 = vtr(vp + d0 * 4096 + ks * 1024 + 512);
          const bf16x8 vf = (bf16x8){lo[0], lo[1], lo[2], lo[3], hi4[0], hi4[1], hi4[2], hi4[3]};
          o[d0] = __builtin_amdgcn_mfma_f32_32x32x16_bf16(pa[ks], vf, o[d0], 0, 0, 0); }
    }
    if (!QKF) { if (has_next) qkt_c<NCH>(pn0, pn1, shm + LDS_K + s1 * KSLOT, qr, negm, r32, hi); }
}
template <int MODE>
__device__ __forceinline__ void attn_unit(const AttnPtrs& P, int b, int h, int qb, LAS char* shm) {
  constexpr int NCH = (MODE == 0) ? 6 : 4;
  constexpr float THR = 8.0f;
  const int tid = tidx(), lane = tid & 63, r32 = lane & 31, hi = lane >> 5; const int wid = __builtin_amdgcn_readfirstlane(tid >> 6);
  const long rowbase = (long)b * SEQ; const int q0 = qb * 256;
  const unsigned lds0 = (unsigned)(uintptr_t)shm;
  LAS float* wsf = (LAS float*)(shm + LDS_WS) + wid * 64;
  const bf16_t *Qp, *Kp, *Vp; int ldq, ldk; bf16_t* Op;
  if (MODE == 0) { Qp = P.qm + h * 96; ldq = NQMP; Kp = P.kvm + h * 128; Vp = P.kvm + h * 128 + 64; ldk = NKVM; Op = P.concat + 640 + h * 64; }
  else { Qp = P.proj + O_SQ + h * 64; ldq = NPP; Kp = P.proj + O_SK + (h / 3) * 64; Vp = P.proj + O_SV + (h / 3) * 64; ldk = NPP; Op = P.concat + 256 + h * 64; }
  const bf16_t* ksrc = Kp + (rowbase + lane) * ldk + wid * 8;
  const bf16_t* krsrc = P.kpe + (rowbase + lane) * 32 + (wid & 3) * 8;
  const bf16_t* vsrc = Vp + (rowbase + 16 * (wid & 3) + (lane >> 2)) * ldk + (wid >> 2) * 32 + (lane & 3) * 8;
  const unsigned kdst = lds0 + LDS_K + wid * 1024, krdst = lds0 + LDS_K + (8 + (wid & 3)) * 1024, vdst = lds0 + LDS_V + wid * 1024;
#define ATT_DMA_K(t, s) do { glds16(ksrc + (long)(t) * 64 * ldk, (unsigned)__builtin_amdgcn_readfirstlane(kdst + (s) * KSLOT)); \
    if (MODE == 0 && wid < 4) glds16(krsrc + (long)(t) * 64 * 32, (unsigned)__builtin_amdgcn_readfirstlane(krdst + (s) * KSLOT)); } while (0)
#define ATT_DMA_V(t, s) glds16(vsrc + (long)(t) * 64 * ldk, (unsigned)__builtin_amdgcn_readfirstlane(vdst + (s) * VSLOT))
  const LAS char* vp0 = shm + LDS_V + ((lane >> 4) & 1) * 32 + (lane & 3) * 8 + (4 * hi + ((lane & 15) >> 2)) * 64;
  int t_lo, t_hi;
  if (MODE == 0) { t_lo = 0; t_hi = (q0 + 256) / 64; } else { t_lo = q0 / 64 - 2; if (t_lo < 0) t_lo = 0; t_hi = q0 / 64 + 4; }
  ATT_DMA_K(t_lo, 0); ATT_DMA_V(t_lo, 0); ATT_DMA_K(t_lo + 1, 1); ATT_DMA_V(t_lo + 1, 1); ATT_DMA_K(t_lo + 2, 2);
  const int qpos = q0 + wid * 32 + r32;
  bf16x8 qr[NCH];
  { const float c2 = (MODE == 0 ? 0.10206207261596575f : 0.125f) * LOG2E;
    const bf16_t* qrow = Qp + (rowbase + qpos) * ldq + hi * 8;
    float qf[NCH][8];
#pragma unroll
    for (int d0 = 0; d0 < NCH; ++d0) { const bf16x8 v = *reinterpret_cast<const bf16x8*>(qrow + d0 * 16);
#pragma unroll
      for (int j = 0; j < 8; ++j) qf[d0][j] = bf2f((bf16_t)v[j]); }
    if (MODE == 0) {
      const float2* tb = P.tabm + qpos * 16 + hi * 8;
#pragma unroll
      for (int j = 0; j < 8; ++j) { const float2 cs = tb[j]; const float x1 = qf[NCH - 2][j], x2 = qf[NCH - 1][j]; qf[NCH - 2][j] = x1 * cs.x - x2 * cs.y; qf[NCH - 1][j] = x1 * cs.y + x2 * cs.x; }
    }
#pragma unroll
    for (int d0 = 0; d0 < NCH; ++d0) { u32x4 w; w.x = cvt_pk_bf16(qf[d0][0] * c2, qf[d0][1] * c2); w.y = cvt_pk_bf16(qf[d0][2] * c2, qf[d0][3] * c2); w.z = cvt_pk_bf16(qf[d0][4] * c2, qf[d0][5] * c2); w.w = cvt_pk_bf16(qf[d0][6] * c2, qf[d0][7] * c2);
      qr[d0] = __builtin_bit_cast(bf16x8, w); }
  }
  float mhat, l_run;
  if (MODE == 0) { mhat = 0.f; l_run = 0.f; } else { mhat = P.sinks[h] * LOG2E; l_run = (hi == 0) ? 1.f : 0.f; }
  f32x16 negm;
#pragma unroll
  for (int r = 0; r < 16; ++r) negm[r] = -mhat;
  f32x16 o[2]; o[0] = f32x16{}; o[1] = f32x16{};
  const int qw0 = q0 + wid * 32;
  ATT_WAIT_BAR0();
  f32x16 pc0, pc1, pn0, pn1;
  qkt_c<NCH>(pc0, pc1, shm + LDS_K, qr, negm, r32, hi);
  asm volatile("s_waitcnt lgkmcnt(0)\n\ts_barrier" ::: "memory");
  if (wid < 4) {
  int s = 0;
  for (int t = t_lo; t < t_hi; ++t) {
    const int s1 = (s == 2) ? 0 : s + 1, s2 = (s == 0) ? 2 : s - 1;
    const bool has_next = (t + 1 < t_hi);
    if (t + 3 < t_hi) ATT_DMA_K(t + 3, s);
    if (t + 2 < t_hi) ATT_DMA_V(t + 2, s2);
    att_step<MODE, true>(pc0, pc1, pn0, pn1, o, negm, mhat, l_run, qr, shm, wsf, vp0, t, t_lo, has_next, s, s1, qpos, qw0, r32, hi);
    if (t + 3 < t_hi) { if (MODE == 0 && wid < 4) asm volatile("s_waitcnt vmcnt(3) lgkmcnt(0)\n\ts_barrier" ::: "memory"); else asm volatile("s_waitcnt vmcnt(2) lgkmcnt(0)\n\ts_barrier" ::: "memory"); }
    else ATT_WAIT_BAR0();
    pc0 = pn0; pc1 = pn1; s = s1;
  }
  } else {
  int s = 0;
  for (int t = t_lo; t < t_hi; ++t) {
    const int s1 = (s == 2) ? 0 : s + 1, s2 = (s == 0) ? 2 : s - 1;
    const bool has_next = (t + 1 < t_hi);
    if (t + 3 < t_hi) ATT_DMA_K(t + 3, s);
    if (t + 2 < t_hi) ATT_DMA_V(t + 2, s2);
    att_step<MODE, false>(pc0, pc1, pn0, pn1, o, negm, mhat, l_run, qr, shm, wsf, vp0, t, t_lo, has_next, s, s1, qpos, qw0, r32, hi);
    if (t + 3 < t_hi) { if (MODE == 0 && wid < 4) asm volatile("s_waitcnt vmcnt(3) lgkmcnt(0)\n\ts_barrier" ::: "memory"); else asm volatile("s_waitcnt vmcnt(2) lgkmcnt(0)\n\ts_barrier" ::: "memory"); }
    else ATT_WAIT_BAR0();
    pc0 = pn0; pc1 = pn1; s = s1;
  }
  }
  { auto rr = __builtin_amdgcn_permlane32_swap(__float_as_uint(l_run), __float_as_uint(l_run), false, false); l_run = __uint_as_float(rr[0]) + __uint_as_float(rr[1]); }
  if (hi == 0) wsf[32 + r32] = l_run;
  float rli[16];
#pragma unroll
  for (int r = 0; r < 16; ++r) rli[r] = 1.0f / wsf[32 + crow(r, hi)];
  bf16_t* Ow = Op + (rowbase + q0 + wid * 32) * DM;
  { LAS bf16_t* stg = (LAS bf16_t*)(shm + LDS_OST) + wid * 2048;
#pragma unroll
    for (int r = 0; r < 16; ++r) { const int orow = crow(r, hi);
#pragma unroll
      for (int d0 = 0; d0 < 2; ++d0) stg[orow * 64 + d0 * 32 + r32] = (bf16_t)f2bf(o[d0][r] * rli[r]); }
#pragma unroll
    for (int i = 0; i < 4; ++i) { const int row = i * 8 + (lane >> 3), ch = lane & 7; const u32x4 v = *(const LAS u32x4*)(stg + row * 64 + ch * 8); *(u32x4*)(Ow + (long)row * DM + ch * 8) = v; } }
  asm volatile("s_waitcnt lgkmcnt(0)\n\ts_barrier" ::: "memory");
#undef ATT_DMA_K
#undef ATT_DMA_V
}
}
namespace ret {
using att::crow; using att::glds16; using att::qkt; using att::pv; using att::s16x4;
struct RetPtrs { const bf16_t* proj; const float2* tabr; const float* gn_w; float* U; bf16_t* concat; };
constexpr int R_V = 0, R_K = 32768, R_ST = 65536, R_STG = 0;
constexpr int ST_PITCH = 72;
__device__ __forceinline__ float gamma_log2(int h) { return log2f(1.0f - exp2f(-5.0f - (float)h)); }

__device__ __forceinline__ void dma_v4(const RetPtrs& P, int b, int h, int cp, unsigned lds0, int wid, int lane) {
  const bf16_t* vsrc = P.proj + ((long)b * SEQ + 256 * cp + 16 * (wid & 3) + (lane >> 2)) * NPP + O_RV + h * 64 + (wid >> 2) * 32 + (lane & 3) * 8;
#pragma unroll
  for (int tt = 0; tt < 4; ++tt) glds16(vsrc + (long)tt * 64 * NPP, (unsigned)__builtin_amdgcn_readfirstlane(lds0 + R_V + tt * 8192 + wid * 1024));
}
__device__ __forceinline__ bf16x8 tr_frag(int vb, int off) { s16x4 lo, hi;
  asm volatile("ds_read_b64_tr_b16 %0,%1" : "=&v"(lo) : "v"(vb + off) : "memory");
  asm volatile("ds_read_b64_tr_b16 %0,%1" : "=&v"(hi) : "v"(vb + off + 512) : "memory");
  asm volatile("s_waitcnt lgkmcnt(0)" : "+v"(lo), "+v"(hi) :: "memory");
  return (bf16x8){lo[0], lo[1], lo[2], lo[3], hi[0], hi[1], hi[2], hi[3]}; }

__device__ __forceinline__ void upd_unit(const RetPtrs& P, int b, int h, int cp, LAS char* shm) {
  const int tid = tidx(), lane = tid & 63, hi = lane >> 5; const int wid = __builtin_amdgcn_readfirstlane(tid >> 6);
  const unsigned lds0 = (unsigned)(uintptr_t)shm;
  const float lg = gamma_log2(h);
  dma_v4(P, b, h, cp, lds0, wid, lane);
#pragma unroll
  for (int it = 0; it < 2; ++it) { const int item = tid + 512 * it, row = item >> 2, c = item & 3; const int pos = 256 * cp + row;
    const bf16_t* src = P.proj + ((long)b * SEQ + pos) * NPP + O_RK + h * 64 + 8 * c;
    const bf16x8 lo = *(const bf16x8*)src, hi8 = *(const bf16x8*)(src + 32);
    const float2* tb = P.tabr + pos * 32 + 8 * c;
    const float sc = 0.125f * exp2f(lg * (float)(127 - (row & 127)));
    float y1[8], y2[8];
#pragma unroll
    for (int j = 0; j < 8; ++j) { const float2 cs = tb[j]; const float x1 = bf2f((bf16_t)lo[j]), x2 = bf2f((bf16_t)hi8[j]); y1[j] = (x1 * cs.x - x2 * cs.y) * sc; y2[j] = (x1 * cs.y + x2 * cs.x) * sc; }
    u32x4 w1, w2; w1.x = cvt_pk_bf16(y1[0], y1[1]); w1.y = cvt_pk_bf16(y1[2], y1[3]); w1.z = cvt_pk_bf16(y1[4], y1[5]); w1.w = cvt_pk_bf16(y1[6], y1[7]);
    w2.x = cvt_pk_bf16(y2[0], y2[1]); w2.y = cvt_pk_bf16(y2[2], y2[3]); w2.z = cvt_pk_bf16(y2[4], y2[5]); w2.w = cvt_pk_bf16(y2[6], y2[7]);
    LAS char* dst = shm + R_K + (row >> 6) * 8192 + (row & 63) * 64 + c * 16;
    *(LAS u32x4*)dst = w1; *(LAS u32x4*)(dst + 4096) = w2; }
  asm volatile("s_waitcnt vmcnt(0) lgkmcnt(0)\n\ts_barrier" ::: "memory");
  const int wg = wid >> 2, dt = (wid >> 1) & 1, et = wid & 1;
  const int vbl = ((lane >> 4) & 1) * 32 + (lane & 3) * 8 + (4 * hi + ((lane & 15) >> 2)) * 64;
  f32x16 acc = f32x16{};
#pragma unroll
  for (int tt = 0; tt < 2; ++tt) { const int tile = 2 * wg + tt;
#pragma unroll
    for (int ks = 0; ks < 4; ++ks) { const bf16x8 a = tr_frag((int)lds0 + R_K + tile * 8192 + vbl, dt * 4096 + ks * 1024), bb = tr_frag((int)lds0 + R_V + tile * 8192 + vbl, et * 4096 + ks * 1024);
      acc = __builtin_amdgcn_mfma_f32_32x32x16_bf16(a, bb, acc, 0, 0, 0); } }
  float* Uo = P.U + ((size_t)((b * 4 + h) * 64 + 2 * cp + wg)) * 4096 + (32 * dt) * 64 + 32 * et + (lane & 31);
#pragma unroll
  for (int r = 0; r < 16; ++r) Uo[crow(r, hi) * 64] = acc[r];
  asm volatile("s_waitcnt lgkmcnt(0)\n\ts_barrier" ::: "memory");
}

__device__ __forceinline__ void out_unit(const RetPtrs& P, int b, int h, int cp, LAS char* shm) {
  const int tid = tidx(), lane = tid & 63, r32 = lane & 31, hi = lane >> 5; const int wid = __builtin_amdgcn_readfirstlane(tid >> 6);
  const unsigned lds0 = (unsigned)(uintptr_t)shm;
  const float lg = gamma_log2(h);
  const long rowbase = (long)b * SEQ;
  dma_v4(P, b, h, cp, lds0, wid, lane);
#pragma unroll
  for (int it = 0; it < 2; ++it) { const int item = tid + 512 * it, row = item >> 2, c = item & 3; const int pos = 256 * cp + row;
    const bf16_t* src = P.proj + (rowbase + pos) * NPP + O_RK + h * 64 + 8 * c;
    const bf16x8 lo = *(const bf16x8*)src, hi8 = *(const bf16x8*)(src + 32);
    const float2* tb = P.tabr + pos * 32 + 8 * c;
    float y1[8], y2[8];
#pragma unroll
    for (int j = 0; j < 8; ++j) { const float2 cs = tb[j]; const float x1 = bf2f((bf16_t)lo[j]), x2 = bf2f((bf16_t)hi8[j]); y1[j] = (x1 * cs.x - x2 * cs.y) * 0.125f; y2[j] = (x1 * cs.y + x2 * cs.x) * 0.125f; }
    u32x4 w1, w2; w1.x = cvt_pk_bf16(y1[0], y1[1]); w1.y = cvt_pk_bf16(y1[2], y1[3]); w1.z = cvt_pk_bf16(y1[4], y1[5]); w1.w = cvt_pk_bf16(y1[6], y1[7]);
    w2.x = cvt_pk_bf16(y2[0], y2[1]); w2.y = cvt_pk_bf16(y2[2], y2[3]); w2.z = cvt_pk_bf16(y2[4], y2[5]); w2.w = cvt_pk_bf16(y2[6], y2[7]);
    LAS char* dst = shm + R_K + (row >> 6) * 8192 + c * 1024 + (row & 63) * 16;
    *(LAS u32x4*)dst = w1; *(LAS u32x4*)(dst + 4096) = w2; }
  { const int n0 = 2 * cp; const float cd = exp2f(lg * 128.0f);
    const float* Ub = P.U + (size_t)((b * 4 + h) * 64) * 4096 + tid * 8;
    f32x4 s0a = (f32x4){0.f, 0.f, 0.f, 0.f}, s0b = s0a;
    for (int m = 0; m < n0; ++m) { const f32x4 ua = *(const f32x4*)(Ub + (size_t)m * 4096), ub = *(const f32x4*)(Ub + (size_t)m * 4096 + 4); s0a = s0a * cd + ua; s0b = s0b * cd + ub; }
    const f32x4 ua = *(const f32x4*)(Ub + (size_t)n0 * 4096), ub = *(const f32x4*)(Ub + (size_t)n0 * 4096 + 4);
    const f32x4 s1a = s0a * cd + ua, s1b = s0b * cd + ub;
    const int d = tid >> 3, e0 = (tid & 7) * 8;
    LAS bf16_t* st0 = (LAS bf16_t*)(shm + R_ST), * st1 = st0 + 64 * ST_PITCH;
#pragma unroll
    for (int j = 0; j < 4; ++j) { st0[(e0 + j) * ST_PITCH + d] = (bf16_t)f2bf(s0a[j]); st0[(e0 + 4 + j) * ST_PITCH + d] = (bf16_t)f2bf(s0b[j]);
      st1[(e0 + j) * ST_PITCH + d] = (bf16_t)f2bf(s1a[j]); st1[(e0 + 4 + j) * ST_PITCH + d] = (bf16_t)f2bf(s1b[j]); } }
  const int wg = wid >> 2; const int qi = (wid & 3) * 32 + r32;
  const int qpos = 256 * cp + 128 * wg + qi;
  bf16x8 qr[4], qx[4];
  { const bf16_t* qrow = P.proj + (rowbase + qpos) * NPP + O_RQ + h * 64 + hi * 8;
    float qf[4][8];
#pragma unroll
    for (int d0 = 0; d0 < 4; ++d0) { const bf16x8 v = *(const bf16x8*)(qrow + d0 * 16);
#pragma unroll
      for (int j = 0; j < 8; ++j) qf[d0][j] = bf2f((bf16_t)v[j]); }
#pragma unroll
    for (int d0 = 0; d0 < 2; ++d0) { const float2* tb = P.tabr + qpos * 32 + 16 * d0 + 8 * hi;
#pragma unroll
      for (int j = 0; j < 8; ++j) { const float2 cs = tb[j]; const float x1 = qf[d0][j], x2 = qf[d0 + 2][j]; qf[d0][j] = x1 * cs.x - x2 * cs.y; qf[d0 + 2][j] = x1 * cs.y + x2 * cs.x; } }
    const float xi = exp2f(lg * (float)(qi + 1));
#pragma unroll
    for (int d0 = 0; d0 < 4; ++d0) { u32x4 w, x;
      w.x = cvt_pk_bf16(qf[d0][0], qf[d0][1]); w.y = cvt_pk_bf16(qf[d0][2], qf[d0][3]); w.z = cvt_pk_bf16(qf[d0][4], qf[d0][5]); w.w = cvt_pk_bf16(qf[d0][6], qf[d0][7]);
      x.x = cvt_pk_bf16(qf[d0][0] * xi, qf[d0][1] * xi); x.y = cvt_pk_bf16(qf[d0][2] * xi, qf[d0][3] * xi); x.z = cvt_pk_bf16(qf[d0][4] * xi, qf[d0][5] * xi); x.w = cvt_pk_bf16(qf[d0][6] * xi, qf[d0][7] * xi);
      qr[d0] = __builtin_bit_cast(bf16x8, w); qx[d0] = __builtin_bit_cast(bf16x8, x); } }
  asm volatile("s_waitcnt vmcnt(0) lgkmcnt(0)\n\ts_barrier" ::: "memory");
  f32x16 o[2]; o[0] = f32x16{}; o[1] = f32x16{};
  const int vb0 = (int)(lds0 + R_V) + ((lane >> 4) & 1) * 32 + (lane & 3) * 8 + (4 * hi + ((lane & 15) >> 2)) * 64;
#pragma unroll
  for (int tt = 0; tt < 2; ++tt) {
    if (tt * 64 <= (wid & 3) * 32 + 31) {
      const int tile = 2 * wg + tt;
      f32x16 p0 = f32x16{}, p1 = f32x16{};
      qkt<4>(p0, p1, shm + R_K + tile * 8192, qr, r32, hi);
#pragma unroll
      for (int r = 0; r < 16; ++r) { const int ki = tt * 64 + crow(r, hi);
        const float d0 = (qi >= ki) ? exp2f(lg * (float)(qi - ki)) : 0.f, d1 = (qi >= ki + 32) ? exp2f(lg * (float)(qi - ki - 32)) : 0.f;
        p0[r] *= d0; p1[r] *= d1; }
      u32x4 pw0, pw1, pw2, pw3;
      pw0 = (u32x4){cvt_pk_bf16(p0[0], p0[1]), cvt_pk_bf16(p0[2], p0[3]), cvt_pk_bf16(p0[4], p0[5]), cvt_pk_bf16(p0[6], p0[7])};
      pw1 = (u32x4){cvt_pk_bf16(p0[8], p0[9]), cvt_pk_bf16(p0[10], p0[11]), cvt_pk_bf16(p0[12], p0[13]), cvt_pk_bf16(p0[14], p0[15])};
      pw2 = (u32x4){cvt_pk_bf16(p1[0], p1[1]), cvt_pk_bf16(p1[2], p1[3]), cvt_pk_bf16(p1[4], p1[5]), cvt_pk_bf16(p1[6], p1[7])};
      pw3 = (u32x4){cvt_pk_bf16(p1[8], p1[9]), cvt_pk_bf16(p1[10], p1[11]), cvt_pk_bf16(p1[12], p1[13]), cvt_pk_bf16(p1[14], p1[15])};
      pv(o, vb0 + tile * 8192, __builtin_bit_cast(bf16x8, pw0), __builtin_bit_cast(bf16x8, pw1), __builtin_bit_cast(bf16x8, pw2), __builtin_bit_cast(bf16x8, pw3));
    }
  }
  { const LAS bf16_t* st = (const LAS bf16_t*)(shm + R_ST) + wg * 64 * ST_PITCH;
#pragma unroll
    for (int eb = 0; eb < 2; ++eb)
#pragma unroll
      for (int s = 0; s < 4; ++s) { const bf16x8 bfrag = *(const LAS bf16x8*)(st + (eb * 32 + r32) * ST_PITCH + 16 * s + 8 * hi);
        o[eb] = __builtin_amdgcn_mfma_f32_32x32x16_bf16(qx[s], bfrag, o[eb], 0, 0, 0); } }
  asm volatile("s_waitcnt lgkmcnt(0)\n\ts_barrier" ::: "memory");
  { LAS float* stg = (LAS float*)(shm + R_STG) + wid * (32 * 66);
#pragma unroll
    for (int r = 0; r < 16; ++r) { stg[crow(r, hi) * 66 + r32] = o[0][r]; stg[crow(r, hi) * 66 + 32 + r32] = o[1][r]; }
    asm volatile("s_waitcnt lgkmcnt(0)" ::: "memory");
    const int row = lane >> 1, half = lane & 1;
    float v[32]; float s1 = 0.f;
#pragma unroll
    for (int j = 0; j < 32; ++j) { v[j] = stg[row * 66 + half * 32 + j]; s1 += v[j]; }
    s1 += __shfl_xor(s1, 1);
    const float mu = s1 * (1.0f / 64.0f); float s2 = 0.f;
#pragma unroll
    for (int j = 0; j < 32; ++j) { v[j] -= mu; s2 += v[j] * v[j]; }
    s2 += __shfl_xor(s2, 1);
    const float rs = rsqrtf(s2 * (1.0f / 64.0f) + LN_EPS);
    const long grow = rowbase + 256 * cp + 128 * wg + (wid & 3) * 32 + row;
    const bf16_t* gp = P.proj + grow * NPP + O_RG + h * 64 + half * 32;
    const float* gw = P.gn_w + h * 64 + half * 32;
    bf16_t* op = P.concat + grow * DM + h * 64 + half * 32;
#pragma unroll
    for (int c = 0; c < 4; ++c) { const bf16x8 g8 = *(const bf16x8*)(gp + 8 * c); float ov[8];
#pragma unroll
      for (int j = 0; j < 8; ++j) { const float g = bf2f((bf16_t)g8[j]); const float silu = g / (1.0f + __expf(-g)); ov[j] = v[8 * c + j] * rs * gw[8 * c + j] * silu; }
      u32x4 w; w.x = cvt_pk_bf16(ov[0], ov[1]); w.y = cvt_pk_bf16(ov[2], ov[3]); w.z = cvt_pk_bf16(ov[4], ov[5]); w.w = cvt_pk_bf16(ov[6], ov[7]);
      *(u32x4*)(op + 8 * c) = w; } }
  asm volatile("s_waitcnt lgkmcnt(0)\n\ts_barrier" ::: "memory");
}
}
namespace moe {
constexpr int CAP = TOK;
struct MoePtrs { const bf16_t* Y; const float* ln_g; const float* ln_b; const float* router_w; const float* router_bias;
                 float* X1; bf16_t* X1B; unsigned* cnt; unsigned* list; float* gate; };

__device__ __forceinline__ void ln1_router_row(const MoePtrs& P, int row, int lane, const LAS float* rw4, LAS float* xs, LAS unsigned* sel, const u32x2 (&yh)[4]) {
  f32x4 v[4]; float s = 0.f;
#pragma unroll
  for (int j = 0; j < 4; ++j) { const u32x2 h = yh[j]; v[j] = (f32x4){__uint_as_float(h.x << 16), __uint_as_float(h.x & 0xffff0000u), __uint_as_float(h.y << 16), __uint_as_float(h.y & 0xffff0000u)}; s += (v[j][0] + v[j][1]) + (v[j][2] + v[j][3]); }
  const float mean = wave_sum(s) * (1.f / DM); float s2 = 0.f;
#pragma unroll
  for (int j = 0; j < 4; ++j) { v[j] = v[j] - mean; s2 += (v[j][0] * v[j][0] + v[j][1] * v[j][1]) + (v[j][2] * v[j][2] + v[j][3] * v[j][3]); }
  const float rstd = rsqrtf(wave_sum(s2) * (1.f / DM) + LN_EPS);
  u32x2* xb = (u32x2*)(P.X1B + (size_t)row * DM) + lane;
#pragma unroll
  for (int j = 0; j < 4; ++j) { const int c0 = 4 * lane + 256 * j;
    const f32x4 g = *(const f32x4*)(P.ln_g + c0), bb = *(const f32x4*)(P.ln_b + c0);
    const f32x4 x = v[j] * rstd * g + bb;
    u32x2 o; o.x = pk2(x[0], x[1]); o.y = pk2(x[2], x[3]); xb[64 * j] = o;
    *(LAS f32x4*)(xs + c0) = x; }
  asm volatile("s_waitcnt lgkmcnt(0)" ::: "memory");
  const int e_l = lane & 15, kq = lane >> 4; float acc = 0.f;
#pragma unroll 8
  for (int i = 0; i < 64; ++i) { const f32x4 x = *(const LAS f32x4*)(xs + 16 * i + 4 * kq); const f32x4 w = *(const LAS f32x4*)(rw4 + ((4 * i + kq) * 16 + e_l) * 4);
    acc = fmaf(x[0], w[0], acc); acc = fmaf(x[1], w[1], acc); acc = fmaf(x[2], w[2], acc); acc = fmaf(x[3], w[3], acc); }
  acc += __shfl_xor(acc, 16); acc += __shfl_xor(acc, 32);
  float sc[16], bi[16];
#pragma unroll
  for (int e = 0; e < 16; ++e) { const float lg = __shfl(acc, e); sc[e] = 1.f / (1.f + expf(-lg)); bi[e] = sc[e] + P.router_bias[e]; }
  int bestg = 0; float bestgs = -INFINITY;
#pragma unroll
  for (int gI = 0; gI < 4; ++gI) { float m1 = -INFINITY, m2 = -INFINITY;
#pragma unroll
    for (int k = 0; k < 4; ++k) { const float x = bi[gI * 4 + k]; if (x > m1) { m2 = m1; m1 = x; } else if (x > m2) { m2 = x; } }
    const float gs = m1 + m2; if (gs > bestgs) { bestgs = gs; bestg = gI; } }
  int i1 = 0, i2 = 0; float m1 = -INFINITY, m2 = -INFINITY, s1 = 0.f, s2v = 0.f;
#pragma unroll
  for (int e = 0; e < 16; ++e) { if ((e >> 2) == bestg) { const float x = bi[e]; if (x > m1) { m2 = m1; i2 = i1; s2v = s1; m1 = x; i1 = e; s1 = sc[e]; } else if (x > m2) { m2 = x; i2 = e; s2v = sc[e]; } } }
  if (lane == 0) { const float inv = 1.f / (s1 + s2v); sel[0] = (unsigned)i1; sel[1] = (unsigned)i2; ((LAS float*)sel)[2] = s1 * inv; ((LAS float*)sel)[3] = s2v * inv; }
}
__device__ __forceinline__ void p5_phase(const MoePtrs& P, LAS char* shm, int vcu, int G) {
  const int tid = tidx(), lane = tid & 63, wave = tid >> 6;
  LAS float* rw4 = (LAS float*)shm; LAS float* xs = (LAS float*)(shm + 65536) + wave * 1024;
  LAS unsigned* sel = (LAS unsigned*)(shm + 98304);
  LAS unsigned* wbase = sel + 4 * 128;
  for (int i = tid; i < DM * 16; i += 512) { const int k = i >> 4, e = i & 15; rw4[((k >> 2) * 16 + e) * 4 + (k & 3)] = P.router_w[i]; }
  __syncthreads();
  const int rows_per_wg = (TOK + G - 1) / G;
  const int row0 = vcu * rows_per_wg; int nrows = TOK - row0; if (nrows > rows_per_wg) nrows = rows_per_wg; if (nrows < 0) nrows = 0;
  { u32x2 ycur[4], ynxt[4];
#pragma unroll
    for (int j = 0; j < 4; ++j) { ynxt[j] = (u32x2){0u, 0u}; if (wave < nrows) ynxt[j] = ((const u32x2*)(P.Y + (size_t)(row0 + wave) * DM) + lane)[64 * j]; }
    for (int r = wave; r < nrows; r += 8) {
#pragma unroll
      for (int j = 0; j < 4; ++j) ycur[j] = ynxt[j];
      if (r + 8 < nrows) {
#pragma unroll
        for (int j = 0; j < 4; ++j) ynxt[j] = ((const u32x2*)(P.Y + (size_t)(row0 + r + 8) * DM) + lane)[64 * j]; }
      ln1_router_row(P, row0 + r, lane, rw4, xs, sel + 4 * r, ycur); } }
  __syncthreads();
  LAS unsigned* wcnt = wbase + 16;
  unsigned e = 99u, myrank = 0u;
  if (wave < 2) { if (tid < 2 * nrows) e = sel[4 * (tid >> 1) + (tid & 1)];
    const unsigned long long lt = (lane == 0) ? 0ull : (~0ull >> (64 - lane));
#pragma unroll
    for (int k = 0; k < 16; ++k) { const unsigned long long mk = __ballot(e == (unsigned)k); if (e == (unsigned)k) myrank = (unsigned)__popcll(mk & lt); if (lane == k) wcnt[wave * 16 + k] = (unsigned)__popcll(mk); } }
  __syncthreads();
  if (tid < 16) { const unsigned c = wcnt[tid] + wcnt[16 + tid]; wbase[tid] = c ? atomicAdd(P.cnt + 64 * tid, c) : 0u; }
  __syncthreads();
  if (tid < 2 * nrows) { const int r = tid >> 1, sl = tid & 1;
    const size_t pos = (size_t)e * CAP + wbase[e] + (wave == 1 ? wcnt[e] : 0u) + myrank;
    P.list[pos] = (unsigned)(row0 + r) * 2u + (unsigned)sl; P.gate[pos] = ((LAS float*)sel)[4 * r + 2 + sl]; }
  __syncthreads();
}

template <int MODE>
struct MoeOrder {
  static constexpr int NPN = MODE == 0 ? 2 : 4, LDA2 = (MODE == 0 ? DM : DEXP) * 2;
  static constexpr size_t BSTRIDE_E = MODE == 0 ? (size_t)512 * DM * 2 : (size_t)DM * DEXP * 2, BSTRIDE_PN = MODE == 0 ? (size_t)256 * DM * 2 : (size_t)256 * DEXP * 2;
  const unsigned* __restrict__ cnt; const unsigned* __restrict__ list; const char* A; const char* Bt;
  __device__ __forceinline__ bool next(int i, pg8::Unit& u) const {
    const int L = i * (int)gridDim.x + (int)blockIdx.x; const int tile = L / NPN; u.pn = L % NPN; u.pm = tile;
    int acc = 0, e = -1, mt = 0, valid = 0;
#pragma unroll
    for (int k = 0; k < NEXP; ++k) { const int cn = __builtin_amdgcn_readfirstlane((int)cnt[64 * k]); const int nt = (cn + 255) >> 8; if (e < 0 && tile < acc + nt) { e = k; mt = tile - acc; valid = cn - mt * 256; } acc += nt; }
    if (e < 0) return false;
    u.e = e; u.mt = mt; u.valid = valid > 256 ? 256 : valid; u.pad = 0;
    u.pA = MODE == 1 ? A + (size_t)tile * 256 * LDA2 : A;
    u.pB = Bt + (size_t)e * BSTRIDE_E + (size_t)u.pn * BSTRIDE_PN;
    return true;
  }
  __device__ __forceinline__ unsigned rowoff(const pg8::Unit& u, int r) const {
    unsigned slot = 0u; if (r < u.valid) slot = list[(size_t)u.e * CAP + u.mt * 256 + r];
    return (slot >> 1) * (unsigned)LDA2; }
};
struct EpiSwiglu {
  static constexpr bool PERM = true;
  bf16_t* A2; const float* gate;
  __device__ __forceinline__ void operator()(const f32x4 (&acc)[2][2][4][2], const pg8::Unit& u, int wr, int wc, int fr, int fq) const {
    { const int l_ = tidx() & 63; fr = l_ & 15; fq = l_ >> 4; }
    const int col0 = u.pn * 128 + wc * 32 + 8 * fq; const int lane = fq * 16 + fr;
    const int rb = wr * 64 + lane; const size_t gb = (size_t)u.e * CAP + u.mt * 256;
    float g0 = 0.f, g1 = 0.f; if (rb < u.valid) g0 = gate[gb + rb]; if (128 + rb < u.valid) g1 = gate[gb + 128 + rb];
#pragma unroll
    for (int ai = 0; ai < 2; ++ai)
#pragma unroll
      for (int m = 0; m < 4; ++m) { const int r = ai * 128 + wr * 64 + m * 16 + fr;
        const float g = __shfl(ai ? g1 : g0, m * 16 + fr);
        float a[8];
#pragma unroll
        for (int n = 0; n < 2; ++n)
#pragma unroll
          for (int i = 0; i < 4; ++i) { const float h1 = acc[ai][0][m][n][i], h2 = acc[ai][1][m][n][i]; a[4 * n + i] = h1 / (1.f + __expf(-h1)) * h2 * g; }
        u32x4 w; w.x = cvt_pk_bf16(a[0], a[1]); w.y = cvt_pk_bf16(a[2], a[3]); w.z = cvt_pk_bf16(a[4], a[5]); w.w = cvt_pk_bf16(a[6], a[7]);
        *(u32x4*)(A2 + ((size_t)u.pm * 256 + r) * 256 + col0) = w;
        asm volatile("" ::: "memory"); }
  }
};
struct EpiScatter {
  static constexpr bool PERM = true;
  bf16_t* YE; const unsigned* list;
  __device__ __forceinline__ void operator()(const f32x4 (&acc)[2][2][4][2], const pg8::Unit& u, int wr, int wc, int fr, int fq) const {
    { const int l_ = tidx() & 63; fr = l_ & 15; fq = l_ >> 4; }
    const int col0 = u.pn * 256 + wc * 32 + 8 * fq; const int lane = fq * 16 + fr;
    const int rb = wr * 64 + lane; const size_t gb = (size_t)u.e * CAP + u.mt * 256;
    unsigned s0 = (unsigned)(2 * TOK), s1 = (unsigned)(2 * TOK); if (rb < u.valid) s0 = list[gb + rb]; if (128 + rb < u.valid) s1 = list[gb + 128 + rb];
#pragma unroll
    for (int ai = 0; ai < 2; ++ai)
#pragma unroll
      for (int m = 0; m < 4; ++m) {
        const unsigned slot = (unsigned)__shfl((int)(ai ? s1 : s0), m * 16 + fr);
        { bf16_t* rowp = YE + (size_t)slot * DM + col0;
#pragma unroll
          for (int bj = 0; bj < 2; ++bj) { const f32x4 v0 = acc[ai][bj][m][0], v1 = acc[ai][bj][m][1];
            u32x4 w; w.x = cvt_pk_bf16(v0[0], v0[1]); w.y = cvt_pk_bf16(v0[2], v0[3]); w.z = cvt_pk_bf16(v1[0], v1[1]); w.w = cvt_pk_bf16(v1[2], v1[3]);
            *(u32x4*)(rowp + bj * 128) = w; } }
        asm volatile("" ::: "memory"); }
  }
};
struct Ln2Ptrs { const bf16_t* X1; const bf16_t* YE; const float* g; const float* b; float* out; bf16_t* XB; };
#define LN2_LOAD(P, row, lane, X, Y0, Y1) do { const u32x2* xr_ = (const u32x2*)((P).X1 + (size_t)(row) * DM) + (lane); \
  const u32x2* y0_ = (const u32x2*)((P).YE + (size_t)(row) * 2 * DM) + (lane); const u32x2* y1_ = y0_ + DM / 4; \
  _Pragma("unroll") for (int j = 0; j < 4; ++j) { X[j] = xr_[64 * j]; Y0[j] = y0_[64 * j]; Y1[j] = y1_[64 * j]; } } while (0)
__device__ __forceinline__ void ln2_row(const Ln2Ptrs& P, int row, int lane, const u32x2 (&inx)[4], const u32x2 (&iny0)[4], const u32x2 (&iny1)[4]) {
  f32x4 v[4]; float s = 0.f;
#pragma unroll
  for (int j = 0; j < 4; ++j) { const u32x2 xh = inx[j]; const f32x4 x = (f32x4){__uint_as_float(xh.x << 16), __uint_as_float(xh.x & 0xffff0000u), __uint_as_float(xh.y << 16), __uint_as_float(xh.y & 0xffff0000u)}; const u32x2 a = iny0[j], bq = iny1[j];
    f32x4 y; y[0] = __uint_as_float(a.x << 16) + __uint_as_float(bq.x << 16); y[1] = __uint_as_float(a.x & 0xffff0000u) + __uint_as_float(bq.x & 0xffff0000u);
    y[2] = __uint_as_float(a.y << 16) + __uint_as_float(bq.y << 16); y[3] = __uint_as_float(a.y & 0xffff0000u) + __uint_as_float(bq.y & 0xffff0000u);
    v[j] = x * ALPHA + y; s += (v[j][0] + v[j][1]) + (v[j][2] + v[j][3]); }
  const float mean = wave_sum(s) * (1.f / DM); float s2 = 0.f;
#pragma unroll
  for (int j = 0; j < 4; ++j) { v[j] = v[j] - mean; s2 += (v[j][0] * v[j][0] + v[j][1] * v[j][1]) + (v[j][2] * v[j][2] + v[j][3] * v[j][3]); }
  const float rstd = rsqrtf(wave_sum(s2) * (1.f / DM) + LN_EPS);
  f32x4* xo = (f32x4*)(P.out + (size_t)row * DM) + lane; u32x2* xb = (u32x2*)(P.XB + (size_t)row * DM) + lane;
#pragma unroll
  for (int j = 0; j < 4; ++j) { const int c0 = 4 * lane + 256 * j;
    const f32x4 g = *(const f32x4*)(P.g + c0), bb = *(const f32x4*)(P.b + c0);
    const f32x4 x = v[j] * rstd * g + bb;
    if (P.out) xo[64 * j] = x; else { u32x2 o; o.x = pk2(x[0], x[1]); o.y = pk2(x[2], x[3]); xb[64 * j] = o; } }
}
}
#ifndef PROBE_PHASE
#define PROBE_PHASE 0
#endif
#define NREP(p) ((PROBE_PHASE == (p)) ? 2 : 1)
constexpr int LDS_BYTES = 147456;
constexpr int NTHREADS = 512;
constexpr int MISC_OFF = 131072;
constexpr int CW_QCTR = 64;
constexpr int CW_CNT = 8192;
constexpr int CW_BAR = 4096;

typedef GAS unsigned gu32;
#define RLX_AGENT __ATOMIC_RELAXED, __HIP_MEMORY_SCOPE_AGENT
#define XB_TMO      128
#define XB_XCNT(j)  (256  + 64 * (j))
#define XB_XSUB(j)  (1280 + 64 * (j))
#define XB_XGEN(j)  (2304 + 64 * (j))
#define XB_TOP      3328
#define XB_TOPGEN   3392
#define XCD_BAR_WORDS 3456
#define XB_SPIN_CAP (1u << 20)
__device__ __forceinline__ unsigned xb_ld(gu32* p)              { return __hip_atomic_load(p, __ATOMIC_RELAXED, __HIP_MEMORY_SCOPE_AGENT); }
__device__ __forceinline__ unsigned xb_add(gu32* p, unsigned v) { return __hip_atomic_fetch_add(p, v, __ATOMIC_RELAXED, __HIP_MEMORY_SCOPE_AGENT); }
__device__ __forceinline__ unsigned xb_xcc_id() { return (unsigned)__builtin_amdgcn_s_getreg((3 << 11) | 20) & 0xFu; }
#define XB_SPIN(cond, bar) do { unsigned _sp = 0; while (cond) { __builtin_amdgcn_s_sleep(1); \
    if ((++_sp & 255u) == 0u) { if (xb_ld(&(bar)[XB_TMO])) break; if (_sp > XB_SPIN_CAP) { (void)xb_add(&(bar)[XB_TMO], 1u); break; } } } } while (0)
struct XcdBarrier { gu32* bar; unsigned x; volatile LAS unsigned* st; };
__device__ __forceinline__ XcdBarrier xcd_barrier_post(gu32* bar, volatile LAS unsigned* st) {
    XcdBarrier b; b.bar = bar; b.x = xb_xcc_id(); b.st = st;
    if (tidx() == 0) (void)xb_add(&bar[XB_XCNT(b.x)], 1u);
    return b;
}
__device__ __forceinline__ void xcd_barrier_complete(gu32* bar, unsigned x, unsigned& nloc, unsigned& nx) {
    const unsigned G = gridDim.x * gridDim.y * gridDim.z;
    unsigned sum, cnt, mine, sp = 0u;
    for (;;) {
        sum = 0u; cnt = 0u; mine = 0u;
#pragma unroll
        for (unsigned j = 0; j < 16; ++j) { const unsigned c = xb_ld(&bar[XB_XCNT(j)]); sum += c; cnt += (c > 0u) ? 1u : 0u; mine = (j == x) ? c : mine; }
        if (sum == G) break;
        __builtin_amdgcn_s_sleep(1);
        if ((++sp & 255u) == 0u) { if (xb_ld(&bar[XB_TMO])) break; if (sp > XB_SPIN_CAP) { (void)xb_add(&bar[XB_TMO], 1u); break; } }
    }
    nloc = mine > 0u ? mine : 1u; nx = cnt > 0u ? cnt : 1u;
}
__device__ __forceinline__ void xcd_barrier(const XcdBarrier& b) {
    asm volatile("s_waitcnt vmcnt(0)" ::: "memory");
    __syncthreads();
    if (tidx() == 0) {
        gu32* bar = b.bar; unsigned bx_ = b.x;
        asm volatile("" : "+s"(bar), "+s"(bx_));
        __builtin_amdgcn_s_waitcnt(0);
        unsigned nloc = b.st[0], nx = b.st[1];
        if (nloc == 0u) { xcd_barrier_complete(bar, bx_, nloc, nx); b.st[0] = nloc; b.st[1] = nx; }
        const unsigned old = xb_add(&bar[XB_XSUB(bx_)], 1u);
        const unsigned gen = old / nloc;
        if (old + 1u == (gen + 1u) * nloc) {
            __builtin_amdgcn_fence(__ATOMIC_RELEASE, "agent");
            asm volatile("s_waitcnt vmcnt(0)" ::: "memory");
            const unsigned og = xb_add(&bar[XB_TOP], 1u);
            const unsigned tg = og / nx;
            if (og + 1u == (tg + 1u) * nx) xb_add(&bar[XB_TOPGEN], 1u);
            else XB_SPIN(xb_ld(&bar[XB_TOPGEN]) == tg, bar);
            __builtin_amdgcn_fence(__ATOMIC_ACQUIRE, "agent");
            xb_add(&bar[XB_XGEN(bx_)], 1u);
            asm volatile("s_waitcnt vmcnt(0)" ::: "memory");
        } else {
            XB_SPIN(xb_ld(&bar[XB_XGEN(bx_)]) == gen, bar);
            __builtin_amdgcn_fence(__ATOMIC_ACQUIRE, "agent");
            asm volatile("s_waitcnt vmcnt(0)" ::: "memory");
        }
    }
    __syncthreads();
}

struct Args { const float* in[17]; float* out; unsigned char* ws; };
#define CAS __attribute__((address_space(4)))
__device__ __forceinline__ const CAS char* kargs() { const CAS char* kp = (const CAS char*)__builtin_amdgcn_kernarg_segment_ptr(); asm volatile("" : "+s"(kp)); return kp; }

__global__ void __launch_bounds__(NTHREADS, 2) mk_fwd(Args a) {
    extern __shared__ __attribute__((aligned(16))) unsigned char lds[];
    LAS unsigned char* L = (LAS unsigned char*)lds;
    LAS char* shm = (LAS char*)lds;
    volatile LAS unsigned* MISC = (volatile LAS unsigned*)(L + MISC_OFF);
#define lane (tidx() & 63)
#define wave (__builtin_amdgcn_readfirstlane(tidx() >> 6))
    const int G = gridDim.x, bx = blockIdx.x;
    const int vcu = (G % 8 == 0) ? (bx % 8) * (G / 8) + bx / 8 : bx;
    for (int u = tidx(); u < (LDS_BYTES - MISC_OFF) / 4; u += NTHREADS) ((LAS unsigned*)(L + MISC_OFF))[u] = 0u;
    __syncthreads();

#define KPTR(off, ET) ((ET*)(ET GAS*)(*(const unsigned long long CAS*)(kargs() + (off))))
#define IN_(i) KPTR(8 * (i), const float)
#define g_x_in IN_(0)
#define g_w_in IN_(1)
#define g_ret_gn_w IN_(2)
#define g_swa_sinks IN_(3)
#define g_qn_w IN_(4)
#define g_kvn_w IN_(5)
#define g_w_uq IN_(6)
#define g_w_ukv IN_(7)
#define g_w_out IN_(8)
#define g_ln1_g IN_(9)
#define g_ln1_b IN_(10)
#define g_router_w IN_(11)
#define g_router_bias IN_(12)
#define g_wgu IN_(13)
#define g_wd IN_(14)
#define g_ln2_g IN_(15)
#define g_ln2_b IN_(16)
#define g_out KPTR(136, float)
#define g_ws KPTR(144, unsigned char)
#define g_CTL ((unsigned*)(g_ws + WS_CTL))
#define g_XB ((bf16_t*)(g_ws + WS_R0))
#define g_PROJ ((bf16_t*)(g_ws + WS_R1))
#define g_Y ((bf16_t*)(g_ws + WS_R1))
#define g_QM ((bf16_t*)(g_ws + WS_QM))
#define g_KVM ((bf16_t*)(g_ws + WS_KVM))
#define g_KPE ((bf16_t*)(g_ws + WS_KPE))
#define g_CONCAT ((bf16_t*)(g_ws + WS_R3))
#define g_X1 ((float*)(g_ws + WS_X1))
#define g_TABR ((const float2*)(g_ws + WS_TABR))
#define g_TABM ((const float2*)(g_ws + WS_TABM))
#define g_X1B ((bf16_t*)(g_ws + WS_R0))
#define g_A2 ((bf16_t*)(g_ws + WS_A2))
#define g_YE ((bf16_t*)(g_ws + WS_YE))
#define g_list ((unsigned*)(g_ws + WS_LIST))
#define g_gate ((float*)(g_ws + WS_GATE))

    XcdBarrier bar = xcd_barrier_post((gu32*)(g_CTL + CW_BAR), MISC + 8);
#define GRID_BAR() do { xcd_barrier(bar); if (PROBE_PHASE == 10) xcd_barrier(bar); } while (0)

    for (int rep_ = 0; rep_ < NREP(9); ++rep_)
    { P0Args pa; pa.x = g_x_in; pa.w_in = g_w_in; pa.qn_w = g_qn_w; pa.kvn_w = g_kvn_w; pa.w_uq = g_w_uq; pa.w_ukv = g_w_ukv; pa.w_out = g_w_out; pa.ws = g_ws;
      p0_all(pa, L, vcu, G); }
    GRID_BAR();

    for (int l = 0; l < DEPTH; ++l) {
        for (int rep_ = 0; rep_ < NREP(1); ++rep_)
        { pg8::Gemm g{g_XB, (const bf16_t*)(g_ws + WS_WIN) + (size_t)l * NPP * DM, DM, DM, DM, 0}; pg8::EpiBf16Norm E{g_PROJ, (float*)(g_ws + WS_PARTS), NPP, 0};
          pg8::StaticOrder S; S.init(g, TOK, NPP, G, bx);
          pg8::gemm_phase<pg8::EpiBf16Norm, pg8::StaticOrder, true, false>(L, g, S, E);
          const int nun = (TOK / 256) * (NPP / 256); const int nfull = nun % G;
          if (nfull == 0) p0_experts(g_wgu + (size_t)l * NEXP * DM * 512, g_wd + (size_t)l * NEXP * DEXP * DM, g_ws, (LAS float*)(L + wave * 16384), bx * 8 + wave, G * 8, lane);
          else if (bx >= nfull) p0_experts(g_wgu + (size_t)l * NEXP * DM * 512, g_wd + (size_t)l * NEXP * DEXP * DM, g_ws, (LAS float*)(L + wave * 16384), (bx - nfull) * 8 + wave, (G - nfull) * 8, lane); }
        GRID_BAR();
        for (int rep_ = 0; rep_ < NREP(2); ++rep_) {
        { pg8::Gemm g{g_PROJ + O_CQ, (const bf16_t*)(g_ws + WS_WUQ) + (size_t)l * NQMP * 384, NPP, 384, 384, 0}; pg8::EpiRms E{g_QM, (const float*)(g_ws + WS_PARTS), NQMP, 0, 8, 1.0f / 384.0f, RMS_EPS, 0};
          pg8::StaticOrder S; S.init(g, TOK, NQMP, G, bx);
          pg8::gemm_phase<pg8::EpiRms, pg8::StaticOrder, true, false>(L, g, S, E); }
        { pg8::Gemm g{g_PROJ + O_CKV, (const bf16_t*)(g_ws + WS_WUKV) + (size_t)l * NKVM * 256, NPP, 256, 256, 0}; pg8::EpiRms E{g_KVM, (const float*)(g_ws + WS_PARTS), NKVM, 8, 4, 1.0f / 256.0f, RMS_EPS, 0};
          pg8::StaticOrder S; S.init(g, TOK, NKVM, G, G - 1 - bx);
          pg8::gemm_phase<pg8::EpiRms, pg8::StaticOrder, true, false>(L, g, S, E); }
        for (int idx = vcu * NTHREADS + tidx(); idx < TOK * 16; idx += G * NTHREADS) {
          const int t = idx >> 4, i = idx & 15, pos = t % SEQ; const bf16_t* p = g_PROJ + (size_t)t * NPP + O_KR; const float2 cs = g_TABM[pos * 16 + i];
          const float x1 = bf2f(p[i]), x2 = bf2f(p[i + 16]);
          g_KPE[(size_t)t * 32 + i] = (bf16_t)f2bf(x1 * cs.x - x2 * cs.y); g_KPE[(size_t)t * 32 + i + 16] = (bf16_t)f2bf(x1 * cs.y + x2 * cs.x); }
        { ret::RetPtrs rp; rp.proj = g_PROJ; rp.tabr = g_TABR; rp.gn_w = g_ret_gn_w + l * 256; rp.U = (float*)(g_ws + WS_U); rp.concat = g_CONCAT;
          for (int u = G - 1 - bx; u < 256; u += G) ret::upd_unit(rp, u >> 7, (u >> 5) & 3, u & 31, shm); }
        }
        GRID_BAR();
        { att::AttnPtrs ap; ap.proj = g_PROJ; ap.qm = g_QM; ap.kvm = g_KVM; ap.kpe = g_KPE; ap.tabm = g_TABM; ap.sinks = g_swa_sinks + l * 6; ap.concat = g_CONCAT;
          ret::RetPtrs rp; rp.proj = g_PROJ; rp.tabr = g_TABR; rp.gn_w = g_ret_gn_w + l * 256; rp.U = (float*)(g_ws + WS_U); rp.concat = g_CONCAT;
          for (int rep_ = 0; rep_ < NREP(3); ++rep_)
          for (;;) {
            if (tidx() == 0) MISC[0] = atomicAdd(g_CTL + CW_QCTR + 64 * l + rep_, 1u);
            __syncthreads();
            const unsigned idx = MISC[0];
            __syncthreads();
            if (idx >= 1024u) break;
            if (idx < 384u) { const int qb = 31 - (int)(idx / 12u), bh = (int)(idx % 12u); att::attn_unit<0>(ap, bh / 6, bh % 6, qb, shm); }
            else if (idx < 768u) { const unsigned i2 = idx - 384u; const int qb = (int)(i2 / 12u), bh = (int)(i2 % 12u); att::attn_unit<1>(ap, bh / 6, bh % 6, qb, shm); }
            else { const int u = (int)(idx - 768u); ret::out_unit(rp, u >> 7, (u >> 5) & 3, u & 31, shm); }
          } }
        GRID_BAR();
        for (int rep_ = 0; rep_ < NREP(4); ++rep_)
        { pg8::Gemm g{g_CONCAT, (const bf16_t*)(g_ws + WS_WOUT) + (size_t)l * DM * DM, DM, DM, DM, 0}; pg8::EpiResid E{(l == 0) ? g_x_in : (const float*)nullptr, g_XB, g_Y, DM, ALPHA};
          pg8::StaticOrder S; S.init(g, TOK, DM, G, bx);
          pg8::gemm_phase<pg8::EpiResid, pg8::StaticOrder, true, false>(L, g, S, E); }
        GRID_BAR();
#define g_cnt (g_CTL + CW_CNT + 2048 * l)
        if (PROBE_PHASE == 5) { moe::MoePtrs mp; mp.Y = g_Y; mp.ln_g = g_ln1_g + l * DM; mp.ln_b = g_ln1_b + l * DM; mp.router_w = g_router_w; mp.router_bias = g_router_bias; mp.X1 = nullptr; mp.X1B = g_X1B;
          mp.cnt = g_CTL + CW_CNT + 2048 * l + 1024; mp.list = (unsigned*)(g_ws + WS_R1 + 64 * MiB); mp.gate = (float*)(g_ws + WS_R1 + 65 * MiB);
          moe::p5_phase(mp, shm, vcu, G); }
        { moe::MoePtrs mp; mp.Y = g_Y; mp.ln_g = g_ln1_g + l * DM; mp.ln_b = g_ln1_b + l * DM; mp.router_w = g_router_w; mp.router_bias = g_router_bias; mp.X1 = nullptr; mp.X1B = g_X1B; mp.cnt = g_cnt; mp.list = g_list; mp.gate = g_gate;
          moe::p5_phase(mp, shm, vcu, G); }
        GRID_BAR();
        for (int rep_ = 0; rep_ < NREP(6); ++rep_)
        { moe::MoeOrder<0> S; S.cnt = g_cnt; S.list = g_list; S.A = (const char*)g_X1B; S.Bt = (const char*)(g_ws + WS_WGU);
          pg8::Gemm g{nullptr, nullptr, DM, DM, DM, 0}; moe::EpiSwiglu E{g_A2, g_gate};
          pg8::gemm_phase<moe::EpiSwiglu, moe::MoeOrder<0>, true, true>(L, g, S, E); }
        GRID_BAR();
        for (int rep_ = 0; rep_ < NREP(7); ++rep_)
        { moe::MoeOrder<1> S; S.cnt = g_cnt; S.list = g_list; S.A = (const char*)g_A2; S.Bt = (const char*)(g_ws + WS_WD);
          pg8::Gemm g{nullptr, nullptr, DEXP, DEXP, DEXP, 0}; moe::EpiScatter E{g_YE, g_list};
          pg8::gemm_phase<moe::EpiScatter, moe::MoeOrder<1>, true, false>(L, g, S, E); }
        GRID_BAR();
        for (int rep_ = 0; rep_ < NREP(8); ++rep_)
        { moe::Ln2Ptrs lp; lp.X1 = g_X1B; lp.YE = g_YE; lp.g = g_ln2_g + l * DM; lp.b = g_ln2_b + l * DM; lp.out = (l + 1 < DEPTH) ? (float*)nullptr : g_out; lp.XB = g_XB;
          u32x2 cx[4], cy0[4], cy1[4], nx[4], ny0[4], ny1[4]; int row = vcu * 8 + wave; const int ln_ = lane;
#pragma unroll
          for (int j = 0; j < 4; ++j) { nx[j] = (u32x2){0u, 0u}; ny0[j] = nx[j]; ny1[j] = nx[j]; }
          if (row < TOK) LN2_LOAD(lp, row, ln_, nx, ny0, ny1);
          for (; row < TOK; row += G * 8) {
#pragma unroll
            for (int j = 0; j < 4; ++j) { cx[j] = nx[j]; cy0[j] = ny0[j]; cy1[j] = ny1[j]; }
            if (row + G * 8 < TOK) LN2_LOAD(lp, row + G * 8, ln_, nx, ny0, ny1);
            moe::ln2_row(lp, row, ln_, cx, cy0, cy1); } }
        if (l + 1 < DEPTH) GRID_BAR();
    }
    if (xb_ld((gu32*)(g_CTL + CW_BAR + XB_TMO)) != 0u && bx == 0 && tidx() == 0) g_out[0] = __builtin_nanf("");
#undef g_out
#undef g_ws
#undef g_list
#undef g_gate
#undef g_cnt
}

extern "C" void kernel_launch(void* const* d_in, const int* in_sizes, int n_in, void* d_out, int out_size, void* d_ws, size_t ws_size, hipStream_t stream) {
    static int grid = 0;
    if (grid == 0) {
        if (n_in != 17 || ws_size < WS_END || out_size != TOK * DM) { fprintf(stderr, "kernel_launch: unexpected problem (n_in %d, ws %zu, out %d); nothing launched\n", n_in, ws_size, out_size); grid = -1; return; }
        int dev = 0, cus = 0, per_cu = 0;
        if (hipGetDevice(&dev) != hipSuccess || hipDeviceGetAttribute(&cus, hipDeviceAttributeMultiprocessorCount, dev) != hipSuccess) { grid = -1; return; }
        if (hipFuncSetAttribute((const void*)mk_fwd, hipFuncAttributeMaxDynamicSharedMemorySize, LDS_BYTES) != hipSuccess) { fprintf(stderr, "kernel_launch: hipFuncSetAttribute failed\n"); grid = -1; return; }
        if (hipOccupancyMaxActiveBlocksPerMultiprocessor(&per_cu, (const void*)mk_fwd, NTHREADS, LDS_BYTES) != hipSuccess || per_cu < 1) { fprintf(stderr, "kernel_launch: occupancy query says %d workgroups per CU\n", per_cu); (void)hipGetLastError(); grid = -1; return; }
        grid = cus;
    }
    if (grid < 0) return;
    (void)hipMemsetAsync((char*)d_ws + WS_CTL, 0, CTL_ZERO_BYTES, stream);
    Args a{};
    for (int i = 0; i < 17; ++i) a.in[i] = (const float*)d_in[i];
    a.out = (float*)d_out; a.ws = (unsigned char*)d_ws;
    hipLaunchKernelGGL(mk_fwd, dim3(grid), dim3(NTHREADS), LDS_BYTES, stream, a);
}
```

```cpp
#define PROBE_PHASE 0
#include <hip/hip_runtime.h>
#include <cstdio>
#include <cstdint>
#include <math.h>
#include <type_traits>

constexpr int BATCH = 2, SEQ = 8192, TOK = BATCH * SEQ, DM = 1024, DEPTH = 2;
constexpr int NP = 2336, NPP = 2560;
constexpr int O_RQ = 0, O_RK = 256, O_RV = 512, O_RG = 768, O_SQ = 1024, O_SK = 1408, O_SV = 1536, O_CQ = 1664, O_CKV = 2048, O_KR = 2304;
constexpr int NQM = 576, NQMP = 768, NKVM = 768;
constexpr int NEXP = 16, DEXP = 256;
constexpr float LN_EPS = 1e-5f, RMS_EPS = 1e-6f;
constexpr float ALPHA = 1.4142135623730951f;
constexpr float LOG2E = 1.4426950408889634f;

typedef unsigned short bf16_t;
typedef short bf16x8 __attribute__((ext_vector_type(8)));
typedef float f32x4 __attribute__((ext_vector_type(4)));
typedef float f32x16 __attribute__((ext_vector_type(16)));
typedef unsigned u32x4 __attribute__((ext_vector_type(4)));
typedef unsigned u32x2 __attribute__((ext_vector_type(2)));
#define LAS __attribute__((address_space(3)))
#define GAS __attribute__((address_space(1)))

constexpr size_t MiB = 1u << 20;
constexpr size_t WS_CTL = 0, CTL_ZERO_BYTES = 1 * MiB;
constexpr size_t WS_LIST = 1 * MiB, WS_GATE = 2 * MiB;
constexpr size_t WS_TABR = 3 * MiB, WS_TABM = 5 * MiB;
constexpr size_t WS_WIN = 6 * MiB;
constexpr size_t WS_WUQ = 16 * MiB;
constexpr size_t WS_WUKV = 17 * MiB + 256 * 1024;
constexpr size_t WS_WOUT = 18 * MiB;
constexpr size_t WS_WGU = 22 * MiB;
constexpr size_t WS_WD = 38 * MiB;
constexpr size_t WS_R0 = 46 * MiB;
constexpr size_t WS_R1 = 78 * MiB;
constexpr size_t WS_A2 = WS_R1, WS_YE = WS_R1 + 18 * MiB;
constexpr size_t WS_R2 = 162 * MiB;
constexpr size_t WS_QM = WS_R2, WS_KVM = WS_R2 + 24 * MiB, WS_KPE = WS_R2 + 48 * MiB, WS_U = WS_R2 + 49 * MiB;
constexpr size_t WS_R3 = 219 * MiB;
constexpr size_t WS_X1 = WS_R2;
constexpr size_t WS_PARTS = 251 * MiB;
constexpr size_t WS_END = 252 * MiB;
static_assert(WS_WUQ + 2 * 768 * 384 * 2 <= WS_WUKV && WS_WUKV + 2 * 768 * 256 * 2 <= WS_WOUT, "ws map");
static_assert(WS_U + 8 * MiB <= WS_R3 && WS_X1 + 64 * MiB <= WS_END && WS_YE + 64 * MiB <= WS_R2, "ws map");

__device__ __forceinline__ int tidx() { int t = (int)threadIdx.x; asm volatile("" : "+v"(t)); return t; }

__device__ __forceinline__ float bf2f(bf16_t v) { return __uint_as_float(((unsigned)v) << 16); }
__device__ __forceinline__ unsigned f2bf(float f) { unsigned u = __float_as_uint(f); return (u + 0x7fffu + ((u >> 16) & 1u)) >> 16; }
__device__ __forceinline__ unsigned pk2(float lo, float hi) { return f2bf(lo) | (f2bf(hi) << 16); }
__device__ __forceinline__ unsigned cvt_pk_bf16(float lo, float hi) { unsigned r; asm volatile("v_cvt_pk_bf16_f32 %0, %1, %2" : "=v"(r) : "v"(lo), "v"(hi)); return r; }
template <int K> __device__ __forceinline__ float sx(float v) {
  if constexpr (K == 32) { auto rr = __builtin_amdgcn_permlane32_swap(__float_as_uint(v), __float_as_uint(v), false, false); return __uint_as_float(((tidx() & 32) != 0) ? rr[0] : rr[1]); }
  else return __uint_as_float((unsigned)__builtin_amdgcn_ds_swizzle((int)__float_as_uint(v), (K << 10) | 0x1f));
}
__device__ __forceinline__ float wave_sum(float v) {
  v += sx<1>(v); v += sx<2>(v); v += sx<4>(v); v += sx<8>(v); v += sx<16>(v); v += sx<32>(v);
  return v;
}
#define LDS_WAIT() asm volatile("s_waitcnt lgkmcnt(0)" ::: "memory")
#define VM_WAIT() asm volatile("s_waitcnt vmcnt(0)" ::: "memory")

namespace pg8 {
constexpr int BM = 256, BK = 64, HALF = 128, HTB = HALF * BK * 2  , STAGE_BYTES = 8 * HTB, NXCD = 8, WGM = 8;

__host__ __device__ __forceinline__ int lds_byte(int r, int c) { const int st = (r >> 4) * 2 + (c >> 5), rr = r & 15, cc = c & 31, ob = rr * 64 + cc * 2; return st * 1024 + (ob ^ (((ob >> 9) & 1) << 5)); }
__host__ __device__ __forceinline__ void stage_rc(int b, int& R, int& C) { const int st = b / 1024, sb = b % 1024, swz = sb ^ (((sb >> 9) & 1) << 5); R = (st >> 1) * 16 + swz / 64; C = (st & 1) * 32 + (swz % 64) / 2; }
__host__ __device__ __forceinline__ int perm32(int rho) { const int n = rho >> 4, i = rho & 15; return 8 * (i >> 2) + 4 * n + (i & 3); }

struct Unit { int pm, pn; const char* pA; const char* pB; int e, mt, valid, pad; };
struct Gemm { const bf16_t* A; const bf16_t* Bt; int lda, ldb, K, pad; };

struct StaticOrder {
    int nM, nN, nwg, G, c; const char* A; const char* Bt; size_t tA, tB;
    __host__ __device__ void init(const Gemm& g, int M, int N, int G_, int c_) { nM = M / BM; nN = N / BM; nwg = nM * nN; G = G_; c = c_; A = (const char*)g.A; Bt = (const char*)g.Bt; tA = (size_t)BM * g.lda * 2; tB = (size_t)BM * g.ldb * 2; }
    __device__ __forceinline__ unsigned rowoff(const Unit&, int) const { return 0u; }
    __host__ __device__ bool next(int i, Unit& u) const {
        const long L = (long)i * G + c; if (L >= nwg) return false;
        int wgid = (int)L; { const int q = nwg / NXCD, r = nwg % NXCD, xcd = wgid % NXCD, off = wgid / NXCD; wgid = (xcd < r ? xcd * (q + 1) : r * (q + 1) + (xcd - r) * q) + off; }
        const int nig = WGM * nN, gid = wgid / nig, fm = gid * WGM, gsz = (nM - fm) < WGM ? (nM - fm) : WGM;
        u.pm = fm + ((wgid % nig) % gsz); u.pn = (wgid % nig) / gsz; u.pA = A + (size_t)u.pm * tA; u.pB = Bt + (size_t)u.pn * tB; u.e = 0; u.mt = 0; u.valid = BM; u.pad = 0; return true;
    }
};

struct EpiBf16 {
    static constexpr bool PERM = true;
    bf16_t* O; int ldc, pad;
    __device__ __forceinline__ void operator()(const f32x4 (&acc)[2][2][4][2], const Unit& u, int wr, int wc, int fr, int fq) const {
        const int row0 = u.pm * BM + wr * 64 + fr; const int col0 = u.pn * BM + wc * 32 + 8 * fq;
#pragma unroll
        for (int ai = 0; ai < 2; ++ai)
#pragma unroll
            for (int m = 0; m < 4; ++m) { bf16_t* rowp = O + (size_t)(row0 + ai * HALF + m * 16) * ldc + col0;
#pragma unroll
                for (int bj = 0; bj < 2; ++bj) { const f32x4 v0 = acc[ai][bj][m][0], v1 = acc[ai][bj][m][1];
                    u32x4 w; w.x = cvt_pk_bf16(v0[0], v0[1]); w.y = cvt_pk_bf16(v0[2], v0[3]); w.z = cvt_pk_bf16(v1[0], v1[1]); w.w = cvt_pk_bf16(v1[2], v1[3]);
                    *(u32x4*)(rowp + bj * HALF) = w; } }
    }
};
struct EpiBf16Norm {
    static constexpr bool PERM = true;
    bf16_t* O; float* parts; int ldc, pad;
    __device__ __forceinline__ void operator()(const f32x4 (&acc)[2][2][4][2], const Unit& u, int wr, int wc, int fr, int fq) const {
        const int row0 = u.pm * BM + wr * 64 + fr; const int col0 = u.pn * BM + wc * 32 + 8 * fq;
        const bool nrm = (u.pn >= 6 && u.pn <= 8);
#pragma unroll
        for (int ai = 0; ai < 2; ++ai)
#pragma unroll
            for (int m = 0; m < 4; ++m) { const int row = row0 + ai * HALF + m * 16; bf16_t* rowp = O + (size_t)row * ldc + col0; float ss = 0.f;
#pragma unroll
                for (int bj = 0; bj < 2; ++bj) { const f32x4 v0 = acc[ai][bj][m][0], v1 = acc[ai][bj][m][1];
                    if (bj == 1 || u.pn != 6) ss += (v0[0] * v0[0] + v0[1] * v0[1]) + (v0[2] * v0[2] + v0[3] * v0[3]) + (v1[0] * v1[0] + v1[1] * v1[1]) + (v1[2] * v1[2] + v1[3] * v1[3]);
                    u32x4 w; w.x = cvt_pk_bf16(v0[0], v0[1]); w.y = cvt_pk_bf16(v0[2], v0[3]); w.z = cvt_pk_bf16(v1[0], v1[1]); w.w = cvt_pk_bf16(v1[2], v1[3]);
                    *(u32x4*)(rowp + bj * HALF) = w; }
                if (nrm) { ss += sx<16>(ss); ss += sx<32>(ss); if (fq == 0) parts[(size_t)row * 12 + 4 * (u.pn - 6) + wc] = ss; } }
    }
};
struct EpiRms {
    static constexpr bool PERM = true;
    bf16_t* O; const float* parts; int ldc, s0, ns; float inv_k, eps; int pad;
    __device__ __forceinline__ void operator()(const f32x4 (&acc)[2][2][4][2], const Unit& u, int wr, int wc, int fr, int fq) const {
        const int row0 = u.pm * BM + wr * 64 + fr; const int col0 = u.pn * BM + wc * 32 + 8 * fq;
#pragma unroll
        for (int ai = 0; ai < 2; ++ai)
#pragma unroll
            for (int m = 0; m < 4; ++m) { const int row = row0 + ai * HALF + m * 16;
                const f32x4* pp = (const f32x4*)(parts + (size_t)row * 12 + s0); f32x4 a = pp[0]; float ss = (a[0] + a[1]) + (a[2] + a[3]);
                if (ns == 8) { const f32x4 b = pp[1]; ss += (b[0] + b[1]) + (b[2] + b[3]); }
                const float r = rsqrtf(ss * inv_k + eps);
                bf16_t* rowp = O + (size_t)row * ldc + col0;
#pragma unroll
                for (int bj = 0; bj < 2; ++bj) { const f32x4 v0 = acc[ai][bj][m][0] * r, v1 = acc[ai][bj][m][1] * r;
                    u32x4 w; w.x = cvt_pk_bf16(v0[0], v0[1]); w.y = cvt_pk_bf16(v0[2], v0[3]); w.z = cvt_pk_bf16(v1[0], v1[1]); w.w = cvt_pk_bf16(v1[2], v1[3]);
                    *(u32x4*)(rowp + bj * HALF) = w; } }
    }
};
struct EpiResid {
    static constexpr bool PERM = true;
    const float* XF; const bf16_t* XH; bf16_t* Y; int ldc; float alpha;
    __device__ __forceinline__ void operator()(const f32x4 (&acc)[2][2][4][2], const Unit& u, int wr, int wc, int fr, int fq) const {
        const int col0 = u.pn * BM + wc * 32 + 8 * fq; float al = alpha; asm volatile("" : "+v"(al));
#pragma unroll
        for (int ai = 0; ai < 2; ++ai)
#pragma unroll
            for (int m = 0; m < 4; ++m) { const size_t off = (size_t)(u.pm * BM + ai * HALF + wr * 64 + m * 16 + fr) * ldc + col0;
#pragma unroll
                for (int bj = 0; bj < 2; ++bj) { f32x4 x0, x1;
                    if (XF) { x0 = *(const f32x4*)(XF + off + bj * HALF); x1 = *(const f32x4*)(XF + off + bj * HALF + 4); }
                    else { const u32x4 h = *(const u32x4*)(XH + off + bj * HALF);
                        x0 = (f32x4){__uint_as_float(h.x << 16), __uint_as_float(h.x & 0xffff0000u), __uint_as_float(h.y << 16), __uint_as_float(h.y & 0xffff0000u)};
                        x1 = (f32x4){__uint_as_float(h.z << 16), __uint_as_float(h.z & 0xffff0000u), __uint_as_float(h.w << 16), __uint_as_float(h.w & 0xffff0000u)}; }
                    const f32x4 v0 = x0 * al + acc[ai][bj][m][0], v1 = x1 * al + acc[ai][bj][m][1];
                    u32x4 w; w.x = cvt_pk_bf16(v0[0], v0[1]); w.y = cvt_pk_bf16(v0[2], v0[3]); w.z = cvt_pk_bf16(v1[0], v1[1]); w.w = cvt_pk_bf16(v1[2], v1[3]);
                    *(u32x4*)(Y + off + bj * HALF) = w; } }
    }
};

template <class Epi, class Sched, bool ALIGN_EPI, bool GATHER>
__device__ __forceinline__ void gemm_phase(LAS unsigned char* lds, const Gemm g, const Sched& S, const Epi& E) {
    const int tid = tidx(), wid = __builtin_amdgcn_readfirstlane(tid >> 6), lane = tid & 63, wr = wid >> 2, wc = wid & 3, fr = lane & 15, fq = lane >> 4;
    int nt = g.K / BK; asm volatile("" : "+s"(nt));
    unsigned voffA[2], voffB[2]; int RA[2];
#pragma unroll
    for (int i = 0; i < 2; ++i) { int R, C; stage_rc(tid * 16 + i * 8192, R, C); const int Rb = Epi::PERM ? ((R & ~31) + perm32(R & 31)) : R;
        RA[i] = R; voffA[i] = GATHER ? (unsigned)C * 2u : (unsigned)(R * g.lda + C) * 2u; voffB[i] = (unsigned)(Rb * g.ldb + C) * 2u; }
    const size_t kstep = (size_t)(BK * 2);
    const size_t hstepA = GATHER ? (size_t)0 : (size_t)HALF * g.lda * 2, hstepB = (size_t)HALF * g.ldb * 2;
    const unsigned ldsw = (unsigned)wid * 1024u;
    const int aoff = lds_byte(wr * 64 + fr, fq * 8), boff = lds_byte(wc * 32 + fr, fq * 8);
#define PG8_SA(b, h) (((b) * 2 + (h)) * HTB)
#define PG8_SB(b, h) ((4 + (b) * 2 + (h)) * HTB)
#define PG8_STAGE(bufoff, gbase, voff) do { _Pragma("unroll") for (int _i = 0; _i < 2; ++_i) \
        __builtin_amdgcn_global_load_lds((const unsigned*)((const char*)(gbase) + (voff)[_i]), (LAS unsigned*)(lds + (bufoff) + ldsw + _i * 8192), 16, 0, 0); } while (0)
#define PG8_STAGE_A(bufoff, gbase, h, vg) do { _Pragma("unroll") for (int _i = 0; _i < 2; ++_i) \
        __builtin_amdgcn_global_load_lds((const unsigned*)((const char*)(gbase) + (GATHER ? (size_t)0 : (h) * hstepA) + (GATHER ? (vg)[h][_i] : voffA[_i])), (LAS unsigned*)(lds + (bufoff) + ldsw + _i * 8192), 16, 0, 0); } while (0)
#define PG8_GOFF(vg, u) do { if (GATHER) { _Pragma("unroll") for (int _h = 0; _h < 2; ++_h) _Pragma("unroll") for (int _i = 0; _i < 2; ++_i) (vg)[_h][_i] = S.rowoff(u, _h * HALF + RA[_i]) + voffA[_i]; } } while (0)
#define PG8_LDA(dst, b, h) do { _Pragma("unroll") for (int m = 0; m < 4; ++m) _Pragma("unroll") for (int k = 0; k < 2; ++k) dst[m][k] = *(const LAS bf16x8*)(lds + PG8_SA(b, h) + aoff + m * 2048 + k * 1024); } while (0)
#define PG8_LDB(dst, b, h) do { _Pragma("unroll") for (int n = 0; n < 2; ++n) _Pragma("unroll") for (int k = 0; k < 2; ++k) dst[n][k] = *(const LAS bf16x8*)(lds + PG8_SB(b, h) + boff + n * 2048 + k * 1024); } while (0)
#define PG8_MMA(ai, bj, At, Bt) do { __builtin_amdgcn_s_setprio(1); _Pragma("unroll") for (int m = 0; m < 4; ++m) _Pragma("unroll") for (int n = 0; n < 2; ++n) _Pragma("unroll") for (int k = 0; k < 2; ++k) \
        acc[ai][bj][m][n] = __builtin_amdgcn_mfma_f32_16x16x32_bf16(Bt[n][k], At[m][k], acc[ai][bj][m][n], 0, 0, 0); __builtin_amdgcn_s_setprio(0); } while (0)
#define PG8_WAIT_V(n) asm volatile("s_waitcnt vmcnt(" #n ")" ::: "memory")
#define PG8_WAIT_L(n) asm volatile("s_waitcnt lgkmcnt(" #n ")" ::: "memory")
#define PG8_BAR __builtin_amdgcn_s_barrier()
#define PG8_SCHED __builtin_amdgcn_sched_barrier(0)
    Unit cur, nxt; int ui = 0;
    if (!S.next(0, cur)) return;
    f32x4 acc[2][2][4][2];
#pragma unroll
    for (int a = 0; a < 2; ++a)
#pragma unroll
        for (int b = 0; b < 2; ++b)
#pragma unroll
            for (int m = 0; m < 4; ++m)
#pragma unroll
                for (int n = 0; n < 2; ++n) acc[a][b][m][n] = (f32x4){0.f, 0.f, 0.f, 0.f};
    bf16x8 At[4][2], B0[2][2], B1[2][2];
    const char* cA = cur.pA; const char* cB = cur.pB;
    unsigned vgc[2][2] = {{0u, 0u}, {0u, 0u}};
    PG8_GOFF(vgc, cur);
    PG8_STAGE(PG8_SB(0, 0), cB, voffB); PG8_STAGE(PG8_SB(0, 1), cB + hstepB, voffB); PG8_STAGE_A(PG8_SA(0, 0), cA, 0, vgc); PG8_STAGE_A(PG8_SA(0, 1), cA, 1, vgc);
    if (wr == 1) PG8_BAR;
    PG8_WAIT_V(2); PG8_BAR;
    PG8_STAGE(PG8_SB(1, 0), cB + kstep, voffB); PG8_STAGE_A(PG8_SA(1, 0), cA + kstep, 0, vgc); PG8_STAGE(PG8_SB(1, 1), cB + hstepB + kstep, voffB);
    PG8_WAIT_V(6); PG8_BAR;
    for (;;) {
        const bool has_next = S.next(ui + 1, nxt);
        const char* nA = has_next ? nxt.pA : cA; const char* nB = has_next ? nxt.pB : cB;

#pragma unroll 1
        for (int t = 0; t < nt; t += 2) {
            const bool last = (t == nt - 2);
            const char* a1 = cA + (size_t)(t + 1) * kstep;
            const char* a2 = last ? nA : cA + (size_t)(t + 2) * kstep; const char* b2 = last ? nB : cB + (size_t)(t + 2) * kstep;
            const char* a3 = a2 + kstep; const char* b3 = b2 + kstep;
            unsigned vgn[2][2] = {{0u, 0u}, {0u, 0u}};
            if (GATHER) { if (last && has_next) { PG8_GOFF(vgn, nxt); PG8_SCHED; } }
            PG8_LDB(B0, 0, 0); PG8_LDB(B1, 0, 1); PG8_SCHED; PG8_LDA(At, 0, 0); PG8_STAGE_A(PG8_SA(1, 1), a1, 1, vgc);
            if (GATHER) { if (last && has_next) {
#pragma unroll
                for (int _h = 0; _h < 2; ++_h) { vgc[_h][0] = vgn[_h][0]; vgc[_h][1] = vgn[_h][1]; } } }
            PG8_WAIT_V(8); PG8_WAIT_L(0); PG8_BAR; PG8_MMA(0, 0, At, B0); PG8_MMA(0, 1, At, B1); PG8_BAR; PG8_SCHED;
            PG8_LDA(At, 0, 1); PG8_STAGE(PG8_SB(0, 0), b2, voffB); PG8_STAGE(PG8_SB(0, 1), b2 + hstepB, voffB); PG8_STAGE_A(PG8_SA(0, 0), a2, 0, vgc);
            PG8_WAIT_V(8); PG8_WAIT_L(0); PG8_BAR; PG8_MMA(1, 0, At, B0); PG8_MMA(1, 1, At, B1); PG8_BAR; PG8_SCHED;
            PG8_LDB(B0, 1, 0); PG8_LDB(B1, 1, 1); PG8_SCHED; PG8_LDA(At, 1, 0); PG8_STAGE_A(PG8_SA(0, 1), a2, 1, vgc);
            PG8_WAIT_V(8); PG8_WAIT_L(0); PG8_BAR; PG8_MMA(0, 0, At, B0); PG8_MMA(0, 1, At, B1); PG8_BAR; PG8_SCHED;
            PG8_LDA(At, 1, 1); PG8_STAGE(PG8_SB(1, 0), b3, voffB); PG8_STAGE(PG8_SB(1, 1), b3 + hstepB, voffB); PG8_STAGE_A(PG8_SA(1, 0), a3, 0, vgc);
            PG8_WAIT_V(8); PG8_WAIT_L(0); PG8_BAR; PG8_MMA(1, 0, At, B0); PG8_MMA(1, 1, At, B1); PG8_BAR; PG8_SCHED;
        }
        if constexpr (ALIGN_EPI) { if (wr == 0) PG8_BAR; }
        E(acc, cur, wr, wc, fr, fq);
        if (!has_next) break;
#pragma unroll
        for (int a = 0; a < 2; ++a)
#pragma unroll
            for (int b = 0; b < 2; ++b)
#pragma unroll
                for (int m = 0; m < 4; ++m)
#pragma unroll
                    for (int n = 0; n < 2; ++n) acc[a][b][m][n] = (f32x4){0.f, 0.f, 0.f, 0.f};
        cur = nxt; cA = nA; cB = nB; ++ui;

        if constexpr (ALIGN_EPI) { if (wr == 1) PG8_BAR; }
    }
    PG8_WAIT_V(0);
    if constexpr (!ALIGN_EPI) { if (wr == 0) PG8_BAR; }
    PG8_BAR;
#undef PG8_SA
#undef PG8_SB
#undef PG8_STAGE
#undef PG8_STAGE_A
#undef PG8_GOFF
#undef PG8_LDA
#undef PG8_LDB
#undef PG8_MMA
#undef PG8_WAIT_V
#undef PG8_WAIT_L
#undef PG8_BAR
#undef PG8_SCHED
}
}
__device__ __forceinline__ void p0_transpose_item(const float* __restrict__ W, int K, int N, bf16_t* WT, int row_off, LAS float* scr, int kb, int nb, int lane, const float* __restrict__ kscale) {
    const int k0 = 64 * kb, n0 = 32 * nb;
    float wv[32];
#pragma unroll
    for (int i = 0; i < 32; ++i) { const int kk = 2 * i + (lane >> 5); wv[i] = W[(size_t)(k0 + kk) * N + n0 + (lane & 31)]; }
#pragma unroll
    for (int i = 0; i < 32; ++i) { const int kk = 2 * i + (lane >> 5); float w = wv[i]; if (kscale) w *= kscale[k0 + kk]; scr[kk * 33 + (lane & 31)] = w; }
    LDS_WAIT(); asm volatile("" ::: "memory");
    const int c = lane & 7;
#pragma unroll
    for (int j = 0; j < 4; ++j) { const int n = (lane >> 3) + 8 * j; const LAS float* s = scr + (8 * c) * 33 + n;
        u32x4 o; o.x = pk2(s[0 * 33], s[1 * 33]); o.y = pk2(s[2 * 33], s[3 * 33]); o.z = pk2(s[4 * 33], s[5 * 33]); o.w = pk2(s[6 * 33], s[7 * 33]);
        *(u32x4*)(WT + (size_t)(row_off + n0 + n) * K + k0 + 8 * c) = o; }
    LDS_WAIT(); asm volatile("" ::: "memory");
}
__device__ __forceinline__ void p0_convert(const float* W, int K, int N, bf16_t* WT, LAS float* scr, int gw, int NGW, int lane, const float* kscale, int rowmap) {
    const int nblk = N / 32, nitems = (K / 64) * nblk;
    for (int it = gw; it < nitems; it += NGW) { const int kb = it / nblk, nb = it % nblk; int row_off = 0;
        if (rowmap == 1) { const int c0 = nb * 32; const int cc = (c0 < 256) ? c0 : c0 - 256; const int pn = cc >> 7, j = (cc & 127) + ((c0 < 256) ? 0 : 128); row_off = (256 * pn + j) - c0; }
        p0_transpose_item(W, K, N, WT, row_off, scr, kb, nb, lane, kscale); }
}
__device__ __forceinline__ void p0_zero_rows(bf16_t* WT, int K, int r0, int r1, int gtid, int NGT) {
    const size_t n16 = (size_t)(r1 - r0) * K * 2 / 16; u32x4* p = (u32x4*)(WT + (size_t)r0 * K);
    for (size_t i = gtid; i < n16; i += NGT) p[i] = (u32x4){0u, 0u, 0u, 0u};
}
struct P0Args { const float *x, *w_in, *qn_w, *kvn_w, *w_uq, *w_ukv, *w_out; unsigned char* ws; };
__device__ __forceinline__ void p0_experts(const float* wgu_l, const float* wd_l, unsigned char* ws, LAS float* scr, int gw, int NGW, int lane) {
    for (int it = gw; it < NEXP * 384; it += NGW) {
        if (it < NEXP * 256) { const int e = it >> 8, r = it & 255, kb = r >> 4, nb = r & 15; const int c0 = nb * 32; const int cc = (c0 < 256) ? c0 : c0 - 256; const int row_off = (256 * (cc >> 7) + (cc & 127) + ((c0 < 256) ? 0 : 128)) - c0;
            p0_transpose_item(wgu_l + (size_t)e * DM * 512, DM, 512, (bf16_t*)(ws + WS_WGU) + (size_t)e * 512 * DM, row_off, scr, kb, nb, lane, nullptr); }
        else { const int i2 = it - NEXP * 256; const int e = i2 >> 7, r = i2 & 127, kb = r >> 5, nb = r & 31;
            p0_transpose_item(wd_l + (size_t)e * DEXP * DM, DEXP, DM, (bf16_t*)(ws + WS_WD) + (size_t)e * DM * DEXP, 0, scr, kb, nb, lane, nullptr); }
    }
}
__device__ __forceinline__ void p0_all(const P0Args& a, LAS unsigned char* lds, int vcu, int G) {
    const int tid = tidx(), lane = tid & 63, wave = tid >> 6;
    LAS float* scr = (LAS float*)(lds + wave * 16384);
    const int gw = vcu * 8 + wave, NGW = G * 8, gtid = vcu * 512 + tid, NGT = G * 512;
    for (int l = 0; l < DEPTH; ++l) {
        bf16_t* win_t = (bf16_t*)(a.ws + WS_WIN) + (size_t)l * NPP * DM;
        p0_convert(a.w_in + (size_t)l * DM * NP, DM, NP, win_t, scr, gw, NGW, lane, nullptr, 0);
        p0_zero_rows(win_t, DM, NP, NPP, gtid, NGT);
        bf16_t* wuq_t = (bf16_t*)(a.ws + WS_WUQ) + (size_t)l * NQMP * 384;
        p0_convert(a.w_uq + (size_t)l * 384 * NQM, 384, NQM, wuq_t, scr, gw, NGW, lane, a.qn_w + l * 384, 0);
        p0_zero_rows(wuq_t, 384, NQM, NQMP, gtid, NGT);
        p0_convert(a.w_ukv + (size_t)l * 256 * NKVM, 256, NKVM, (bf16_t*)(a.ws + WS_WUKV) + (size_t)l * NKVM * 256, scr, gw, NGW, lane, a.kvn_w + l * 256, 0);
        p0_convert(a.w_out + (size_t)l * DM * DM, DM, DM, (bf16_t*)(a.ws + WS_WOUT) + (size_t)l * DM * DM, scr, gw, NGW, lane, nullptr, 0);
    }
    { const f32x4* xs = (const f32x4*)a.x; u32x2* xb = (u32x2*)(a.ws + WS_R0); const size_t n4 = (size_t)TOK * DM / 4;
      for (size_t i = gtid; i < n4; i += NGT) { const f32x4 v = xs[i]; u32x2 o; o.x = pk2(v[0], v[1]); o.y = pk2(v[2], v[3]); xb[i] = o; } }
    { float2* tr = (float2*)(a.ws + WS_TABR); float2* tm = (float2*)(a.ws + WS_TABM);
      for (int idx = gtid; idx < SEQ * 32; idx += NGT) { const int pos = idx >> 5, i = idx & 31;
          const float invf = (float)exp(-log(10000.0) * (double)(2 * i) / 64.0); const double ang = (double)((float)pos * invf);
          tr[idx] = make_float2((float)cos(ang), (float)sin(ang)); }
      for (int idx = gtid; idx < SEQ * 16; idx += NGT) { const int pos = idx >> 4, i = idx & 15;
          const float invf = (float)exp(-log(10000.0) * (double)(2 * i) / 32.0); const double ang = (double)((float)pos * invf);
          tm[idx] = make_float2((float)cos(ang), (float)sin(ang)); } }
}
namespace att {
__device__ __forceinline__ int crow(int r, int hi) { return (r & 3) + 8 * (r >> 2) + 4 * hi; }
#define ATT_SBAR() __builtin_amdgcn_sched_barrier(0)
#define ATT_PIN(x) asm volatile("" : "+v"(x))
#define ATT_WAIT_BAR0() asm volatile("s_waitcnt vmcnt(0) lgkmcnt(0)\n\ts_barrier" ::: "memory")
constexpr int KSLOT = 12288, VSLOT = 8192, NKS = 4, NVS = 3;
constexpr int LDS_K = 0, LDS_V = NKS * KSLOT, LDS_WS = LDS_V + NVS * VSLOT, LDS_OST = LDS_WS + 8 * 256, LDS_BYTES = LDS_OST + 8 * 4096;
__device__ __forceinline__ void glds16(const void* gsrc, unsigned lds_dst) { unsigned keep;
  asm volatile("s_mov_b32 %0, m0\n\ts_mov_b32 m0, %2\n\ts_nop 0\n\tglobal_load_lds_dwordx4 %1, off\n\ts_mov_b32 m0, %0" : "=&s"(keep) : "v"(gsrc), "s"(lds_dst) : "memory"); }
__device__ __forceinline__ float max3f(float a, float b, float c) { float r; asm("v_max3_f32 %0, %1, %2, %3" : "=v"(r) : "v"(a), "v"(b), "v"(c)); return r; }
__device__ __forceinline__ float rowmax(const f32x16& p0, const f32x16& p1) {
  float a = max3f(p0[0], p0[1], p1[0]), b = max3f(p0[2], p0[3], p1[1]); a = max3f(a, p1[2], p1[3]);
#pragma unroll
  for (int r = 4; r < 16; r += 4) { a = max3f(a, p0[r], p0[r + 1]); b = max3f(b, p0[r + 2], p0[r + 3]); a = max3f(a, p1[r], p1[r + 1]); b = max3f(b, p1[r + 2], p1[r + 3]); }
  const float m = fmaxf(a, b);
  auto rr = __builtin_amdgcn_permlane32_swap(__float_as_uint(m), __float_as_uint(m), false, false);
  return fmaxf(__uint_as_float(rr[0]), __uint_as_float(rr[1]));
}
typedef short s16x4 __attribute__((ext_vector_type(4)));
typedef short v4i16_t __attribute__((ext_vector_type(4)));
__device__ __forceinline__ s16x4 vtr(const LAS char* p) { return __builtin_bit_cast(s16x4, __builtin_amdgcn_ds_read_tr16_b64_v4i16((LAS v4i16_t*)p)); }
__device__ __forceinline__ bf16x8 kfr(const LAS char* p) { return *(const LAS bf16x8*)p; }
template <int NCH>
__device__ __forceinline__ void qkt(f32x16& p0, f32x16& p1, const LAS char* Kslot, const bf16x8* qr, int r32, int hi) {
  const LAS char* kb = Kslot + hi * 1024 + r32 * 16;
#pragma unroll
  for (int d0 = 0; d0 < NCH; ++d0) {
    const bf16x8 b0 = *(const LAS bf16x8*)(kb + d0 * 2048);
    const bf16x8 b1 = *(const LAS bf16x8*)(kb + d0 * 2048 + 512);
    p0 = __builtin_amdgcn_mfma_f32_32x32x16_bf16(b0, qr[d0], p0, 0, 0, 0);
    p1 = __builtin_amdgcn_mfma_f32_32x32x16_bf16(b1, qr[d0], p1, 0, 0, 0);
  }
}
__device__ __forceinline__ void pv(f32x16* o, int vb, bf16x8 pa0, bf16x8 pa1, bf16x8 pa2, bf16x8 pa3) {
#pragma unroll
  for (int d0 = 0; d0 < 2; ++d0) { s16x4 lo[4], hi[4];
#pragma unroll
    for (int ks = 0; ks < 4; ++ks) {
      asm volatile("ds_read_b64_tr_b16 %0,%1 offset:%c2" : "=&v"(lo[ks]) : "v"(vb), "i"(d0 * 4096 + ks * 1024) : "memory");
      asm volatile("ds_read_b64_tr_b16 %0,%1 offset:%c2" : "=&v"(hi[ks]) : "v"(vb), "i"(d0 * 4096 + ks * 1024 + 512) : "memory"); }
    asm volatile("s_waitcnt lgkmcnt(0)" ::: "memory"); ATT_SBAR();
#define ATT_PK(k) (bf16x8){lo[k][0], lo[k][1], lo[k][2], lo[k][3], hi[k][0], hi[k][1], hi[k][2], hi[k][3]}
    o[d0] = __builtin_amdgcn_mfma_f32_32x32x16_bf16(pa0, ATT_PK(0), o[d0], 0, 0, 0);
    o[d0] = __builtin_amdgcn_mfma_f32_32x32x16_bf16(pa1, ATT_PK(1), o[d0], 0, 0, 0);
    o[d0] = __builtin_amdgcn_mfma_f32_32x32x16_bf16(pa2, ATT_PK(2), o[d0], 0, 0, 0);
    o[d0] = __builtin_amdgcn_mfma_f32_32x32x16_bf16(pa3, ATT_PK(3), o[d0], 0, 0, 0);
#undef ATT_PK
  }
}
struct AttnPtrs { const bf16_t* proj; const bf16_t* qm; const bf16_t* kvm; const bf16_t* kpe; const float2* tabm; const float* sinks; bf16_t* concat; };

template <int MODE>
__device__ __forceinline__ void attn_unit(const AttnPtrs& P, int b, int h, int qb, LAS char* shm) {
  constexpr int NCH = (MODE == 0) ? 6 : 4;
  constexpr float THR = 8.0f;
  const int tid = tidx(), lane = tid & 63, r32 = lane & 31, hi = lane >> 5; const int wid = __builtin_amdgcn_readfirstlane(tid >> 6);
  const long rowbase = (long)b * SEQ; const int q0 = qb * 256;
  const unsigned lds0 = (unsigned)(uintptr_t)shm;
  LAS float* wsf = (LAS float*)(shm + LDS_WS) + wid * 64;
  const bf16_t *Qp, *Kp, *Vp; int ldq, ldk; bf16_t* Op;
  if (MODE == 0) { Qp = P.qm + h * 96; ldq = NQMP; Kp = P.kvm + h * 128; Vp = P.kvm + h * 128 + 64; ldk = NKVM; Op = P.concat + 640 + h * 64; }
  else { Qp = P.proj + O_SQ + h * 64; ldq = NPP; Kp = P.proj + O_SK + (h / 3) * 64; Vp = P.proj + O_SV + (h / 3) * 64; ldk = NPP; Op = P.concat + 256 + h * 64; }
  const bf16_t* ksrc = Kp + (rowbase + lane) * ldk + wid * 8;
  const bf16_t* krsrc = P.kpe + (rowbase + lane) * 32 + (wid & 3) * 8;
  const bf16_t* vsrc = Vp + (rowbase + 16 * (wid & 3) + (lane >> 2)) * ldk + (wid >> 2) * 32 + (lane & 3) * 8;
  const unsigned kdst = lds0 + LDS_K + wid * 1024, krdst = lds0 + LDS_K + (8 + (wid & 3)) * 1024, vdst = lds0 + LDS_V + wid * 1024;
#define ATT_DMA_K(t, s) do { glds16(ksrc + (long)(t) * 64 * ldk, (unsigned)__builtin_amdgcn_readfirstlane(kdst + (s) * KSLOT)); \
    if (MODE == 0 && wid < 4) glds16(krsrc + (long)(t) * 64 * 32, (unsigned)__builtin_amdgcn_readfirstlane(krdst + (s) * KSLOT)); } while (0)
#define ATT_DMA_V(t, s) glds16(vsrc + (long)(t) * 64 * ldk, (unsigned)__builtin_amdgcn_readfirstlane(vdst + (s) * VSLOT))
  const LAS char* kp0 = shm + LDS_K + hi * 1024 + r32 * 16;
  const LAS char* vp0 = shm + LDS_V + ((lane >> 4) & 1) * 32 + (lane & 3) * 8 + (4 * hi + ((lane & 15) >> 2)) * 64;
  int t_lo, t_hi;
  if (MODE == 0) { t_lo = 0; t_hi = (q0 + 256) / 64; } else { t_lo = q0 / 64 - 2; if (t_lo < 0) t_lo = 0; t_hi = q0 / 64 + 4; }
  ATT_DMA_K(t_lo, 0); ATT_DMA_V(t_lo, 0); ATT_DMA_K(t_lo + 1, 1); ATT_DMA_K(t_lo + 2, 2);
  const int qpos = q0 + wid * 32 + r32;
  bf16x8 qr[NCH];
  { float c2 = (MODE == 0 ? 0.10206207261596575f : 0.125f) * LOG2E; asm volatile("" : "+v"(c2));
    const bf16_t* qrow = Qp + (rowbase + qpos) * ldq + hi * 8;
    constexpr int NPLAIN = (MODE == 0) ? NCH - 2 : NCH;
#pragma unroll
    for (int d0 = 0; d0 < NPLAIN; ++d0) { const bf16x8 v = *reinterpret_cast<const bf16x8*>(qrow + d0 * 16); float q8[8];
#pragma unroll
      for (int j = 0; j < 8; ++j) q8[j] = bf2f((bf16_t)v[j]) * c2;
      u32x4 w; w.x = cvt_pk_bf16(q8[0], q8[1]); w.y = cvt_pk_bf16(q8[2], q8[3]); w.z = cvt_pk_bf16(q8[4], q8[5]); w.w = cvt_pk_bf16(q8[6], q8[7]);
      qr[d0] = __builtin_bit_cast(bf16x8, w); }
    if (MODE == 0) {
      const bf16x8 va = *reinterpret_cast<const bf16x8*>(qrow + (NCH - 2) * 16), vb = *reinterpret_cast<const bf16x8*>(qrow + (NCH - 1) * 16);
      const float2* tb = P.tabm + qpos * 16 + hi * 8; float qa[8], qb8[8];
#pragma unroll
      for (int j = 0; j < 8; ++j) { const float2 cs = tb[j]; const float x1 = bf2f((bf16_t)va[j]), x2 = bf2f((bf16_t)vb[j]); qa[j] = (x1 * cs.x - x2 * cs.y) * c2; qb8[j] = (x1 * cs.y + x2 * cs.x) * c2; }
      u32x4 w; w.x = cvt_pk_bf16(qa[0], qa[1]); w.y = cvt_pk_bf16(qa[2], qa[3]); w.z = cvt_pk_bf16(qa[4], qa[5]); w.w = cvt_pk_bf16(qa[6], qa[7]);
      qr[NCH - 2] = __builtin_bit_cast(bf16x8, w);
      w.x = cvt_pk_bf16(qb8[0], qb8[1]); w.y = cvt_pk_bf16(qb8[2], qb8[3]); w.z = cvt_pk_bf16(qb8[4], qb8[5]); w.w = cvt_pk_bf16(qb8[6], qb8[7]);
      qr[NCH - 1] = __builtin_bit_cast(bf16x8, w); }
  }
  float mhat, l_run;
  if (MODE == 0) { mhat = 0.f; l_run = 0.f; } else { mhat = P.sinks[h] * LOG2E; l_run = (hi == 0) ? 1.f : 0.f; }
  f32x16 negm;
#pragma unroll
  for (int r = 0; r < 16; ++r) negm[r] = -mhat;
  f32x16 o[2]; o[0] = f32x16{}; o[1] = f32x16{};
  ATT_WAIT_BAR0();
  f32x16 pA0, pA1, pB0, pB1; u32x4 pw0, pw1, pw2, pw3; s16x4 vlo[8], vhi[8];
  int r0 = 0, r1 = 1, r2 = 2;
  int k0s = 0, k1s = 1, k2s = 2, k3s = 3;
  bf16x8 ka, kb, kc, kd;
  ka = kfr(kp0); kb = kfr(kp0 + 512); kc = kfr(kp0 + 2048); kd = kfr(kp0 + 2560);
  bool resc = false; float fsc = 1.f;

#define ATT_PKW(X, B) cvt_pk_bf16(X[B], X[(B) + 1])
#define ATT_MF(D, KF, QF, C) D = __builtin_amdgcn_mfma_f32_32x32x16_bf16(KF, QF, C, 0, 0, 0)
#define ATT_MF1(D, KF, QF) asm volatile("v_mfma_f32_32x32x16_bf16 %0, %1, %2, %3" : "=&v"(D) : "v"(KF), "v"(QF), "v"(negm))
#define ATT_VRD(i) do { vlo[i] = vtr(vp_ + (((i) >> 2) * 4096 + ((i) & 3) * 1024)); vhi[i] = vtr(vp_ + (((i) >> 2) * 4096 + ((i) & 3) * 1024 + 512)); } while (0)
#define ATT_VFR(i) (bf16x8){vlo[i][0], vlo[i][1], vlo[i][2], vlo[i][3], vhi[i][0], vhi[i][1], vhi[i][2], vhi[i][3]}
#define ATT_PAF(k) __builtin_bit_cast(bf16x8, pw##k)
#define ATT_KF(i) kfr(kp_ + ((i) >> 1) * 2048 + ((i) & 1) * 512)
#define ATT_PHASE_A(S0, S1, PP0, PP1, FILL) do { \
    const LAS char* kp_ = kp0 + k0s * KSLOT; const LAS char* vp_ = vp0 + r2 * VSLOT; float sacc = 0.f; \
    if (FILL) { ATT_VRD(0); } ATT_SBAR(); \
    ATT_MF1(S0, ka, qr[0]); if (FILL) { sacc = PP0[0] + PP0[1]; sacc += PP0[2]; sacc += PP0[3]; ATT_PIN(sacc); pw0[0] = ATT_PKW(PP0, 0); ATT_VRD(4); } ka = ATT_KF(4); ATT_SBAR(); \
    ATT_MF1(S1, kb, qr[0]); if (FILL) { sacc += PP0[4]; sacc += PP0[5]; sacc += PP0[6]; ATT_PIN(sacc); pw0[1] = ATT_PKW(PP0, 2); ATT_VRD(1); } kb = ATT_KF(5); ATT_SBAR(); \
    ATT_MF(S0, kc, qr[1], S0); if (FILL) { sacc += PP0[7]; sacc += PP0[8]; sacc += PP0[9]; ATT_PIN(sacc); pw0[2] = ATT_PKW(PP0, 4); ATT_VRD(5); } kc = ATT_KF(6); ATT_SBAR(); \
    ATT_MF(S1, kd, qr[1], S1); if (FILL) { sacc += PP0[10]; sacc += PP0[11]; sacc += PP0[12]; ATT_PIN(sacc); pw0[3] = ATT_PKW(PP0, 6); ATT_PIN(pw0); ATT_VRD(2); } kd = ATT_KF(7); ATT_SBAR(); \
    ATT_MF(S0, ka, qr[2], S0); if (FILL) { sacc += PP0[13]; sacc += PP0[14]; sacc += PP0[15]; ATT_PIN(sacc); pw1[0] = ATT_PKW(PP0, 8); pw1[1] = ATT_PKW(PP0, 10); ATT_VRD(6); } if (NCH == 6) ka = ATT_KF(8); ATT_SBAR(); \
    ATT_MF(S1, kb, qr[2], S1); if (FILL) { sacc += PP1[0]; sacc += PP1[1]; sacc += PP1[2]; ATT_PIN(sacc); pw1[2] = ATT_PKW(PP0, 12); pw1[3] = ATT_PKW(PP0, 14); ATT_PIN(pw1); ATT_VRD(3); } if (NCH == 6) kb = ATT_KF(9); ATT_SBAR(); \
    ATT_MF(S0, kc, qr[3], S0); if (FILL) { sacc += PP1[3]; sacc += PP1[4]; sacc += PP1[5]; ATT_PIN(sacc); pw2[0] = ATT_PKW(PP1, 0); ATT_VRD(7); } if (NCH == 6) kc = ATT_KF(10); ATT_SBAR(); \
    ATT_MF(S1, kd, qr[3], S1); if (FILL) { sacc += PP1[6]; sacc += PP1[7]; sacc += PP1[8]; ATT_PIN(sacc); pw2[1] = ATT_PKW(PP1, 2); } if (NCH == 6) kd = ATT_KF(11); ATT_SBAR(); \
    if (NCH == 6) { \
      ATT_MF(S0, ka, qr[NCH - 2], S0); if (FILL) { sacc += PP1[9]; sacc += PP1[10]; ATT_PIN(sacc); pw2[2] = ATT_PKW(PP1, 4); pw2[3] = ATT_PKW(PP1, 6); ATT_PIN(pw2); } ATT_SBAR(); \
      ATT_MF(S1, kb, qr[NCH - 2], S1); if (FILL) { sacc += PP1[11]; sacc += PP1[12]; ATT_PIN(sacc); pw3[0] = ATT_PKW(PP1, 8); } ATT_SBAR(); \
      ATT_MF(S0, kc, qr[NCH - 1], S0); if (FILL) { sacc += PP1[13]; sacc += PP1[14]; ATT_PIN(sacc); pw3[1] = ATT_PKW(PP1, 10); pw3[2] = ATT_PKW(PP1, 12); } ATT_SBAR(); \
      ATT_MF(S1, kd, qr[NCH - 1], S1); if (FILL) { sacc += PP1[15]; ATT_PIN(sacc); pw3[3] = ATT_PKW(PP1, 14); ATT_PIN(pw3); } ATT_SBAR(); \
    } else if (FILL) { sacc += PP1[9]; sacc += PP1[10]; sacc += PP1[11]; sacc += PP1[12]; sacc += PP1[13]; sacc += PP1[14]; sacc += PP1[15]; \
      pw2[2] = ATT_PKW(PP1, 4); pw2[3] = ATT_PKW(PP1, 6); pw3[0] = ATT_PKW(PP1, 8); pw3[1] = ATT_PKW(PP1, 10); pw3[2] = ATT_PKW(PP1, 12); pw3[3] = ATT_PKW(PP1, 14); ATT_SBAR(); } \
    l_run += sacc; } while (0)
#define ATT_MID(S0, S1, t, MASKED, FIRST) do { \
    if (MASKED) { const int k0_ = (t) * 64; \
      _Pragma("unroll") for (int r = 0; r < 16; ++r) { const int kv = k0_ + crow(r, hi); \
        bool bad0 = kv > qpos, bad1 = kv + 32 > qpos; \
        if (MODE == 1) { bad0 = bad0 || (kv < qpos - 127); bad1 = bad1 || (kv + 32 < qpos - 127); } \
        S0[r] = bad0 ? -1e30f : S0[r]; S1[r] = bad1 ? -1e30f : S1[r]; } } \
    const float rm_ = rowmax(S0, S1); resc = false; \
    if ((FIRST) || __any(rm_ > THR)) { const float dl = (FIRST) ? rm_ : fmaxf(rm_, 0.f); mhat += dl; \
      _Pragma("unroll") for (int r = 0; r < 16; ++r) { S0[r] -= dl; S1[r] -= dl; } \
      _Pragma("unroll") for (int r = 0; r < 16; ++r) negm[r] = -mhat; \
      if (!(FIRST)) { fsc = __builtin_amdgcn_exp2f(-dl); l_run *= fsc; resc = true; } } \
    ATT_SBAR(); } while (0)
#define ATT_EX4(X, B) do { X[B] = __builtin_amdgcn_exp2f(X[B]); X[(B) + 1] = __builtin_amdgcn_exp2f(X[(B) + 1]); X[(B) + 2] = __builtin_amdgcn_exp2f(X[(B) + 2]); X[(B) + 3] = __builtin_amdgcn_exp2f(X[(B) + 3]); ATT_PIN(X); } while (0)
#define ATT_PHASE_B(S0, S1, HASPV, HASNEXT) do { const LAS char* kn_ = kp0 + k1s * KSLOT; \
    if (HASPV) o[0] = __builtin_amdgcn_mfma_f32_32x32x16_bf16(ATT_PAF(0), ATT_VFR(0), o[0], 0, 0, 0); ATT_EX4(S0, 0); ATT_SBAR(); \
    if (HASPV) o[1] = __builtin_amdgcn_mfma_f32_32x32x16_bf16(ATT_PAF(0), ATT_VFR(4), o[1], 0, 0, 0); ATT_EX4(S0, 4); ATT_SBAR(); \
    if (HASPV) o[0] = __builtin_amdgcn_mfma_f32_32x32x16_bf16(ATT_PAF(1), ATT_VFR(1), o[0], 0, 0, 0); if (HASNEXT) ka = kfr(kn_); ATT_EX4(S0, 8); ATT_SBAR(); \
    if (HASPV) o[1] = __builtin_amdgcn_mfma_f32_32x32x16_bf16(ATT_PAF(1), ATT_VFR(5), o[1], 0, 0, 0); if (HASNEXT) kb = kfr(kn_ + 512); ATT_EX4(S0, 12); ATT_SBAR(); \
    if (HASPV) o[0] = __builtin_amdgcn_mfma_f32_32x32x16_bf16(ATT_PAF(2), ATT_VFR(2), o[0], 0, 0, 0); if (HASNEXT) kc = kfr(kn_ + 2048); ATT_EX4(S1, 0); ATT_SBAR(); \
    if (HASPV) o[1] = __builtin_amdgcn_mfma_f32_32x32x16_bf16(ATT_PAF(2), ATT_VFR(6), o[1], 0, 0, 0); if (HASNEXT) kd = kfr(kn_ + 2560); ATT_EX4(S1, 4); ATT_SBAR(); \
    if (HASPV) o[0] = __builtin_amdgcn_mfma_f32_32x32x16_bf16(ATT_PAF(3), ATT_VFR(3), o[0], 0, 0, 0); ATT_EX4(S1, 8); ATT_SBAR(); \
    if (HASPV) o[1] = __builtin_amdgcn_mfma_f32_32x32x16_bf16(ATT_PAF(3), ATT_VFR(7), o[1], 0, 0, 0); ATT_EX4(S1, 12); ATT_SBAR(); \
    if (resc) { if (hi == 0) wsf[r32] = fsc; \
      _Pragma("unroll") for (int r = 0; r < 16; ++r) { const float g = wsf[crow(r, hi)]; o[0][r] *= g; o[1][r] *= g; } } } while (0)
#define ATT_STEP(S0, S1, PP0, PP1, t, MASKED, FIRST, COUNTED, HASNEXT) do { \
    if ((t) + 3 < t_hi) ATT_DMA_K((t) + 3, k3s);           \
    if ((t) + 1 < t_hi) ATT_DMA_V((t) + 1, r1);            \
    ATT_PHASE_A(S0, S1, PP0, PP1, !(FIRST)); \
    ATT_MID(S0, S1, t, MASKED, (FIRST) && (MODE == 0)); \
    ATT_PHASE_B(S0, S1, !(FIRST), HASNEXT); \
      \
    if (COUNTED) { if (MODE == 0 && wid < 4) asm volatile("s_waitcnt vmcnt(3) lgkmcnt(0)\n\ts_barrier" ::: "memory"); else asm volatile("s_waitcnt vmcnt(2) lgkmcnt(0)\n\ts_barrier" ::: "memory"); } \
    else ATT_WAIT_BAR0(); \
    { const int tmp_ = r0; r0 = r1; r1 = r2; r2 = tmp_; const int tk_ = k0s; k0s = k1s; k1s = k2s; k2s = k3s; k3s = tk_; } } while (0)

  int t = t_lo;
  ATT_STEP(pA0, pA1, pB0, pB1, t, true, true, false, true); ++t;
  if (MODE == 0) {
    if (t + 4 < t_hi) { ATT_STEP(pB0, pB1, pA0, pA1, t, false, false, true, true); ++t; }
    for (; t + 4 < t_hi; t += 2) { ATT_STEP(pA0, pA1, pB0, pB1, t, false, false, true, true); ATT_STEP(pB0, pB1, pA0, pA1, t + 1, false, false, true, true); }
    if (t_hi > 4) { ATT_STEP(pA0, pA1, pB0, pB1, t, true, false, false, true); ++t; }
  } else {
    if (t_hi - t_lo > 4) { ATT_STEP(pB0, pB1, pA0, pA1, t, true, false, false, true); ATT_STEP(pA0, pA1, pB0, pB1, t + 1, true, false, false, true); t += 2; }
  }
  ATT_STEP(pB0, pB1, pA0, pA1, t, true, false, false, true); ATT_STEP(pA0, pA1, pB0, pB1, t + 1, true, false, false, true); ATT_STEP(pB0, pB1, pA0, pA1, t + 2, true, false, false, false);
  { const LAS char* vp_ = vp0 + r2 * VSLOT; float sacc = 0.f;
#pragma unroll
    for (int i = 0; i < 8; ++i) { vlo[i] = vtr(vp_ + ((i >> 2) * 4096 + (i & 3) * 1024)); vhi[i] = vtr(vp_ + ((i >> 2) * 4096 + (i & 3) * 1024 + 512)); }
#pragma unroll
    for (int r = 0; r < 16; ++r) sacc += pB0[r] + pB1[r];
    l_run += sacc;
    pw0 = (u32x4){ATT_PKW(pB0, 0), ATT_PKW(pB0, 2), ATT_PKW(pB0, 4), ATT_PKW(pB0, 6)}; pw1 = (u32x4){ATT_PKW(pB0, 8), ATT_PKW(pB0, 10), ATT_PKW(pB0, 12), ATT_PKW(pB0, 14)};
    pw2 = (u32x4){ATT_PKW(pB1, 0), ATT_PKW(pB1, 2), ATT_PKW(pB1, 4), ATT_PKW(pB1, 6)}; pw3 = (u32x4){ATT_PKW(pB1, 8), ATT_PKW(pB1, 10), ATT_PKW(pB1, 12), ATT_PKW(pB1, 14)};
    o[0] = __builtin_amdgcn_mfma_f32_32x32x16_bf16(ATT_PAF(0), ATT_VFR(0), o[0], 0, 0, 0); o[1] = __builtin_amdgcn_mfma_f32_32x32x16_bf16(ATT_PAF(0), ATT_VFR(4), o[1], 0, 0, 0);
    o[0] = __builtin_amdgcn_mfma_f32_32x32x16_bf16(ATT_PAF(1), ATT_VFR(1), o[0], 0, 0, 0); o[1] = __builtin_amdgcn_mfma_f32_32x32x16_bf16(ATT_PAF(1), ATT_VFR(5), o[1], 0, 0, 0);
    o[0] = __builtin_amdgcn_mfma_f32_32x32x16_bf16(ATT_PAF(2), ATT_VFR(2), o[0], 0, 0, 0); o[1] = __builtin_amdgcn_mfma_f32_32x32x16_bf16(ATT_PAF(2), ATT_VFR(6), o[1], 0, 0, 0);
    o[0] = __builtin_amdgcn_mfma_f32_32x32x16_bf16(ATT_PAF(3), ATT_VFR(3), o[0], 0, 0, 0); o[1] = __builtin_amdgcn_mfma_f32_32x32x16_bf16(ATT_PAF(3), ATT_VFR(7), o[1], 0, 0, 0); }
  { auto rr = __builtin_amdgcn_permlane32_swap(__float_as_uint(l_run), __float_as_uint(l_run), false, false); l_run = __uint_as_float(rr[0]) + __uint_as_float(rr[1]); }
  if (hi == 0) wsf[32 + r32] = l_run;
  float rli[16];
#pragma unroll
  for (int r = 0; r < 16; ++r) rli[r] = 1.0f / wsf[32 + crow(r, hi)];
  bf16_t* Ow = Op + (rowbase + q0 + wid * 32) * DM;
  { LAS bf16_t* stg = (LAS bf16_t*)(shm + LDS_OST) + wid * 2048;
#pragma unroll
    for (int r = 0; r < 16; ++r) { const int orow = crow(r, hi);
#pragma unroll
      for (int d0 = 0; d0 < 2; ++d0) stg[orow * 64 + d0 * 32 + r32] = (bf16_t)f2bf(o[d0][r] * rli[r]); }
#pragma unroll
    for (int i = 0; i < 4; ++i) { const int row = i * 8 + (lane >> 3), ch = lane & 7; const u32x4 v = *(const LAS u32x4*)(stg + row * 64 + ch * 8); *(u32x4*)(Ow + (long)row * DM + ch * 8) = v; } }
  asm volatile("s_waitcnt lgkmcnt(0)\n\ts_barrier" ::: "memory");
#undef ATT_STEP
#undef ATT_PHASE_A
#undef ATT_PHASE_B
#undef ATT_MID
#undef ATT_EX4
#undef ATT_MF
#undef ATT_MF1
#undef ATT_VRD
#undef ATT_VFR
#undef ATT_PAF
#undef ATT_KF
#undef ATT_PKW
#undef ATT_DMA_K
#undef ATT_DMA_V
}
}
namespace ret {
using att::crow; using att::glds16; using att::qkt; using att::pv; using att::s16x4;
struct RetPtrs { const bf16_t* proj; const float2* tabr; const float* gn_w; float* U; bf16_t* concat; };
constexpr int R_V = 0, R_K = 32768, R_ST = 65536, R_STG = 0;
constexpr int ST_PITCH = 72;
__device__ __forceinline__ float gamma_log2(int h) { return log2f(1.0f - exp2f(-5.0f - (float)h)); }

__device__ __forceinline__ void dma_v4(const RetPtrs& P, int b, int h, int cp, unsigned lds0, int wid, int lane) {
  const bf16_t* vsrc = P.proj + ((long)b * SEQ + 256 * cp + 16 * (wid & 3) + (lane >> 2)) * NPP + O_RV + h * 64 + (wid >> 2) * 32 + (lane & 3) * 8;
#pragma unroll
  for (int tt = 0; tt < 4; ++tt) glds16(vsrc + (long)tt * 64 * NPP, (unsigned)__builtin_amdgcn_readfirstlane(lds0 + R_V + tt * 8192 + wid * 1024));
}
__device__ __forceinline__ bf16x8 tr_frag(int vb, int off) { s16x4 lo, hi;
  asm volatile("ds_read_b64_tr_b16 %0,%1" : "=&v"(lo) : "v"(vb + off) : "memory");
  asm volatile("ds_read_b64_tr_b16 %0,%1" : "=&v"(hi) : "v"(vb + off + 512) : "memory");
  asm volatile("s_waitcnt lgkmcnt(0)" : "+v"(lo), "+v"(hi) :: "memory");
  return (bf16x8){lo[0], lo[1], lo[2], lo[3], hi[0], hi[1], hi[2], hi[3]}; }

__device__ __forceinline__ void upd_unit(const RetPtrs& P, int b, int h, int cp, LAS char* shm) {
  const int tid = tidx(), lane = tid & 63, hi = lane >> 5; const int wid = __builtin_amdgcn_readfirstlane(tid >> 6);
  const unsigned lds0 = (unsigned)(uintptr_t)shm;
  const float lg = gamma_log2(h);
  dma_v4(P, b, h, cp, lds0, wid, lane);
#pragma unroll
  for (int it = 0; it < 2; ++it) { const int item = tid + 512 * it, row = item >> 2, c = item & 3; const int pos = 256 * cp + row;
    const bf16_t* src = P.proj + ((long)b * SEQ + pos) * NPP + O_RK + h * 64 + 8 * c;
    const bf16x8 lo = *(const bf16x8*)src, hi8 = *(const bf16x8*)(src + 32);
    const float2* tb = P.tabr + pos * 32 + 8 * c;
    float sc8 = 0.125f; asm volatile("" : "+v"(sc8));
    const float sc = sc8 * exp2f(lg * (float)(127 - (row & 127)));
    float y1[8], y2[8];
#pragma unroll
    for (int j = 0; j < 8; ++j) { const float2 cs = tb[j]; const float x1 = bf2f((bf16_t)lo[j]), x2 = bf2f((bf16_t)hi8[j]); y1[j] = (x1 * cs.x - x2 * cs.y) * sc; y2[j] = (x1 * cs.y + x2 * cs.x) * sc; }
    u32x4 w1, w2; w1.x = cvt_pk_bf16(y1[0], y1[1]); w1.y = cvt_pk_bf16(y1[2], y1[3]); w1.z = cvt_pk_bf16(y1[4], y1[5]); w1.w = cvt_pk_bf16(y1[6], y1[7]);
    w2.x = cvt_pk_bf16(y2[0], y2[1]); w2.y = cvt_pk_bf16(y2[2], y2[3]); w2.z = cvt_pk_bf16(y2[4], y2[5]); w2.w = cvt_pk_bf16(y2[6], y2[7]);
    LAS char* dst = shm + R_K + (row >> 6) * 8192 + (row & 63) * 64 + c * 16;
    *(LAS u32x4*)dst = w1; *(LAS u32x4*)(dst + 4096) = w2; }
  asm volatile("s_waitcnt vmcnt(0) lgkmcnt(0)\n\ts_barrier" ::: "memory");
  const int wg = wid >> 2, dt = (wid >> 1) & 1, et = wid & 1;
  const int vbl = ((lane >> 4) & 1) * 32 + (lane & 3) * 8 + (4 * hi + ((lane & 15) >> 2)) * 64;
  f32x16 acc = f32x16{};
#pragma unroll
  for (int tt = 0; tt < 2; ++tt) { const int tile = 2 * wg + tt;
#pragma unroll
    for (int ks = 0; ks < 4; ++ks) { const bf16x8 a = tr_frag((int)lds0 + R_K + tile * 8192 + vbl, dt * 4096 + ks * 1024), bb = tr_frag((int)lds0 + R_V + tile * 8192 + vbl, et * 4096 + ks * 1024);
      acc = __builtin_amdgcn_mfma_f32_32x32x16_bf16(a, bb, acc, 0, 0, 0); } }
  float* Uo = P.U + ((size_t)((b * 4 + h) * 64 + 2 * cp + wg)) * 4096 + (32 * dt) * 64 + 32 * et + (lane & 31);
#pragma unroll
  for (int r = 0; r < 16; ++r) Uo[crow(r, hi) * 64] = acc[r];
  asm volatile("s_waitcnt lgkmcnt(0)\n\ts_barrier" ::: "memory");
}

__device__ __forceinline__ void out_unit(const RetPtrs& P, int b, int h, int cp, LAS char* shm) {
  const int tid = tidx(), lane = tid & 63, r32 = lane & 31, hi = lane >> 5; const int wid = __builtin_amdgcn_readfirstlane(tid >> 6);
  const unsigned lds0 = (unsigned)(uintptr_t)shm;
  const float lg = gamma_log2(h);
  const long rowbase = (long)b * SEQ;
  dma_v4(P, b, h, cp, lds0, wid, lane);
#pragma unroll
  for (int it = 0; it < 2; ++it) { const int item = tid + 512 * it, row = item >> 2, c = item & 3; const int pos = 256 * cp + row;
    const bf16_t* src = P.proj + (rowbase + pos) * NPP + O_RK + h * 64 + 8 * c;
    const bf16x8 lo = *(const bf16x8*)src, hi8 = *(const bf16x8*)(src + 32);
    const float2* tb = P.tabr + pos * 32 + 8 * c;
    float y1[8], y2[8]; float sc8 = 0.125f; asm volatile("" : "+v"(sc8));
#pragma unroll
    for (int j = 0; j < 8; ++j) { const float2 cs = tb[j]; const float x1 = bf2f((bf16_t)lo[j]), x2 = bf2f((bf16_t)hi8[j]); y1[j] = (x1 * cs.x - x2 * cs.y) * sc8; y2[j] = (x1 * cs.y + x2 * cs.x) * sc8; }
    u32x4 w1, w2; w1.x = cvt_pk_bf16(y1[0], y1[1]); w1.y = cvt_pk_bf16(y1[2], y1[3]); w1.z = cvt_pk_bf16(y1[4], y1[5]); w1.w = cvt_pk_bf16(y1[6], y1[7]);
    w2.x = cvt_pk_bf16(y2[0], y2[1]); w2.y = cvt_pk_bf16(y2[2], y2[3]); w2.z = cvt_pk_bf16(y2[4], y2[5]); w2.w = cvt_pk_bf16(y2[6], y2[7]);
    LAS char* dst = shm + R_K + (row >> 6) * 8192 + c * 1024 + (row & 63) * 16;
    *(LAS u32x4*)dst = w1; *(LAS u32x4*)(dst + 4096) = w2; }
  { const int n0 = 2 * cp; const float cd = exp2f(lg * 128.0f);
    const float* Ub = P.U + (size_t)((b * 4 + h) * 64) * 4096 + tid * 8;
    f32x4 s0a = (f32x4){0.f, 0.f, 0.f, 0.f}, s0b = s0a;
    for (int m = 0; m < n0; ++m) { const f32x4 ua = *(const f32x4*)(Ub + (size_t)m * 4096), ub = *(const f32x4*)(Ub + (size_t)m * 4096 + 4); s0a = s0a * cd + ua; s0b = s0b * cd + ub; }
    const f32x4 ua = *(const f32x4*)(Ub + (size_t)n0 * 4096), ub = *(const f32x4*)(Ub + (size_t)n0 * 4096 + 4);
    const f32x4 s1a = s0a * cd + ua, s1b = s0b * cd + ub;
    const int d = tid >> 3, e0 = (tid & 7) * 8;
    LAS bf16_t* st0 = (LAS bf16_t*)(shm + R_ST), * st1 = st0 + 64 * ST_PITCH;
#pragma unroll
    for (int j = 0; j < 4; ++j) { st0[(e0 + j) * ST_PITCH + d] = (bf16_t)f2bf(s0a[j]); st0[(e0 + 4 + j) * ST_PITCH + d] = (bf16_t)f2bf(s0b[j]);
      st1[(e0 + j) * ST_PITCH + d] = (bf16_t)f2bf(s1a[j]); st1[(e0 + 4 + j) * ST_PITCH + d] = (bf16_t)f2bf(s1b[j]); } }
  const int wg = wid >> 2; const int qi = (wid & 3) * 32 + r32;
  const int qpos = 256 * cp + 128 * wg + qi;
  bf16x8 qr[4], qx[4];
  { const bf16_t* qrow = P.proj + (rowbase + qpos) * NPP + O_RQ + h * 64 + hi * 8;
    float qf[4][8];
#pragma unroll
    for (int d0 = 0; d0 < 4; ++d0) { const bf16x8 v = *(const bf16x8*)(qrow + d0 * 16);
#pragma unroll
      for (int j = 0; j < 8; ++j) qf[d0][j] = bf2f((bf16_t)v[j]); }
#pragma unroll
    for (int d0 = 0; d0 < 2; ++d0) { const float2* tb = P.tabr + qpos * 32 + 16 * d0 + 8 * hi;
#pragma unroll
      for (int j = 0; j < 8; ++j) { const float2 cs = tb[j]; const float x1 = qf[d0][j], x2 = qf[d0 + 2][j]; qf[d0][j] = x1 * cs.x - x2 * cs.y; qf[d0 + 2][j] = x1 * cs.y + x2 * cs.x; } }
    const float xi = exp2f(lg * (float)(qi + 1));
#pragma unroll
    for (int d0 = 0; d0 < 4; ++d0) { u32x4 w, x;
      w.x = cvt_pk_bf16(qf[d0][0], qf[d0][1]); w.y = cvt_pk_bf16(qf[d0][2], qf[d0][3]); w.z = cvt_pk_bf16(qf[d0][4], qf[d0][5]); w.w = cvt_pk_bf16(qf[d0][6], qf[d0][7]);
      x.x = cvt_pk_bf16(qf[d0][0] * xi, qf[d0][1] * xi); x.y = cvt_pk_bf16(qf[d0][2] * xi, qf[d0][3] * xi); x.z = cvt_pk_bf16(qf[d0][4] * xi, qf[d0][5] * xi); x.w = cvt_pk_bf16(qf[d0][6] * xi, qf[d0][7] * xi);
      qr[d0] = __builtin_bit_cast(bf16x8, w); qx[d0] = __builtin_bit_cast(bf16x8, x); } }
  asm volatile("s_waitcnt vmcnt(0) lgkmcnt(0)\n\ts_barrier" ::: "memory");
  f32x16 o[2]; o[0] = f32x16{}; o[1] = f32x16{};
  const int vb0 = (int)(lds0 + R_V) + ((lane >> 4) & 1) * 32 + (lane & 3) * 8 + (4 * hi + ((lane & 15) >> 2)) * 64;
#pragma unroll
  for (int tt = 0; tt < 2; ++tt) {
    if (tt * 64 <= (wid & 3) * 32 + 31) {
      const int tile = 2 * wg + tt;
      f32x16 p0 = f32x16{}, p1 = f32x16{};
      qkt<4>(p0, p1, shm + R_K + tile * 8192, qr, r32, hi);
#pragma unroll
      for (int r = 0; r < 16; ++r) { const int ki = tt * 64 + crow(r, hi);
        const float d0 = (qi >= ki) ? exp2f(lg * (float)(qi - ki)) : 0.f, d1 = (qi >= ki + 32) ? exp2f(lg * (float)(qi - ki - 32)) : 0.f;
        p0[r] *= d0; p1[r] *= d1; }
      u32x4 pw0, pw1, pw2, pw3;
      pw0 = (u32x4){cvt_pk_bf16(p0[0], p0[1]), cvt_pk_bf16(p0[2], p0[3]), cvt_pk_bf16(p0[4], p0[5]), cvt_pk_bf16(p0[6], p0[7])};
      pw1 = (u32x4){cvt_pk_bf16(p0[8], p0[9]), cvt_pk_bf16(p0[10], p0[11]), cvt_pk_bf16(p0[12], p0[13]), cvt_pk_bf16(p0[14], p0[15])};
      pw2 = (u32x4){cvt_pk_bf16(p1[0], p1[1]), cvt_pk_bf16(p1[2], p1[3]), cvt_pk_bf16(p1[4], p1[5]), cvt_pk_bf16(p1[6], p1[7])};
      pw3 = (u32x4){cvt_pk_bf16(p1[8], p1[9]), cvt_pk_bf16(p1[10], p1[11]), cvt_pk_bf16(p1[12], p1[13]), cvt_pk_bf16(p1[14], p1[15])};
      pv(o, vb0 + tile * 8192, __builtin_bit_cast(bf16x8, pw0), __builtin_bit_cast(bf16x8, pw1), __builtin_bit_cast(bf16x8, pw2), __builtin_bit_cast(bf16x8, pw3));
    }
  }
  { const LAS bf16_t* st = (const LAS bf16_t*)(shm + R_ST) + wg * 64 * ST_PITCH;
#pragma unroll
    for (int eb = 0; eb < 2; ++eb)
#pragma unroll
      for (int s = 0; s < 4; ++s) { const bf16x8 bfrag = *(const LAS bf16x8*)(st + (eb * 32 + r32) * ST_PITCH + 16 * s + 8 * hi);
        o[eb] = __builtin_amdgcn_mfma_f32_32x32x16_bf16(qx[s], bfrag, o[eb], 0, 0, 0); } }
  asm volatile("s_waitcnt lgkmcnt(0)\n\ts_barrier" ::: "memory");
  { LAS float* stg = (LAS float*)(shm + R_STG) + wid * (32 * 66);
#pragma unroll
    for (int r = 0; r < 16; ++r) { stg[crow(r, hi) * 66 + r32] = o[0][r]; stg[crow(r, hi) * 66 + 32 + r32] = o[1][r]; }
    asm volatile("s_waitcnt lgkmcnt(0)" ::: "memory");
    const int row = lane >> 1, half = lane & 1;
    float v[32]; float s1 = 0.f;
#pragma unroll
    for (int j = 0; j < 32; ++j) { v[j] = stg[row * 66 + half * 32 + j]; s1 += v[j]; }
    s1 += sx<1>(s1);
    const float mu = s1 * (1.0f / 64.0f); float s2 = 0.f;
#pragma unroll
    for (int j = 0; j < 32; ++j) { v[j] -= mu; s2 += v[j] * v[j]; }
    s2 += sx<1>(s2);
    const float rs = rsqrtf(s2 * (1.0f / 64.0f) + LN_EPS);
    const long grow = rowbase + 256 * cp + 128 * wg + (wid & 3) * 32 + row;
    const bf16_t* gp = P.proj + grow * NPP + O_RG + h * 64 + half * 32;
    const float* gw = P.gn_w + h * 64 + half * 32;
    bf16_t* op = P.concat + grow * DM + h * 64 + half * 32;
#pragma unroll
    for (int c = 0; c < 4; ++c) { const bf16x8 g8 = *(const bf16x8*)(gp + 8 * c); float ov[8];
#pragma unroll
      for (int j = 0; j < 8; ++j) { const float g = bf2f((bf16_t)g8[j]); const float silu = g / (1.0f + __expf(-g)); ov[j] = v[8 * c + j] * rs * gw[8 * c + j] * silu; }
      u32x4 w; w.x = cvt_pk_bf16(ov[0], ov[1]); w.y = cvt_pk_bf16(ov[2], ov[3]); w.z = cvt_pk_bf16(ov[4], ov[5]); w.w = cvt_pk_bf16(ov[6], ov[7]);
      *(u32x4*)(op + 8 * c) = w; } }
  asm volatile("s_waitcnt lgkmcnt(0)\n\ts_barrier" ::: "memory");
}
}
namespace moe {
constexpr int CAP = TOK;
struct MoePtrs { const bf16_t* Y; const float* ln_g; const float* ln_b; const float* router_w; const float* router_bias;
                 float* X1; bf16_t* X1B; unsigned* cnt; unsigned* list; float* gate; };

__device__ __forceinline__ void p5_phase(const MoePtrs& P, LAS char* shm, int vcu, int G) {
  const int tid = tidx(), lane = tid & 63, wave = tid >> 6;
  LAS float* xs = (LAS float*)shm;
  LAS float* lgs = (LAS float*)(shm + 65536);
  LAS unsigned* sel = (LAS unsigned*)(shm + 65536 + 8192);
  LAS unsigned* wbase = sel + 4 * 128; LAS unsigned* wcnt = wbase + 16;
  const int rows_per_wg = (TOK + G - 1) / G;
  const int row0 = vcu * rows_per_wg; int nrows = TOK - row0; if (nrows > rows_per_wg) nrows = rows_per_wg; if (nrows < 0) nrows = 0;
  float w0[16], w1[16];
#pragma unroll
  for (int j = 0; j < 16; ++j) { const float2 w = *(const float2*)(P.router_w + (size_t)(16 * lane + j) * 16 + 2 * wave); w0[j] = w.x; w1[j] = w.y; }
  for (int b0 = 0; b0 < nrows; b0 += 16) {
#pragma unroll
    for (int rr = 0; rr < 2; ++rr) { const int rl = wave * 2 + rr; const int r = b0 + rl;
      if (r < nrows) { const int row = row0 + r;
        const u32x2* yr = (const u32x2*)(P.Y + (size_t)row * DM) + lane;
        f32x4 v[4]; float s = 0.f;
#pragma unroll
        for (int j = 0; j < 4; ++j) { const u32x2 h = yr[64 * j]; v[j] = (f32x4){__uint_as_float(h.x << 16), __uint_as_float(h.x & 0xffff0000u), __uint_as_float(h.y << 16), __uint_as_float(h.y & 0xffff0000u)}; s += (v[j][0] + v[j][1]) + (v[j][2] + v[j][3]); }
        const float mean = wave_sum(s) * (1.f / DM); float s2 = 0.f;
#pragma unroll
        for (int j = 0; j < 4; ++j) { v[j] = v[j] - mean; s2 += (v[j][0] * v[j][0] + v[j][1] * v[j][1]) + (v[j][2] * v[j][2] + v[j][3] * v[j][3]); }
        const float rstd = rsqrtf(wave_sum(s2) * (1.f / DM) + LN_EPS);
        u32x2* xb = (u32x2*)(P.X1B + (size_t)row * DM) + lane;
#pragma unroll
        for (int j = 0; j < 4; ++j) { const int c0 = 4 * lane + 256 * j;
          const f32x4 g = *(const f32x4*)(P.ln_g + c0), bb = *(const f32x4*)(P.ln_b + c0);
          const f32x4 x = v[j] * rstd * g + bb;
          u32x2 o; o.x = pk2(x[0], x[1]); o.y = pk2(x[2], x[3]); xb[64 * j] = o;
          *(LAS f32x4*)(xs + rl * 1024 + (lane & 3) * 256 + ((lane >> 2) + 16 * j) * 4) = x; } } }
    __syncthreads();
    const int nb = (nrows - b0 < 16) ? nrows - b0 : 16;
    for (int rl = 0; rl < nb; ++rl) { float a0 = 0.f, a1 = 0.f;
#pragma unroll
      for (int q = 0; q < 4; ++q) { const f32x4 x = *(const LAS f32x4*)(xs + rl * 1024 + q * 256 + lane * 4);
#pragma unroll
        for (int i = 0; i < 4; ++i) { a0 = fmaf(x[i], w0[4 * q + i], a0); a1 = fmaf(x[i], w1[4 * q + i], a1); } }
      a0 = wave_sum(a0); a1 = wave_sum(a1);
      if (lane == 0) { lgs[(b0 + rl) * 16 + 2 * wave] = a0; lgs[(b0 + rl) * 16 + 2 * wave + 1] = a1; } }
    __syncthreads();
  }
  if (tid < nrows) { const int r = tid;
    float sc[16], bi[16];
#pragma unroll
    for (int e = 0; e < 16; ++e) { const float lg = lgs[r * 16 + e]; sc[e] = 1.f / (1.f + expf(-lg)); bi[e] = sc[e] + P.router_bias[e]; }
    int bestg = 0; float bestgs = -INFINITY;
#pragma unroll
    for (int gI = 0; gI < 4; ++gI) { float m1 = -INFINITY, m2 = -INFINITY;
#pragma unroll
      for (int k = 0; k < 4; ++k) { const float x = bi[gI * 4 + k]; if (x > m1) { m2 = m1; m1 = x; } else if (x > m2) { m2 = x; } }
      const float gs = m1 + m2; if (gs > bestgs) { bestgs = gs; bestg = gI; } }
    int i1 = 0, i2 = 0; float m1 = -INFINITY, m2 = -INFINITY, s1 = 0.f, s2v = 0.f;
#pragma unroll
    for (int e = 0; e < 16; ++e) { if ((e >> 2) == bestg) { const float x = bi[e]; if (x > m1) { m2 = m1; i2 = i1; s2v = s1; m1 = x; i1 = e; s1 = sc[e]; } else if (x > m2) { m2 = x; i2 = e; s2v = sc[e]; } } }
    const float inv = 1.f / (s1 + s2v);
    sel[4 * r] = (unsigned)i1; sel[4 * r + 1] = (unsigned)i2; ((LAS float*)sel)[4 * r + 2] = s1 * inv; ((LAS float*)sel)[4 * r + 3] = s2v * inv; }
  __syncthreads();
  unsigned e = 99u, myrank = 0u;
  if (wave < 4) { if (tid < 2 * nrows) e = sel[4 * (tid >> 1) + (tid & 1)];
    const unsigned long long lt = (lane == 0) ? 0ull : (~0ull >> (64 - lane));
#pragma unroll
    for (int k = 0; k < 16; ++k) { const unsigned long long mk = __ballot(e == (unsigned)k); if (e == (unsigned)k) myrank = (unsigned)__popcll(mk & lt); if (lane == k) wcnt[wave * 16 + k] = (unsigned)__popcll(mk); } }
  __syncthreads();
  if (tid < 16) { const unsigned c = wcnt[tid] + wcnt[16 + tid] + wcnt[32 + tid] + wcnt[48 + tid]; wbase[tid] = c ? atomicAdd(P.cnt + 64 * tid, c) : 0u; }
  __syncthreads();
  if (tid < 2 * nrows) { const int r = tid >> 1, sl = tid & 1;
    const unsigned before = (wave > 0 ? wcnt[e] : 0u) + (wave > 1 ? wcnt[16 + e] : 0u) + (wave > 2 ? wcnt[32 + e] : 0u);
    const size_t pos = (size_t)e * CAP + wbase[e] + before + myrank;
    P.list[pos] = (unsigned)(row0 + r) * 2u + (unsigned)sl; P.gate[pos] = ((LAS float*)sel)[4 * r + 2 + sl]; }
  __syncthreads();
}

template <int MODE>
struct MoeOrder {
  static constexpr int NPN = MODE == 0 ? 2 : 4, LDA2 = (MODE == 0 ? DM : DEXP) * 2;
  static constexpr size_t BSTRIDE_E = MODE == 0 ? (size_t)512 * DM * 2 : (size_t)DM * DEXP * 2, BSTRIDE_PN = MODE == 0 ? (size_t)256 * DM * 2 : (size_t)256 * DEXP * 2;
  const unsigned* __restrict__ cnt; const unsigned* __restrict__ list; const char* A; const char* Bt;
  __device__ __forceinline__ bool next(int i, pg8::Unit& u) const {
    const int L = i * (int)gridDim.x + (int)blockIdx.x; const int tile = L / NPN; u.pn = L % NPN; u.pm = tile;
    int acc = 0, e = -1, mt = 0, valid = 0;
#pragma unroll
    for (int k = 0; k < NEXP; ++k) { const int cn = __builtin_amdgcn_readfirstlane((int)cnt[64 * k]); const int nt = (cn + 255) >> 8; if (e < 0 && tile < acc + nt) { e = k; mt = tile - acc; valid = cn - mt * 256; } acc += nt; }
    if (e < 0) return false;
    u.e = e; u.mt = mt; u.valid = valid > 256 ? 256 : valid; u.pad = 0;
    u.pA = MODE == 1 ? A + (size_t)tile * 256 * LDA2 : A;
    u.pB = Bt + (size_t)e * BSTRIDE_E + (size_t)u.pn * BSTRIDE_PN;
    return true;
  }
  __device__ __forceinline__ unsigned rowoff(const pg8::Unit& u, int r) const {
    unsigned slot = 0u; if (r < u.valid) slot = list[(size_t)u.e * CAP + u.mt * 256 + r];
    return (slot >> 1) * (unsigned)LDA2; }
};
struct EpiSwiglu {
  static constexpr bool PERM = true;
  bf16_t* A2; const float* gate;
  __device__ __forceinline__ void operator()(const f32x4 (&acc)[2][2][4][2], const pg8::Unit& u, int wr, int wc, int fr, int fq) const {
    { const int l_ = tidx() & 63; fr = l_ & 15; fq = l_ >> 4; }
    const int col0 = u.pn * 128 + wc * 32 + 8 * fq; const int lane = fq * 16 + fr;
    const int rb = wr * 64 + lane; const size_t gb = (size_t)u.e * CAP + u.mt * 256;
    float g0 = 0.f, g1 = 0.f; if (rb < u.valid) g0 = gate[gb + rb]; if (128 + rb < u.valid) g1 = gate[gb + 128 + rb];
#pragma unroll
    for (int ai = 0; ai < 2; ++ai)
#pragma unroll
      for (int m = 0; m < 4; ++m) { const int r = ai * 128 + wr * 64 + m * 16 + fr;
        const float g = __uint_as_float((unsigned)__builtin_amdgcn_ds_bpermute((m * 16 + fr) << 2, (int)__float_as_uint(ai ? g1 : g0)));
        float a[8];
#pragma unroll
        for (int n = 0; n < 2; ++n)
#pragma unroll
          for (int i = 0; i < 4; ++i) { const float h1 = acc[ai][0][m][n][i], h2 = acc[ai][1][m][n][i]; a[4 * n + i] = h1 / (1.f + __expf(-h1)) * h2 * g; }
        u32x4 w; w.x = cvt_pk_bf16(a[0], a[1]); w.y = cvt_pk_bf16(a[2], a[3]); w.z = cvt_pk_bf16(a[4], a[5]); w.w = cvt_pk_bf16(a[6], a[7]);
        *(u32x4*)(A2 + ((size_t)u.pm * 256 + r) * 256 + col0) = w;
        asm volatile("" ::: "memory"); }
  }
};
struct EpiScatter {
  static constexpr bool PERM = true;
  bf16_t* YE; const unsigned* list;
  __device__ __forceinline__ void operator()(const f32x4 (&acc)[2][2][4][2], const pg8::Unit& u, int wr, int wc, int fr, int fq) const {
    { const int l_ = tidx() & 63; fr = l_ & 15; fq = l_ >> 4; }
    const int col0 = u.pn * 256 + wc * 32 + 8 * fq; const int lane = fq * 16 + fr;
    const int rb = wr * 64 + lane; const size_t gb = (size_t)u.e * CAP + u.mt * 256;
    unsigned s0 = (unsigned)(2 * TOK), s1 = (unsigned)(2 * TOK); if (rb < u.valid) s0 = list[gb + rb]; if (128 + rb < u.valid) s1 = list[gb + 128 + rb];
#pragma unroll
    for (int ai = 0; ai < 2; ++ai)
#pragma unroll
      for (int m = 0; m < 4; ++m) {
        const unsigned slot = (unsigned)__builtin_amdgcn_ds_bpermute((m * 16 + fr) << 2, (int)(ai ? s1 : s0));
        { bf16_t* rowp = YE + (size_t)slot * DM + col0;
#pragma unroll
          for (int bj = 0; bj < 2; ++bj) { const f32x4 v0 = acc[ai][bj][m][0], v1 = acc[ai][bj][m][1];
            u32x4 w; w.x = cvt_pk_bf16(v0[0], v0[1]); w.y = cvt_pk_bf16(v0[2], v0[3]); w.z = cvt_pk_bf16(v1[0], v1[1]); w.w = cvt_pk_bf16(v1[2], v1[3]);
            *(u32x4*)(rowp + bj * 128) = w; } }
        asm volatile("" ::: "memory"); }
  }
};
struct Ln2Ptrs { const bf16_t* X1; const bf16_t* YE; const float* g; const float* b; float* out; bf16_t* XB; };
#define LN2_LOAD(P, row, lane, X, Y0, Y1) do { const u32x2* xr_ = (const u32x2*)((P).X1 + (size_t)(row) * DM) + (lane); \
  const u32x2* y0_ = (const u32x2*)((P).YE + (size_t)(row) * 2 * DM) + (lane); const u32x2* y1_ = y0_ + DM / 4; \
  _Pragma("unroll") for (int j = 0; j < 4; ++j) { X[j] = xr_[64 * j]; Y0[j] = y0_[64 * j]; Y1[j] = y1_[64 * j]; } } while (0)
__device__ __forceinline__ void ln2_row(const Ln2Ptrs& P, int row, int lane, const u32x2 (&inx)[4], const u32x2 (&iny0)[4], const u32x2 (&iny1)[4]) {
  f32x4 v[4]; float s = 0.f;
#pragma unroll
  for (int j = 0; j < 4; ++j) { const u32x2 xh = inx[j]; const f32x4 x = (f32x4){__uint_as_float(xh.x << 16), __uint_as_float(xh.x & 0xffff0000u), __uint_as_float(xh.y << 16), __uint_as_float(xh.y & 0xffff0000u)}; const u32x2 a = iny0[j], bq = iny1[j];
    f32x4 y; y[0] = __uint_as_float(a.x << 16) + __uint_as_float(bq.x << 16); y[1] = __uint_as_float(a.x & 0xffff0000u) + __uint_as_float(bq.x & 0xffff0000u);
    y[2] = __uint_as_float(a.y << 16) + __uint_as_float(bq.y << 16); y[3] = __uint_as_float(a.y & 0xffff0000u) + __uint_as_float(bq.y & 0xffff0000u);
    v[j] = x * ALPHA + y; s += (v[j][0] + v[j][1]) + (v[j][2] + v[j][3]); }
  const float mean = wave_sum(s) * (1.f / DM); float s2 = 0.f;
#pragma unroll
  for (int j = 0; j < 4; ++j) { v[j] = v[j] - mean; s2 += (v[j][0] * v[j][0] + v[j][1] * v[j][1]) + (v[j][2] * v[j][2] + v[j][3] * v[j][3]); }
  const float rstd = rsqrtf(wave_sum(s2) * (1.f / DM) + LN_EPS);
  f32x4* xo = (f32x4*)(P.out + (size_t)row * DM) + lane; u32x2* xb = (u32x2*)(P.XB + (size_t)row * DM) + lane;
#pragma unroll
  for (int j = 0; j < 4; ++j) { const int c0 = 4 * lane + 256 * j;
    const f32x4 g = *(const f32x4*)(P.g + c0), bb = *(const f32x4*)(P.b + c0);
    const f32x4 x = v[j] * rstd * g + bb;
    if (P.out) xo[64 * j] = x; else { u32x2 o; o.x = pk2(x[0], x[1]); o.y = pk2(x[2], x[3]); xb[64 * j] = o; } }
}
}
#ifndef PROBE_PHASE
#define PROBE_PHASE 0
#endif
#define NREP(p) ((PROBE_PHASE == (p)) ? 2 : 1)
constexpr int LDS_BYTES = 147456;
constexpr int NTHREADS = 512;
constexpr int MISC_OFF = 131072;
constexpr int CW_QCTR = 64;
constexpr int CW_CNT = 8192;
constexpr int CW_BAR = 4096;

typedef GAS unsigned gu32;
#define RLX_AGENT __ATOMIC_RELAXED, __HIP_MEMORY_SCOPE_AGENT
#define XB_TMO      128
#define XB_XCNT(j)  (256  + 64 * (j))
#define XB_XSUB(j)  (1280 + 64 * (j))
#define XB_XGEN(j)  (2304 + 64 * (j))
#define XB_TOP      3328
#define XB_TOPGEN   3392
#define XCD_BAR_WORDS 3456
#define XB_SPIN_CAP (1u << 20)
__device__ __forceinline__ unsigned xb_ld(gu32* p)              { return __hip_atomic_load(p, __ATOMIC_RELAXED, __HIP_MEMORY_SCOPE_AGENT); }
__device__ __forceinline__ unsigned xb_add(gu32* p, unsigned v) { return __hip_atomic_fetch_add(p, v, __ATOMIC_RELAXED, __HIP_MEMORY_SCOPE_AGENT); }
__device__ __forceinline__ unsigned xb_xcc_id() { return (unsigned)__builtin_amdgcn_s_getreg((3 << 11) | 20) & 0xFu; }
#define XB_SPIN(cond, bar) do { unsigned _sp = 0; while (cond) { __builtin_amdgcn_s_sleep(1); \
    if ((++_sp & 255u) == 0u) { if (xb_ld(&(bar)[XB_TMO])) break; if (_sp > XB_SPIN_CAP) { (void)xb_add(&(bar)[XB_TMO], 1u); break; } } } } while (0)
struct XcdBarrier { gu32* bar; unsigned x; volatile LAS unsigned* st; };
__device__ __forceinline__ XcdBarrier xcd_barrier_post(gu32* bar, volatile LAS unsigned* st) {
    XcdBarrier b; b.bar = bar; b.x = xb_xcc_id(); b.st = st;
    if (tidx() == 0) (void)xb_add(&bar[XB_XCNT(b.x)], 1u);
    return b;
}
__device__ __forceinline__ void xcd_barrier_complete(gu32* bar, unsigned x, unsigned& nloc, unsigned& nx) {
    const unsigned G = gridDim.x * gridDim.y * gridDim.z;
    unsigned sum, cnt, mine, sp = 0u;
    for (;;) {
        sum = 0u; cnt = 0u; mine = 0u;
#pragma unroll
        for (unsigned j = 0; j < 16; ++j) { const unsigned c = xb_ld(&bar[XB_XCNT(j)]); sum += c; cnt += (c > 0u) ? 1u : 0u; mine = (j == x) ? c : mine; }
        if (sum == G) break;
        __builtin_amdgcn_s_sleep(1);
        if ((++sp & 255u) == 0u) { if (xb_ld(&bar[XB_TMO])) break; if (sp > XB_SPIN_CAP) { (void)xb_add(&bar[XB_TMO], 1u); break; } }
    }
    nloc = mine > 0u ? mine : 1u; nx = cnt > 0u ? cnt : 1u;
}
__device__ __forceinline__ void xcd_barrier(const XcdBarrier& b) {
    asm volatile("s_waitcnt vmcnt(0)" ::: "memory");
    __syncthreads();
    if (tidx() == 0) {
        gu32* bar = b.bar; unsigned bx_ = b.x;
        asm volatile("" : "+s"(bar), "+s"(bx_));
        __builtin_amdgcn_s_waitcnt(0);
        unsigned nloc = b.st[0], nx = b.st[1];
        if (nloc == 0u) { xcd_barrier_complete(bar, bx_, nloc, nx); b.st[0] = nloc; b.st[1] = nx; }
        const unsigned old = xb_add(&bar[XB_XSUB(bx_)], 1u);
        const unsigned gen = old / nloc;
        if (old + 1u == (gen + 1u) * nloc) {
            __builtin_amdgcn_fence(__ATOMIC_RELEASE, "agent");
            asm volatile("s_waitcnt vmcnt(0)" ::: "memory");
            const unsigned og = xb_add(&bar[XB_TOP], 1u);
            const unsigned tg = og / nx;
            if (og + 1u == (tg + 1u) * nx) xb_add(&bar[XB_TOPGEN], 1u);
            else XB_SPIN(xb_ld(&bar[XB_TOPGEN]) == tg, bar);
            __builtin_amdgcn_fence(__ATOMIC_ACQUIRE, "agent");
            xb_add(&bar[XB_XGEN(bx_)], 1u);
            asm volatile("s_waitcnt vmcnt(0)" ::: "memory");
        } else {
            XB_SPIN(xb_ld(&bar[XB_XGEN(bx_)]) == gen, bar);
            __builtin_amdgcn_fence(__ATOMIC_ACQUIRE, "agent");
            asm volatile("s_waitcnt vmcnt(0)" ::: "memory");
        }
    }
    __syncthreads();
}

struct Args { const float* in[17]; float* out; unsigned char* ws; };
#define CAS __attribute__((address_space(4)))
__device__ __forceinline__ const CAS char* kargs() { const CAS char* kp = (const CAS char*)__builtin_amdgcn_kernarg_segment_ptr(); asm volatile("" : "+s"(kp)); return kp; }

__global__ void __launch_bounds__(NTHREADS, 2) mk_fwd(Args a) {
    extern __shared__ __attribute__((aligned(16))) unsigned char lds[];
    LAS unsigned char* L = (LAS unsigned char*)lds;
    LAS char* shm = (LAS char*)lds;
    volatile LAS unsigned* MISC = (volatile LAS unsigned*)(L + MISC_OFF);
#define lane (tidx() & 63)
#define wave (__builtin_amdgcn_readfirstlane(tidx() >> 6))
    const int G = gridDim.x, bx = blockIdx.x;
    const int vcu = (G % 8 == 0) ? (bx % 8) * (G / 8) + bx / 8 : bx;
    for (int u = tidx(); u < (LDS_BYTES - MISC_OFF) / 4; u += NTHREADS) ((LAS unsigned*)(L + MISC_OFF))[u] = 0u;
    __syncthreads();

#define KPTR(off, ET) ((ET*)(ET GAS*)(*(const unsigned long long CAS*)(kargs() + (off))))
#define IN_(i) KPTR(8 * (i), const float)
#define g_x_in IN_(0)
#define g_w_in IN_(1)
#define g_ret_gn_w IN_(2)
#define g_swa_sinks IN_(3)
#define g_qn_w IN_(4)
#define g_kvn_w IN_(5)
#define g_w_uq IN_(6)
#define g_w_ukv IN_(7)
#define g_w_out IN_(8)
#define g_ln1_g IN_(9)
#define g_ln1_b IN_(10)
#define g_router_w IN_(11)
#define g_router_bias IN_(12)
#define g_wgu IN_(13)
#define g_wd IN_(14)
#define g_ln2_g IN_(15)
#define g_ln2_b IN_(16)
#define g_out KPTR(136, float)
#define g_ws KPTR(144, unsigned char)
#define g_CTL ((unsigned*)(g_ws + WS_CTL))
#define g_XB ((bf16_t*)(g_ws + WS_R0))
#define g_PROJ ((bf16_t*)(g_ws + WS_R1))
#define g_Y ((bf16_t*)(g_ws + WS_R1))
#define g_QM ((bf16_t*)(g_ws + WS_QM))
#define g_KVM ((bf16_t*)(g_ws + WS_KVM))
#define g_KPE ((bf16_t*)(g_ws + WS_KPE))
#define g_CONCAT ((bf16_t*)(g_ws + WS_R3))
#define g_X1 ((float*)(g_ws + WS_X1))
#define g_TABR ((const float2*)(g_ws + WS_TABR))
#define g_TABM ((const float2*)(g_ws + WS_TABM))
#define g_X1B ((bf16_t*)(g_ws + WS_R0))
#define g_A2 ((bf16_t*)(g_ws + WS_A2))
#define g_YE ((bf16_t*)(g_ws + WS_YE))
#define g_list ((unsigned*)(g_ws + WS_LIST))
#define g_gate ((float*)(g_ws + WS_GATE))

    XcdBarrier bar = xcd_barrier_post((gu32*)(g_CTL + CW_BAR), MISC + 8);
#define GRID_BAR() do { xcd_barrier(bar); if (PROBE_PHASE == 10) xcd_barrier(bar); } while (0)

    for (int rep_ = 0; rep_ < NREP(9); ++rep_)
    { P0Args pa; pa.x = g_x_in; pa.w_in = g_w_in; pa.qn_w = g_qn_w; pa.kvn_w = g_kvn_w; pa.w_uq = g_w_uq; pa.w_ukv = g_w_ukv; pa.w_out = g_w_out; pa.ws = g_ws;
      p0_all(pa, L, vcu, G); }
    GRID_BAR();

    for (int l = 0; l < DEPTH; ++l) {
        for (int rep_ = 0; rep_ < NREP(1); ++rep_)
        { pg8::Gemm g{g_XB, (const bf16_t*)(g_ws + WS_WIN) + (size_t)l * NPP * DM, DM, DM, DM, 0}; pg8::EpiBf16Norm E{g_PROJ, (float*)(g_ws + WS_PARTS), NPP, 0};
          pg8::StaticOrder S; S.init(g, TOK, NPP, G, bx);
          pg8::gemm_phase<pg8::EpiBf16Norm, pg8::StaticOrder, true, false>(L, g, S, E);
          const int nun = (TOK / 256) * (NPP / 256); const int nfull = nun % G;
          if (nfull == 0) p0_experts(g_wgu + (size_t)l * NEXP * DM * 512, g_wd + (size_t)l * NEXP * DEXP * DM, g_ws, (LAS float*)(L + wave * 16384), bx * 8 + wave, G * 8, lane);
          else if (bx >= nfull) p0_experts(g_wgu + (size_t)l * NEXP * DM * 512, g_wd + (size_t)l * NEXP * DEXP * DM, g_ws, (LAS float*)(L + wave * 16384), (bx - nfull) * 8 + wave, (G - nfull) * 8, lane); }
        GRID_BAR();
        for (int rep_ = 0; rep_ < NREP(2); ++rep_) {
        { pg8::Gemm g{g_PROJ + O_CQ, (const bf16_t*)(g_ws + WS_WUQ) + (size_t)l * NQMP * 384, NPP, 384, 384, 0}; pg8::EpiRms E{g_QM, (const float*)(g_ws + WS_PARTS), NQMP, 0, 8, 1.0f / 384.0f, RMS_EPS, 0};
          pg8::StaticOrder S; S.init(g, TOK, NQMP, G, bx);
          pg8::gemm_phase<pg8::EpiRms, pg8::StaticOrder, true, false>(L, g, S, E); }
        { pg8::Gemm g{g_PROJ + O_CKV, (const bf16_t*)(g_ws + WS_WUKV) + (size_t)l * NKVM * 256, NPP, 256, 256, 0}; pg8::EpiRms E{g_KVM, (const float*)(g_ws + WS_PARTS), NKVM, 8, 4, 1.0f / 256.0f, RMS_EPS, 0};
          pg8::StaticOrder S; S.init(g, TOK, NKVM, G, G - 1 - bx);
          pg8::gemm_phase<pg8::EpiRms, pg8::StaticOrder, true, false>(L, g, S, E); }
        for (int idx = vcu * NTHREADS + tidx(); idx < TOK * 16; idx += G * NTHREADS) {
          const int t = idx >> 4, i = idx & 15, pos = t % SEQ; const bf16_t* p = g_PROJ + (size_t)t * NPP + O_KR; const float2 cs = g_TABM[pos * 16 + i];
          const float x1 = bf2f(p[i]), x2 = bf2f(p[i + 16]);
          g_KPE[(size_t)t * 32 + i] = (bf16_t)f2bf(x1 * cs.x - x2 * cs.y); g_KPE[(size_t)t * 32 + i + 16] = (bf16_t)f2bf(x1 * cs.y + x2 * cs.x); }
        { ret::RetPtrs rp; rp.proj = g_PROJ; rp.tabr = g_TABR; rp.gn_w = g_ret_gn_w + l * 256; rp.U = (float*)(g_ws + WS_U); rp.concat = g_CONCAT;
          for (int u = G - 1 - bx; u < 256; u += G) ret::upd_unit(rp, u >> 7, (u >> 5) & 3, u & 31, shm); }
        }
        GRID_BAR();
        { att::AttnPtrs ap; ap.proj = g_PROJ; ap.qm = g_QM; ap.kvm = g_KVM; ap.kpe = g_KPE; ap.tabm = g_TABM; ap.sinks = g_swa_sinks + l * 6; ap.concat = g_CONCAT;
          ret::RetPtrs rp; rp.proj = g_PROJ; rp.tabr = g_TABR; rp.gn_w = g_ret_gn_w + l * 256; rp.U = (float*)(g_ws + WS_U); rp.concat = g_CONCAT;
          for (int rep_ = 0; rep_ < NREP(3); ++rep_)
          for (;;) {
            if (tidx() == 0) MISC[0] = atomicAdd(g_CTL + CW_QCTR + 64 * l + rep_, 1u);
            __syncthreads();
            const unsigned idx = MISC[0];
            __syncthreads();
            if (idx >= 1024u) break;
            if (idx < 384u) { const int qb = 31 - (int)(idx / 12u), bh = (int)(idx % 12u); att::attn_unit<0>(ap, bh / 6, bh % 6, qb, shm); }
            else if (idx < 768u) { const unsigned i2 = idx - 384u; const int qb = (int)(i2 / 12u), bh = (int)(i2 % 12u); att::attn_unit<1>(ap, bh / 6, bh % 6, qb, shm); }
            else { const int u = (int)(idx - 768u); ret::out_unit(rp, u >> 7, (u >> 5) & 3, u & 31, shm); }
          } }
        GRID_BAR();
        for (int rep_ = 0; rep_ < NREP(4); ++rep_)
        { pg8::Gemm g{g_CONCAT, (const bf16_t*)(g_ws + WS_WOUT) + (size_t)l * DM * DM, DM, DM, DM, 0}; pg8::EpiResid E{(l == 0) ? g_x_in : (const float*)nullptr, g_XB, g_Y, DM, ALPHA};
          pg8::StaticOrder S; S.init(g, TOK, DM, G, bx);
          pg8::gemm_phase<pg8::EpiResid, pg8::StaticOrder, true, false>(L, g, S, E); }
        GRID_BAR();
#define g_cnt (g_CTL + CW_CNT + 2048 * l)
        if (PROBE_PHASE == 5) { moe::MoePtrs mp; mp.Y = g_Y; mp.ln_g = g_ln1_g + l * DM; mp.ln_b = g_ln1_b + l * DM; mp.router_w = g_router_w; mp.router_bias = g_router_bias; mp.X1 = nullptr; mp.X1B = g_X1B;
          mp.cnt = g_CTL + CW_CNT + 2048 * l + 1024; mp.list = (unsigned*)(g_ws + WS_R1 + 64 * MiB); mp.gate = (float*)(g_ws + WS_R1 + 65 * MiB);
          moe::p5_phase(mp, shm, vcu, G); }
        { moe::MoePtrs mp; mp.Y = g_Y; mp.ln_g = g_ln1_g + l * DM; mp.ln_b = g_ln1_b + l * DM; mp.router_w = g_router_w; mp.router_bias = g_router_bias; mp.X1 = nullptr; mp.X1B = g_X1B; mp.cnt = g_cnt; mp.list = g_list; mp.gate = g_gate;
          moe::p5_phase(mp, shm, vcu, G); }
        GRID_BAR();
        for (int rep_ = 0; rep_ < NREP(6); ++rep_)
        { moe::MoeOrder<0> S; S.cnt = g_cnt; S.list = g_list; S.A = (const char*)g_X1B; S.Bt = (const char*)(g_ws + WS_WGU);
          pg8::Gemm g{nullptr, nullptr, DM, DM, DM, 0}; moe::EpiSwiglu E{g_A2, g_gate};
          pg8::gemm_phase<moe::EpiSwiglu, moe::MoeOrder<0>, true, true>(L, g, S, E); }
        GRID_BAR();
        for (int rep_ = 0; rep_ < NREP(7); ++rep_)
        { moe::MoeOrder<1> S; S.cnt = g_cnt; S.list = g_list; S.A = (const char*)g_A2; S.Bt = (const char*)(g_ws + WS_WD);
          pg8::Gemm g{nullptr, nullptr, DEXP, DEXP, DEXP, 0}; moe::EpiScatter E{g_YE, g_list};
          pg8::gemm_phase<moe::EpiScatter, moe::MoeOrder<1>, true, false>(L, g, S, E); }
        GRID_BAR();
        for (int rep_ = 0; rep_ < NREP(8); ++rep_)
        { moe::Ln2Ptrs lp; lp.X1 = g_X1B; lp.YE = g_YE; lp.g = g_ln2_g + l * DM; lp.b = g_ln2_b + l * DM; lp.out = (l + 1 < DEPTH) ? (float*)nullptr : g_out; lp.XB = g_XB;
          u32x2 cx[4], cy0[4], cy1[4], nx[4], ny0[4], ny1[4]; int row = vcu * 8 + wave; const int ln_ = lane;
#pragma unroll
          for (int j = 0; j < 4; ++j) { nx[j] = (u32x2){0u, 0u}; ny0[j] = nx[j]; ny1[j] = nx[j]; }
          if (row < TOK) LN2_LOAD(lp, row, ln_, nx, ny0, ny1);
          for (; row < TOK; row += G * 8) {
#pragma unroll
            for (int j = 0; j < 4; ++j) { cx[j] = nx[j]; cy0[j] = ny0[j]; cy1[j] = ny1[j]; }
            if (row + G * 8 < TOK) LN2_LOAD(lp, row + G * 8, ln_, nx, ny0, ny1);
            moe::ln2_row(lp, row, ln_, cx, cy0, cy1); } }
        if (l + 1 < DEPTH) GRID_BAR();
    }
    if (xb_ld((gu32*)(g_CTL + CW_BAR + XB_TMO)) != 0u && bx == 0 && tidx() == 0) g_out[0] = __builtin_nanf("");
#undef g_out
#undef g_ws
#undef g_list
#undef g_gate
#undef g_cnt
}

extern "C" void kernel_launch(void* const* d_in, const int* in_sizes, int n_in, void* d_out, int out_size, void* d_ws, size_t ws_size, hipStream_t stream) {
    static int grid = 0;
    if (grid == 0) {
        if (n_in != 17 || ws_size < WS_END || out_size != TOK * DM) { fprintf(stderr, "kernel_launch: unexpected problem (n_in %d, ws %zu, out %d); nothing launched\n", n_in, ws_size, out_size); grid = -1; return; }
        int dev = 0, cus = 0, per_cu = 0;
        if (hipGetDevice(&dev) != hipSuccess || hipDeviceGetAttribute(&cus, hipDeviceAttributeMultiprocessorCount, dev) != hipSuccess) { grid = -1; return; }
        if (hipFuncSetAttribute((const void*)mk_fwd, hipFuncAttributeMaxDynamicSharedMemorySize, LDS_BYTES) != hipSuccess) { fprintf(stderr, "kernel_launch: hipFuncSetAttribute failed\n"); grid = -1; return; }
        if (hipOccupancyMaxActiveBlocksPerMultiprocessor(&per_cu, (const void*)mk_fwd, NTHREADS, LDS_BYTES) != hipSuccess || per_cu < 1) { fprintf(stderr, "kernel_launch: occupancy query says %d workgroups per CU\n", per_cu); (void)hipGetLastError(); grid = -1; return; }
        grid = cus;
    }
    if (grid < 0) return;
    (void)hipMemsetAsync((char*)d_ws + WS_CTL, 0, CTL_ZERO_BYTES, stream);
    Args a{};
    for (int i = 0; i < 17; ++i) a.in[i] = (const float*)d_in[i];
    a.out = (float*)d_out; a.ws = (unsigned char*)d_ws;
    hipLaunchKernelGGL(mk_fwd, dim3(grid), dim3(NTHREADS), LDS_BYTES, stream, a);
}
```
